# Optimizing an MI355X kernel written in HIP

```python
import math
import jax, jax.numpy as jnp
from jax import lax
import numpy as np

D_MODEL = 1024
BATCH = 16
SEQ = 2048
DEPTH = 2

PLE_DIM = 256
N_A_LAYERS = DEPTH // 2
N_B_LAYERS = DEPTH - N_A_LAYERS
N_DENSE_LAYERS = (DEPTH + 1) // 2
N_MOE_LAYERS = DEPTH // 2

RWKV_HEAD = 64
RWKV_HEADS = D_MODEL // RWKV_HEAD
DECAY_LORA = 64
ICLR_LORA = 64
GATE_LORA = 128
GN_EPS = 64e-5

N_HEADS = 16
HEAD_DIM = D_MODEL // N_HEADS
N_KV_GROUPS = 4
Q_PER_GROUP = N_HEADS // N_KV_GROUPS
N_BRANCH = 3
CMP_LEN = 32
CMP_STRIDE = 16
CMP_HIDDEN = 256
SEL_BLOCK = 64
N_SEL = 8
WINDOW = 512
Q_CHUNK = 32
ROPE_THETA = 10000.0

D_FF = 2816
N_EXPERTS = 8
TOP_K = 2
D_FF_EXPERT = 1408
MOE_ROWS = 256

LN_EPS = 1e-5
DEEPNORM_ALPHA = (2.0 * DEPTH) ** 0.25
DEEPNORM_BETA = (8.0 * DEPTH) ** -0.25
NEG_INF = -1e30
FORCE_SCORE = 1e4

kernel_name = "yoco_rwkv7_nsa_moe_deepnorm"


def layer_norm(x, g, b):
    xf = x.astype(jnp.float32)
    mu = jnp.mean(xf, -1, keepdims=True)
    var = jnp.mean(jnp.square(xf - mu), -1, keepdims=True)
    return ((xf - mu) * lax.rsqrt(var + LN_EPS) * g + b).astype(x.dtype)


def rope(x, pos):
    half = x.shape[-1] // 2
    inv = ROPE_THETA ** (-jnp.arange(half, dtype=jnp.float32) / half)
    ang = pos.astype(jnp.float32)[:, None] * inv[None, :]
    cos, sin = jnp.cos(ang), jnp.sin(ang)
    xf = x.astype(jnp.float32)
    x1, x2 = xf[..., :half], xf[..., half:]
    return jnp.concatenate([x1 * cos - x2 * sin, x2 * cos + x1 * sin], -1).astype(x.dtype)


def masked_softmax(s, mask):
    s = jnp.where(mask, s.astype(jnp.float32), NEG_INF)
    p = jax.nn.softmax(s, axis=-1)
    return jnp.where(mask, p, 0.0)


def token_shift(x):
    return jnp.pad(x, ((0, 0), (1, 0), (0, 0)))[:, :-1]


def rwkv7_time_mix(x, mu, w_rkv, w0, w1, w2, a0, a1, a2, g1, g2, k_k, k_a, r_k, gn_g, gn_b, w_o):
    B, T, D = x.shape
    H, N = RWKV_HEADS, RWKV_HEAD
    xx = token_shift(x) - x
    mix = lambda i: x + xx * mu[i]
    rkv = jnp.einsum('mbtd,mde->mbte', jnp.stack([mix(0), mix(1), mix(2)]), w_rkv)
    w = -jax.nn.softplus(-(w0 + jnp.tanh(mix(3) @ w1) @ w2)) - 0.5
    a = jax.nn.sigmoid(a0 + (mix(4) @ a1) @ a2)
    g = jax.nn.sigmoid(mix(5) @ g1) @ g2
    heads = lambda z: z.reshape(B, T, H, N).astype(jnp.float32)
    r, k, v, w, a = heads(rkv[0]), heads(rkv[1]), heads(rkv[2]), heads(w), heads(a)
    kk = k * k_k.reshape(H, N).astype(jnp.float32)
    kk = kk / jnp.maximum(jnp.sqrt(jnp.sum(kk * kk, -1, keepdims=True)), 1e-12)
    k = k * (1.0 + (a - 1.0) * k_a.reshape(H, N).astype(jnp.float32))
    decay = jnp.exp(-jnp.exp(w))

    def step(S, inp):
        r_t, k_t, v_t, d_t, kk_t, a_t = inp
        sk = jnp.einsum('bhij,bhj->bhi', S, kk_t)
        S = (S * d_t[:, :, None, :] - sk[..., :, None] * (kk_t * a_t)[:, :, None, :]
             + v_t[..., :, None] * k_t[:, :, None, :])
        return S, jnp.einsum('bhij,bhj->bhi', S, r_t)

    S0 = jnp.zeros((B, H, N, N), jnp.float32)
    seq = tuple(jnp.moveaxis(z, 1, 0) for z in (r, k, v, decay, kk, a))
    _, out = lax.scan(step, S0, seq)
    out = jnp.moveaxis(out, 0, 1)
    mu_o = jnp.mean(out, -1, keepdims=True)
    var_o = jnp.mean(jnp.square(out - mu_o), -1, keepdims=True)
    out = ((out - mu_o) * lax.rsqrt(var_o + GN_EPS)).reshape(B, T, D) * gn_g + gn_b
    bonus = jnp.sum(r * k * r_k.reshape(H, N).astype(jnp.float32), -1, keepdims=True) * v
    out = out + bonus.reshape(B, T, D)
    return (out * g).astype(x.dtype) @ w_o


def nsa_shared_kv(s, w_kv, cmp_pos, phi_w1, phi_b1, phi_w2):
    B, T, _ = s.shape
    G, dh = N_KV_GROUPS, HEAD_DIM
    kv = jnp.transpose((s @ w_kv).reshape(B, T, 6, G, dh), (2, 0, 3, 1, 4))
    pos = jnp.arange(T)
    n_cmp = (T - CMP_LEN) // CMP_STRIDE + 1
    idx = jnp.arange(n_cmp)[:, None] * CMP_STRIDE + jnp.arange(CMP_LEN)[None, :]

    def compress(z, j):
        blk = z[:, :, idx, :] + cmp_pos[j]
        blk = blk.reshape(B, G, n_cmp, CMP_LEN * dh)
        return jax.nn.gelu(blk @ phi_w1[j] + phi_b1[j]) @ phi_w2[j]

    k_cmp = compress(kv[0], 0)
    v_cmp = compress(kv[1], 1)
    k_slc = rope(kv[2], pos)
    k_win = rope(kv[4], pos)
    return (k_cmp, v_cmp, k_slc, kv[3], k_win, kv[5])


def nsa_attention(h, shared, w_in, w_o):
    B, T, D = h.shape
    G, R, dh, H = N_KV_GROUPS, Q_PER_GROUP, HEAD_DIM, N_HEADS
    k_cmp, v_cmp, k_slc, v_slc, k_win, v_win = shared
    proj = h @ w_in
    q = proj[..., :H * dh].reshape(B, T, G, R, dh).transpose(0, 2, 3, 1, 4)
    gates = jax.nn.sigmoid(proj[..., H * dh:].astype(jnp.float32))
    gates = gates.reshape(B, T, G, R, N_BRANCH).transpose(0, 2, 3, 1, 4)
    pos = jnp.arange(T)
    q_rot = rope(q, pos)
    scale = HEAD_DIM ** -0.5

    n_cmp = k_cmp.shape[2]
    n_blk = T // SEL_BLOCK
    n_pick = min(N_SEL, n_blk)
    cmp_start = jnp.arange(n_cmp) * CMP_STRIDE
    cmp_end = cmp_start + CMP_LEN - 1
    blk_start = jnp.arange(n_blk) * SEL_BLOCK
    blk_ids = jnp.arange(n_blk)
    overlap = ((cmp_start[:, None] < blk_start[None, :] + SEL_BLOCK)
               & (cmp_end[:, None] >= blk_start[None, :])).astype(jnp.float32)
    k_blk = k_slc.reshape(B, G, n_blk, SEL_BLOCK, dh)
    v_blk = v_slc.reshape(B, G, n_blk, SEL_BLOCK, dh)
    k_win_pad = jnp.pad(k_win, ((0, 0), (0, 0), (WINDOW, 0), (0, 0)))
    v_win_pad = jnp.pad(v_win, ((0, 0), (0, 0), (WINDOW, 0), (0, 0)))
    bi = jnp.arange(B)[:, None, None, None]
    gi = jnp.arange(G)[None, :, None, None]
    n_chunks = T // Q_CHUNK
    span = WINDOW + Q_CHUNK

    def attend_chunk(args):
        c, q_c, qr_c, g_c = args
        t = c * Q_CHUNK + jnp.arange(Q_CHUNK)
        s = jnp.einsum('bgrqd,bgnd->bgrqn', q_c, k_cmp) * scale
        p_cmp = masked_softmax(s, cmp_end[None, :] <= t[:, None])
        o_cmp = jnp.einsum('bgrqn,bgnd->bgrqd', p_cmp.astype(v_cmp.dtype), v_cmp)
        imp = jnp.einsum('bgrqn,ns->bgqs', p_cmp, overlap)
        cur = t // SEL_BLOCK
        forced = ((blk_ids[None, :] == 0) | (blk_ids[None, :] == cur[:, None])
                  | (blk_ids[None, :] == cur[:, None] - 1))
        causal_blk = blk_start[None, :] <= t[:, None]
        imp = jnp.where(forced, FORCE_SCORE, jnp.where(causal_blk, imp, NEG_INF))
        _, sel = lax.top_k(imp, n_pick)
        k_sel = k_blk[bi, gi, sel].reshape(B, G, Q_CHUNK, n_pick * SEL_BLOCK, dh)
        v_sel = v_blk[bi, gi, sel].reshape(B, G, Q_CHUNK, n_pick * SEL_BLOCK, dh)
        key_pos = (sel[..., None] * SEL_BLOCK + jnp.arange(SEL_BLOCK)).reshape(B, G, Q_CHUNK, -1)
        s = jnp.einsum('bgrqd,bgqkd->bgrqk', qr_c, k_sel) * scale
        p = masked_softmax(s, (key_pos <= t[None, None, :, None])[:, :, None])
        o_slc = jnp.einsum('bgrqk,bgqkd->bgrqd', p.astype(v_sel.dtype), v_sel)
        kw = lax.dynamic_slice_in_dim(k_win_pad, c * Q_CHUNK, span, axis=2)
        vw = lax.dynamic_slice_in_dim(v_win_pad, c * Q_CHUNK, span, axis=2)
        s_pos = c * Q_CHUNK - WINDOW + jnp.arange(span)
        diff = t[:, None] - s_pos[None, :]
        wmask = (diff >= 0) & (diff < WINDOW) & (s_pos[None, :] >= 0)
        s = jnp.einsum('bgrqd,bgkd->bgrqk', qr_c, kw) * scale
        p = masked_softmax(s, wmask)
        o_win = jnp.einsum('bgrqk,bgkd->bgrqd', p.astype(vw.dtype), vw)
        o = g_c[..., 0:1] * o_cmp + g_c[..., 1:2] * o_slc + g_c[..., 2:3] * o_win
        return o.astype(h.dtype)

    chunked = lambda z: jnp.moveaxis(z.reshape(B, G, R, n_chunks, Q_CHUNK, z.shape[-1]), 3, 0)
    out = lax.map(attend_chunk, (jnp.arange(n_chunks), chunked(q), chunked(q_rot), chunked(gates)))
    out = jnp.transpose(out, (1, 0, 4, 2, 3, 5)).reshape(B, T, H * dh)
    return out @ w_o


def swiglu(x, w_gu, w_down):
    gt, up = jnp.split(x @ w_gu, 2, axis=-1)
    return (jax.nn.silu(gt) * up) @ w_down


def moe_swiglu(x, w_router, b_router, w_gu, w_down):
    B, T, D = x.shape
    xt = x.reshape(-1, D)
    n_tok = xt.shape[0]
    n_assign = n_tok * TOP_K
    logits = (xt @ w_router).astype(jnp.float32) + b_router
    top_logit, top_e = lax.top_k(logits, TOP_K)
    weights = jax.nn.softmax(top_logit, axis=-1)
    flat_e = top_e.reshape(-1)
    flat_tok = jnp.arange(n_assign) // TOP_K
    order = jnp.argsort(flat_e)
    e_sorted = flat_e[order]
    tok_sorted = flat_tok[order]
    w_sorted = weights.reshape(-1)[order]
    counts = jnp.bincount(flat_e, length=N_EXPERTS)
    padded = (counts + MOE_ROWS - 1) // MOE_ROWS * MOE_ROWS
    pad_end = jnp.cumsum(padded)
    pad_start = pad_end - padded
    grp_start = jnp.cumsum(counts) - counts
    dest = pad_start[e_sorted] + jnp.arange(n_assign) - grp_start[e_sorted]
    n_blocks = -(-n_assign // MOE_ROWS) + N_EXPERTS
    n_rows = n_blocks * MOE_ROWS
    row_tok = jnp.zeros((n_rows,), jnp.int32).at[dest].set(tok_sorted.astype(jnp.int32))
    block_e = jnp.minimum(jnp.searchsorted(pad_end, jnp.arange(n_blocks) * MOE_ROWS, side='right'),
                          N_EXPERTS - 1)
    xs = xt[row_tok].reshape(n_blocks, MOE_ROWS, D)

    def expert_block(args):
        xb, e = args
        gt, up = jnp.split(xb @ w_gu[e], 2, axis=-1)
        return (jax.nn.silu(gt) * up) @ w_down[e]

    ys = lax.map(expert_block, (xs, block_e)).reshape(n_rows, D)
    y_assign = ys[dest] * w_sorted[:, None].astype(ys.dtype)
    out = jax.ops.segment_sum(y_assign, tok_sorted, num_segments=n_tok)
    return out.reshape(B, T, D)


def setup_inputs(seed: int = 0) -> dict:
    key = jax.random.key(seed)
    ks = iter(jax.random.split(key, 48))
    nrm = lambda shape, sc: jax.random.normal(next(ks), shape, jnp.float32) * sc
    unif = lambda shape, lo, hi: jax.random.uniform(next(ks), shape, jnp.float32, lo, hi)
    D, NA, NB, ND, NM = D_MODEL, N_A_LAYERS, N_B_LAYERS, N_DENSE_LAYERS, N_MOE_LAYERS
    G, dh = N_KV_GROUPS, HEAD_DIM
    return {
        "x": nrm((BATCH, SEQ, D), 1.0),
        "p": nrm((DEPTH, BATCH, SEQ, PLE_DIM), 1.0),
        "a_mu": unif((NA, 6, D), 0.0, 1.0),
        "a_w_rkv": nrm((NA, 3, D, D), D ** -0.5),
        "a_w0": unif((NA, D), -6.0, -0.5),
        "a_w1": nrm((NA, D, DECAY_LORA), D ** -0.5),
        "a_w2": nrm((NA, DECAY_LORA, D), 0.5 * DECAY_LORA ** -0.5),
        "a_a0": nrm((NA, D), 0.1),
        "a_a1": nrm((NA, D, ICLR_LORA), D ** -0.5),
        "a_a2": nrm((NA, ICLR_LORA, D), 0.5 * ICLR_LORA ** -0.5),
        "a_g1": nrm((NA, D, GATE_LORA), D ** -0.5),
        "a_g2": nrm((NA, GATE_LORA, D), GATE_LORA ** -0.5),
        "a_k_k": 0.85 + nrm((NA, D), 0.05),
        "a_k_a": 1.0 + nrm((NA, D), 0.05),
        "a_r_k": nrm((NA, D), 0.1),
        "a_gn_g": 1.0 + nrm((NA, D), 0.05),
        "a_gn_b": nrm((NA, D), 0.02),
        "a_w_o": nrm((NA, D, D), DEEPNORM_BETA * D ** -0.5),
        "b_w_kv": nrm((D, 6 * G * dh), D ** -0.5),
        "b_cmp_pos": nrm((2, CMP_LEN, dh), 0.5),
        "b_phi_w1": nrm((2, CMP_LEN * dh, CMP_HIDDEN), (CMP_LEN * dh) ** -0.5),
        "b_phi_b1": nrm((2, CMP_HIDDEN), 0.02),
        "b_phi_w2": nrm((2, CMP_HIDDEN, dh), CMP_HIDDEN ** -0.5),
        "b_w_in": nrm((NB, D, N_HEADS * dh + N_BRANCH * N_HEADS), D ** -0.5),
        "b_w_o": nrm((NB, N_HEADS * dh, D), DEEPNORM_BETA * D ** -0.5),
        "f_w_gu": nrm((ND, D, 2 * D_FF), D ** -0.5),
        "f_w_down": nrm((ND, D_FF, D), DEEPNORM_BETA * D_FF ** -0.5),
        "m_w_router": nrm((NM, D, N_EXPERTS), D ** -0.5),
        "m_b_router": nrm((NM, N_EXPERTS), 0.01),
        "m_w_gu": nrm((NM, N_EXPERTS, D, 2 * D_FF_EXPERT), D ** -0.5),
        "m_w_down": nrm((NM, N_EXPERTS, D_FF_EXPERT, D), DEEPNORM_BETA * D_FF_EXPERT ** -0.5),
        "ln_g": 1.0 + nrm((DEPTH, 2, D), 0.05),
        "ln_b": nrm((DEPTH, 2, D), 0.02),
        "ple_w": nrm((DEPTH, PLE_DIM, D), PLE_DIM ** -0.5),
        "ple_gate_w": nrm((DEPTH, D, D), D ** -0.5),
        "ple_gate_b": nrm((DEPTH, D), 0.02),
    }


def reference(x, p, a_mu, a_w_rkv, a_w0, a_w1, a_w2, a_a0, a_a1, a_a2, a_g1, a_g2, a_k_k, a_k_a,
              a_r_k, a_gn_g, a_gn_b, a_w_o, b_w_kv, b_cmp_pos, b_phi_w1, b_phi_b1, b_phi_w2,
              b_w_in, b_w_o, f_w_gu, f_w_down, m_w_router, m_b_router, m_w_gu, m_w_down,
              ln_g, ln_b, ple_w, ple_gate_w, ple_gate_b):
    shared = None
    for i in range(DEPTH):
        if i < N_A_LAYERS:
            j = i
            mix = rwkv7_time_mix(x, a_mu[j], a_w_rkv[j], a_w0[j], a_w1[j], a_w2[j], a_a0[j],
                                 a_a1[j], a_a2[j], a_g1[j], a_g2[j], a_k_k[j], a_k_a[j],
                                 a_r_k[j], a_gn_g[j], a_gn_b[j], a_w_o[j])
        else:
            if shared is None:
                shared = nsa_shared_kv(x, b_w_kv, b_cmp_pos, b_phi_w1, b_phi_b1, b_phi_w2)
            j = i - N_A_LAYERS
            mix = nsa_attention(x, shared, b_w_in[j], b_w_o[j])
        x = layer_norm(DEEPNORM_ALPHA * x + mix, ln_g[i, 0], ln_b[i, 0])
        if i % 2 == 0:
            ffn = swiglu(x, f_w_gu[i // 2], f_w_down[i // 2])
        else:
            ffn = moe_swiglu(x, m_w_router[i // 2], m_b_router[i // 2], m_w_gu[i // 2], m_w_down[i // 2])
        x = layer_norm(DEEPNORM_ALPHA * x + ffn, ln_g[i, 1], ln_b[i, 1])
        x = x + (p[i] @ ple_w[i]) * jax.nn.sigmoid(x @ ple_gate_w[i] + ple_gate_b[i])
    return x
```

```cpp
#include <hip/hip_runtime.h>
#include <cstdio>
#include <cstdint>
namespace orc {
constexpr int T = 2048, D = 1024, NB = 16, PLE = 256;
constexpr int DFF = 2816, DFE = 1408, NE = 8;
constexpr int NCMP = 127;
constexpr float ALPHA = 1.4142135623730951f;
constexpr float LN_EPS = 1e-5f, GN_EPS = 64e-5f;

__device__ __forceinline__ float wsum(float v) {
#pragma unroll
    for (int o = 1; o < 64; o <<= 1) v += __shfl_xor(v, o);
    return v;
}
__device__ __forceinline__ float wmax(float v) {
#pragma unroll
    for (int o = 1; o < 64; o <<= 1) v = fmaxf(v, __shfl_xor(v, o));
    return v;
}
__device__ __forceinline__ float sigmoidf_(float x) { return 1.f / (1.f + expf(-x)); }
__device__ __forceinline__ float softplusf_(float z) { return fmaxf(z, 0.f) + log1pf(expf(-fabsf(z))); }
__device__ __forceinline__ float gelu_tanh(float x) { return 0.5f * x * (1.f + tanhf(0.7978845608028654f * (x + 0.044715f * x * x * x))); }

struct AF_plain { const float* A; long lda; __device__ float operator()(int m, int k) const { return A[(long)m * lda + k]; } };
struct AF_mix { const float* x; const float* mu;
    __device__ float operator()(int m, int k) const { float xv = x[(long)m * D + k]; float pv = m > 0 ? x[(long)(m - 1) * D + k] : 0.f; return xv + (pv - xv) * mu[k]; } };
struct AF_cmp { const float* kv; const float* pos; long j;
    __device__ float operator()(int m, int k) const { int g = m / NCMP, n = m % NCMP, l = k >> 6, d = k & 63; return kv[(long)(n * 16 + l) * 1536 + j * 256 + g * 64 + d] + pos[j * 2048 + l * 64 + d]; } };
struct EF_act { float* C; long ldc; const float* bias; long mode;
    __device__ void operator()(int m, int n, float acc) const { float v = acc + (bias ? bias[n] : 0.f);
        if (mode == 1) v = tanhf(v); else if (mode == 2) v = sigmoidf_(v); else if (mode == 3) v = gelu_tanh(v); C[(long)m * ldc + n] = v; } };
struct EF_decay { float* C; const float* w0;
    __device__ void operator()(int m, int n, float acc) const { float z = w0[n] + acc; float w = -softplusf_(-z) - 0.5f; C[(long)m * D + n] = expf(-expf(w)); } };
struct EF_resid { float* C; const float* res;
    __device__ void operator()(int m, int n, float acc) const { C[(long)m * D + n] = ALPHA * res[(long)m * D + n] + acc; } };
struct EF_ple { float* out; const float* x2; const float* pp; const float* gb;
    __device__ void operator()(int m, int n, float acc) const { long i = (long)m * D + n; out[i] = x2[i] + pp[i] * sigmoidf_(acc + gb[n]); } };
struct EF_moe { float* accb; const float* wt; long e;
    __device__ void operator()(int m, int n, float acc) const { float w = wt[m * 8 + e]; if (w != 0.f) accb[(long)m * D + n] += w * acc; } };

template <class AF, class EF>
__global__ void __launch_bounds__(256) o_gemm(AF af, const float* __restrict__ Bm, long ldb, EF ef, long Mr, long Nc, long K) {
    __shared__ float As[16][65];
    __shared__ float Bs[16][65];
    const int tx = threadIdx.x & 15, ty = threadIdx.x >> 4;
    const int m0 = blockIdx.y * 64, n0 = blockIdx.x * 64;
    float acc[4][4];
#pragma unroll
    for (int i = 0; i < 4; ++i)
#pragma unroll
        for (int j = 0; j < 4; ++j) acc[i][j] = 0.f;
    for (int k0 = 0; k0 < K; k0 += 16) {
#pragma unroll
        for (int i = 0; i < 4; ++i) { int idx = threadIdx.x + i * 256; int kk = idx & 15, mm = idx >> 4; int m = m0 + mm; As[kk][mm] = (m < Mr) ? af(m, k0 + kk) : 0.f; }
#pragma unroll
        for (int i = 0; i < 4; ++i) { int idx = threadIdx.x + i * 256; int nn = idx & 63, kk = idx >> 6; int n = n0 + nn; Bs[kk][nn] = (n < Nc) ? Bm[(long)(k0 + kk) * ldb + n] : 0.f; }
        __syncthreads();
#pragma unroll
        for (int kk = 0; kk < 16; ++kk) {
            float a[4], b[4];
#pragma unroll
            for (int i = 0; i < 4; ++i) { a[i] = As[kk][ty * 4 + i]; b[i] = Bs[kk][tx * 4 + i]; }
#pragma unroll
            for (int i = 0; i < 4; ++i)
#pragma unroll
                for (int j = 0; j < 4; ++j) acc[i][j] = fmaf(a[i], b[j], acc[i][j]);
        }
        __syncthreads();
    }
#pragma unroll
    for (int i = 0; i < 4; ++i)
#pragma unroll
        for (int j = 0; j < 4; ++j) { int m = m0 + ty * 4 + i, n = n0 + tx * 4 + j; if (m < Mr && n < Nc) ef(m, n, acc[i][j]); }
}
template <class AF, class EF> static void ogemm(hipStream_t s, AF af, const float* Bm, long ldb, EF ef, long Mr, long Nc, long K) {
    dim3 grid((unsigned)((Nc + 63) / 64), (unsigned)((Mr + 63) / 64));
    o_gemm<AF, EF><<<grid, 256, 0, s>>>(af, Bm, ldb, ef, Mr, Nc, K);
}

__global__ void o_glu(const float* gu, float* h, long F, long n) { long i = (long)blockIdx.x * blockDim.x + threadIdx.x; if (i >= n) return; long t = i / F, j = i % F; float g = gu[t * 2 * F + j], u = gu[t * 2 * F + F + j]; h[i] = g / (1.f + expf(-g)) * u; }
__global__ void o_zero(float* p, long n) { long i = (long)blockIdx.x * blockDim.x + threadIdx.x; if (i < n) p[i] = 0.f; }
__global__ void o_axpy(const float* x, const float* a, float* y, long n) { long i = (long)blockIdx.x * blockDim.x + threadIdx.x; if (i < n) y[i] = ALPHA * x[i] + a[i]; }
__global__ void __launch_bounds__(256) o_ln(const float* y, const float* g, const float* b, float* out, long rows) {
    long row = (long)blockIdx.x * 4 + (threadIdx.x >> 6); int lane = threadIdx.x & 63; if (row >= rows) return;
    const float* yr = y + row * D; float v[16]; float s = 0.f;
#pragma unroll
    for (int i = 0; i < 16; ++i) { v[i] = yr[lane + 64 * i]; s += v[i]; }
    float mean = wsum(s) * (1.f / D); float q = 0.f;
#pragma unroll
    for (int i = 0; i < 16; ++i) { float d = v[i] - mean; q += d * d; }
    float rstd = rsqrtf(wsum(q) * (1.f / D) + LN_EPS);
#pragma unroll
    for (int i = 0; i < 16; ++i) { int c = lane + 64 * i; out[row * D + c] = (v[i] - mean) * rstd * g[c] + b[c]; }
}
__global__ void __launch_bounds__(256) o_rwkv_prep(const float* k, const float* a, const float* k_k, const float* k_a, float* kk, float* kmod) {
    long th = (long)blockIdx.x * 4 + (threadIdx.x >> 6); int lane = threadIdx.x & 63; int h = th & 15; long t = th >> 4; long i = t * D + h * 64 + lane; int c = h * 64 + lane;
    float kv = k[i], av = a[i]; float x = kv * k_k[c]; float ss = wsum(x * x); kk[i] = x / fmaxf(sqrtf(ss), 1e-12f); kmod[i] = kv * (1.f + (av - 1.f) * k_a[c]);
}
__global__ void __launch_bounds__(64) o_scan(const float* r, const float* kmod, const float* v, const float* dec, const float* kk, const float* a, float* out) {
    const int h = blockIdx.x, i = threadIdx.x;
    __shared__ float sr[32][64], sk[32][64], sd[32][64], skk[32][64], sb[32][64], sv[32][64];
    float S[64];
#pragma unroll
    for (int j = 0; j < 64; ++j) S[j] = 0.f;
    for (int t0 = 0; t0 < T; t0 += 32) {
        __syncthreads();
        for (int s = 0; s < 32; ++s) { long g = (long)(t0 + s) * D + h * 64 + i; sr[s][i] = r[g]; sk[s][i] = kmod[g]; sd[s][i] = dec[g]; float kkv = kk[g]; skk[s][i] = kkv; sb[s][i] = kkv * a[g]; sv[s][i] = v[g]; }
        __syncthreads();
        for (int s = 0; s < 32; ++s) {
            float dot = 0.f;
#pragma unroll
            for (int j = 0; j < 64; ++j) dot = fmaf(S[j], skk[s][j], dot);
            float vi = sv[s][i]; float o = 0.f;
#pragma unroll
            for (int j = 0; j < 64; ++j) { float sn = S[j] * sd[s][j] - dot * sb[s][j] + vi * sk[s][j]; S[j] = sn; o = fmaf(sn, sr[s][j], o); }
            out[(long)(t0 + s) * D + h * 64 + i] = o;
        }
    }
}
__global__ void __launch_bounds__(256) o_gn(const float* so, const float* r, const float* kmod, const float* v, const float* g, const float* r_k, const float* gn_g, const float* gn_b, float* og) {
    long th = (long)blockIdx.x * 4 + (threadIdx.x >> 6); int lane = threadIdx.x & 63; int h = th & 15; long t = th >> 4; long i = t * D + h * 64 + lane; int c = h * 64 + lane;
    float o = so[i]; float mu = wsum(o) * (1.f / 64.f); float d = o - mu; float var = wsum(d * d) * (1.f / 64.f);
    float y = d * rsqrtf(var + GN_EPS) * gn_g[c] + gn_b[c];
    float bonus = wsum(r[i] * kmod[i] * r_k[c]) * v[i];
    og[i] = (y + bonus) * g[i];
}
__global__ void o_cs(float* cs) { int i = blockIdx.x * blockDim.x + threadIdx.x; if (i >= T * 32) return; int t = i >> 5, j = i & 31;
    float inv = powf(10000.f, -(float)j / 32.f); float ang = (float)t * inv; double a = (double)ang; double n = rint(a * 0.15915494309189535); double rr = a - n * 6.283185307179586476925; float rf = (float)rr; cs[2 * i] = cosf(rf); cs[2 * i + 1] = sinf(rf); }
__global__ void o_rope_kv(float* kv, const float* cs) { int i = blockIdx.x * blockDim.x + threadIdx.x; if (i >= T * 2 * 4 * 32) return; int d = i & 31, g = (i >> 5) & 3, jj = (i >> 7) & 1, t = i >> 8; int j = jj ? 4 : 2;
    float* p = kv + (long)t * 1536 + j * 256 + g * 64; float c = cs[(t * 32 + d) * 2], s = cs[(t * 32 + d) * 2 + 1]; float x1 = p[d], x2 = p[d + 32]; p[d] = x1 * c - x2 * s; p[d + 32] = x2 * c + x1 * s; }
__global__ void __launch_bounds__(256) o_attn(const float* proj, const float* kv, const float* kcmp, const float* vcmp, const float* cs, float* att) {
    const int t = blockIdx.x >> 2, g = blockIdx.x & 3, r = threadIdx.x >> 6, d = threadIdx.x & 63;
    __shared__ float pc[4][128]; __shared__ float impv[32]; __shared__ int sel[8];
    const float scale = 0.125f;
    const float q = proj[(long)t * 1072 + (g * 4 + r) * 64 + d];
    const float qo = __shfl_xor(q, 32);
    const int dd = d & 31; const float c = cs[(t * 32 + dd) * 2], s = cs[(t * 32 + dd) * 2 + 1];
    const float qr = (d < 32) ? q * c - qo * s : q * c + qo * s;
    const float g0 = sigmoidf_(proj[(long)t * 1072 + 1024 + (g * 4 + r) * 3 + 0]), g1 = sigmoidf_(proj[(long)t * 1072 + 1024 + (g * 4 + r) * 3 + 1]), g2 = sigmoidf_(proj[(long)t * 1072 + 1024 + (g * 4 + r) * 3 + 2]);
    for (int n = 0; n < NCMP; ++n) { float dot = wsum(q * kcmp[(long)(g * NCMP + n) * 64 + d]) * scale; if (d == 0) pc[r][n] = dot; }
    __syncthreads();
    {
        float s0 = (d < NCMP && d * 16 + 31 <= t) ? pc[r][d] : -1e30f; float s1 = (d + 64 < NCMP && (d + 64) * 16 + 31 <= t) ? pc[r][d + 64] : -1e30f;
        bool v0 = (d < NCMP && d * 16 + 31 <= t), v1 = (d + 64 < NCMP && (d + 64) * 16 + 31 <= t);
        float m = wmax(fmaxf(s0, s1)); float e0 = v0 ? expf(s0 - m) : 0.f, e1 = v1 ? expf(s1 - m) : 0.f; float l = wsum(e0 + e1);
        float p0 = l > 0.f ? e0 / l : 0.f, p1 = l > 0.f ? e1 / l : 0.f;
        __syncthreads();
        pc[r][d] = p0; pc[r][d + 64] = p1;
    }
    __syncthreads();
    float ocmp = 0.f;
    for (int n = 0; n < NCMP; ++n) ocmp = fmaf(pc[r][n], vcmp[(long)(g * NCMP + n) * 64 + d], ocmp);
    if (threadIdx.x < 32) { int sb = threadIdx.x; float im = 0.f;
        for (int rr = 0; rr < 4; ++rr) for (int n = 4 * sb - 1; n <= 4 * sb + 3; ++n) if (n >= 0 && n < NCMP) im += pc[rr][n];
        int cur = t >> 6; bool forced = (sb == 0) || (sb == cur) || (sb == cur - 1); bool causal = sb * 64 <= t;
        impv[sb] = forced ? 1e4f : (causal ? im : -1e30f); }
    __syncthreads();
    if (threadIdx.x == 0) { unsigned used = 0; for (int k = 0; k < 8; ++k) { int best = -1; float bv = 0.f; for (int sb = 0; sb < 32; ++sb) if (!((used >> sb) & 1u)) { if (best < 0 || impv[sb] > bv) { best = sb; bv = impv[sb]; } } used |= 1u << best; sel[k] = best; } }
    __syncthreads();
    float m = -1e30f, l = 0.f, acc = 0.f;
    for (int k = 0; k < 8; ++k) { int sb = sel[k]; for (int i = 0; i < 64; ++i) { int key = sb * 64 + i; if (key > t) break;
            float sc = wsum(qr * kv[(long)key * 1536 + 2 * 256 + g * 64 + d]) * scale; float mn = fmaxf(m, sc); float corr = expf(m - mn), pe = expf(sc - mn);
            l = l * corr + pe; acc = acc * corr + pe * kv[(long)key * 1536 + 3 * 256 + g * 64 + d]; m = mn; } }
    const float oslc = l > 0.f ? acc / l : 0.f;
    m = -1e30f; l = 0.f; acc = 0.f;
    for (int key = (t - 511 > 0 ? t - 511 : 0); key <= t; ++key) {
        float sc = wsum(qr * kv[(long)key * 1536 + 4 * 256 + g * 64 + d]) * scale; float mn = fmaxf(m, sc); float corr = expf(m - mn), pe = expf(sc - mn);
        l = l * corr + pe; acc = acc * corr + pe * kv[(long)key * 1536 + 5 * 256 + g * 64 + d]; m = mn; }
    const float owin = l > 0.f ? acc / l : 0.f;
    att[(long)t * D + (g * 4 + r) * 64 + d] = g0 * ocmp + g1 * oslc + g2 * owin;
}
__global__ void __launch_bounds__(256) o_router(const float* x, const float* wr, const float* br, float* wt) {
    long t = (long)blockIdx.x * 4 + (threadIdx.x >> 6); int lane = threadIdx.x & 63; float lg[8];
#pragma unroll
    for (int e = 0; e < 8; ++e) lg[e] = 0.f;
    for (int k = lane; k < D; k += 64) { float xv = x[t * D + k];
#pragma unroll
        for (int e = 0; e < 8; ++e) lg[e] = fmaf(xv, wr[k * 8 + e], lg[e]); }
#pragma unroll
    for (int e = 0; e < 8; ++e) lg[e] = wsum(lg[e]) + br[e];
    int e1 = 0; float v1 = lg[0];
#pragma unroll
    for (int e = 1; e < 8; ++e) if (lg[e] > v1) { v1 = lg[e]; e1 = e; }
    int e2 = -1; float v2 = 0.f;
#pragma unroll
    for (int e = 0; e < 8; ++e) if (e != e1 && (e2 < 0 || lg[e] > v2)) { v2 = lg[e]; e2 = e; }
    float p2 = expf(v2 - v1); float w1 = 1.f / (1.f + p2), w2 = p2 / (1.f + p2);
    if (lane < 8) wt[t * 8 + lane] = (lane == e1) ? w1 : ((lane == e2) ? w2 : 0.f);
}

struct In {
    const float *x, *p, *a_mu, *a_w_rkv, *a_w0, *a_w1, *a_w2, *a_a0, *a_a1, *a_a2, *a_g1, *a_g2, *a_k_k, *a_k_a, *a_r_k, *a_gn_g, *a_gn_b, *a_w_o,
        *b_w_kv, *b_cmp_pos, *b_phi_w1, *b_phi_b1, *b_phi_w2, *b_w_in, *b_w_o, *f_w_gu, *f_w_down, *m_w_router, *m_b_router, *m_w_gu, *m_w_down,
        *ln_g, *ln_b, *ple_w, *ple_gate_w, *ple_gate_b;
};
static In make_in(void* const* d) { In I; const float** f = (const float**)&I; for (int i = 0; i < 36; ++i) f[i] = (const float*)d[i]; return I; }

static void run_batch(hipStream_t s, const In& I, int b, float* out_b, float* ws) {
    const long TD = (long)T * D; long off = 0; auto take = [&](long n) { float* p = ws + off; off += (n + 63) / 64 * 64; return p; };
    const float* xb = I.x + (long)b * TD;
    float *r = take(TD), *k = take(TD), *v = take(TD), *dec = take(TD), *a = take(TD), *g = take(TD), *kk = take(TD), *kmod = take(TD), *so = take(TD), *og = take(TD);
    float *h64a = take((long)T * 64), *h64b = take((long)T * 64), *h128 = take((long)T * 128);
    float *y = take(TD), *x1 = take(TD), *x2 = take(TD), *x3 = take(TD), *x4 = take(TD), *x5 = take(TD), *pp = take(TD), *macc = take(TD), *att = take(TD);
    float *gu = take((long)T * 2 * DFF), *hh = take((long)T * DFF);
    float *kvb = take((long)T * 1536), *proj = take((long)T * 1072), *hc = take((long)512 * 256), *kcmp = take(512 * 64), *vcmp = take(512 * 64), *cs = take((long)T * 64), *wt = take((long)T * 8);
    const int EB = 256; auto nb = [&](long n) { return (unsigned)((n + EB - 1) / EB); };
    ogemm(s, AF_mix{xb, I.a_mu + 0 * D}, I.a_w_rkv + 0L * D * D, D, EF_act{r, D, nullptr, 0}, T, D, D);
    ogemm(s, AF_mix{xb, I.a_mu + 1 * D}, I.a_w_rkv + 1L * D * D, D, EF_act{k, D, nullptr, 0}, T, D, D);
    ogemm(s, AF_mix{xb, I.a_mu + 2 * D}, I.a_w_rkv + 2L * D * D, D, EF_act{v, D, nullptr, 0}, T, D, D);
    ogemm(s, AF_mix{xb, I.a_mu + 3 * D}, I.a_w1, 64, EF_act{h64a, 64, nullptr, 1}, T, 64, D);
    ogemm(s, AF_plain{h64a, 64}, I.a_w2, D, EF_decay{dec, I.a_w0}, T, D, 64);
    ogemm(s, AF_mix{xb, I.a_mu + 4 * D}, I.a_a1, 64, EF_act{h64b, 64, nullptr, 0}, T, 64, D);
    ogemm(s, AF_plain{h64b, 64}, I.a_a2, D, EF_act{a, D, I.a_a0, 2}, T, D, 64);
    ogemm(s, AF_mix{xb, I.a_mu + 5 * D}, I.a_g1, 128, EF_act{h128, 128, nullptr, 2}, T, 128, D);
    ogemm(s, AF_plain{h128, 128}, I.a_g2, D, EF_act{g, D, nullptr, 0}, T, D, 128);
    o_rwkv_prep<<<T * 16 / 4, 256, 0, s>>>(k, a, I.a_k_k, I.a_k_a, kk, kmod);
    o_scan<<<16, 64, 0, s>>>(r, kmod, v, dec, kk, a, so);
    o_gn<<<T * 16 / 4, 256, 0, s>>>(so, r, kmod, v, g, I.a_r_k, I.a_gn_g, I.a_gn_b, og);
    ogemm(s, AF_plain{og, D}, I.a_w_o, D, EF_resid{y, xb}, T, D, D);
    o_ln<<<T / 4, 256, 0, s>>>(y, I.ln_g + 0 * D, I.ln_b + 0 * D, x1, T);
    ogemm(s, AF_plain{x1, D}, I.f_w_gu, 2 * DFF, EF_act{gu, 2 * DFF, nullptr, 0}, T, 2 * DFF, D);
    o_glu<<<nb((long)T * DFF), EB, 0, s>>>(gu, hh, DFF, (long)T * DFF);
    ogemm(s, AF_plain{hh, DFF}, I.f_w_down, D, EF_resid{y, x1}, T, D, DFF);
    o_ln<<<T / 4, 256, 0, s>>>(y, I.ln_g + 1 * D, I.ln_b + 1 * D, x2, T);
    ogemm(s, AF_plain{I.p + ((long)0 * NB + b) * T * PLE, PLE}, I.ple_w, D, EF_act{pp, D, nullptr, 0}, T, D, PLE);
    ogemm(s, AF_plain{x2, D}, I.ple_gate_w, D, EF_ple{x3, x2, pp, I.ple_gate_b}, T, D, D);
    o_cs<<<T * 32 / 256, 256, 0, s>>>(cs);
    ogemm(s, AF_plain{x3, D}, I.b_w_kv, 1536, EF_act{kvb, 1536, nullptr, 0}, T, 1536, D);
    for (int j = 0; j < 2; ++j) {
        ogemm(s, AF_cmp{kvb, I.b_cmp_pos, j}, I.b_phi_w1 + (long)j * 2048 * 256, 256, EF_act{hc, 256, I.b_phi_b1 + j * 256, 3}, 4 * NCMP, 256, 2048);
        ogemm(s, AF_plain{hc, 256}, I.b_phi_w2 + (long)j * 256 * 64, 64, EF_act{j ? vcmp : kcmp, 64, nullptr, 0}, 4 * NCMP, 64, 256);
    }
    o_rope_kv<<<T * 256 / 256, 256, 0, s>>>(kvb, cs);
    ogemm(s, AF_plain{x3, D}, I.b_w_in, 1072, EF_act{proj, 1072, nullptr, 0}, T, 1072, D);
    o_attn<<<T * 4, 256, 0, s>>>(proj, kvb, kcmp, vcmp, cs, att);
    ogemm(s, AF_plain{att, D}, I.b_w_o, D, EF_resid{y, x3}, T, D, D);
    o_ln<<<T / 4, 256, 0, s>>>(y, I.ln_g + 2 * D, I.ln_b + 2 * D, x4, T);
    o_router<<<T / 4, 256, 0, s>>>(x4, I.m_w_router, I.m_b_router, wt);
    o_zero<<<nb(TD), EB, 0, s>>>(macc, TD);
    for (int e = 0; e < NE; ++e) {
        ogemm(s, AF_plain{x4, D}, I.m_w_gu + (long)e * D * 2 * DFE, 2 * DFE, EF_act{gu, 2 * DFE, nullptr, 0}, T, 2 * DFE, D);
        o_glu<<<nb((long)T * DFE), EB, 0, s>>>(gu, hh, DFE, (long)T * DFE);
        ogemm(s, AF_plain{hh, DFE}, I.m_w_down + (long)e * DFE * D, D, EF_moe{macc, wt, e}, T, D, DFE);
    }
    o_axpy<<<nb(TD), EB, 0, s>>>(x4, macc, y, TD);
    o_ln<<<T / 4, 256, 0, s>>>(y, I.ln_g + 3 * D, I.ln_b + 3 * D, x5, T);
    ogemm(s, AF_plain{I.p + ((long)1 * NB + b) * T * PLE, PLE}, I.ple_w + (long)PLE * D, D, EF_act{pp, D, nullptr, 0}, T, D, PLE);
    ogemm(s, AF_plain{x5, D}, I.ple_gate_w + (long)D * D, D, EF_ple{out_b, x5, pp, I.ple_gate_b + D}, T, D, D);
}
}
extern "C" void kernel_launch(void* const* d_in, const int* in_sizes, int n_in, void* d_out, int out_size, void* d_ws, size_t ws_size, hipStream_t stream) {
    orc::In I = orc::make_in(d_in);
    for (int b = 0; b < orc::NB; ++b) orc::run_batch(stream, I, b, (float*)d_out + (long)b * orc::T * orc::D, (float*)d_ws);
}
```

```cpp
#include <hip/hip_runtime.h>
#include <hip/hip_cooperative_groups.h>
#include <cstdio>
#include <cstdint>
namespace fx {
#define LAS __attribute__((address_space(3)))
typedef unsigned short bf16_t;
typedef short bf16x8 __attribute__((ext_vector_type(8)));
typedef short bf16x4 __attribute__((ext_vector_type(4)));
typedef float f32x4 __attribute__((ext_vector_type(4)));
typedef float f32x2 __attribute__((ext_vector_type(2)));
typedef float f32x16 __attribute__((ext_vector_type(16)));
typedef unsigned u32x4 __attribute__((ext_vector_type(4)));
typedef unsigned u32x2 __attribute__((ext_vector_type(2)));

constexpr int D = 1024, NB = 16, T = 2048, M = NB * T, PLE = 256;
constexpr int DFF = 2816, DFE = 1408, NE = 8;
constexpr int XBT = T + 1;
constexpr int MOE_ROWS_MAX = 264 * 256;
constexpr float ALPHA = 1.4142135623730951f, LN_EPS = 1e-5f, GN_EPS = 64e-5f;
constexpr float LOG2E = 1.4426950408889634f;

constexpr size_t MiB = 1u << 20;
constexpr size_t W_RKV = 0;
constexpr size_t W_L1 = W_RKV + 3 * 2 * MiB;
constexpr size_t W_L2 = W_L1 + 1 * MiB;
constexpr size_t W_AO = W_L2 + 3 * MiB / 2;
constexpr size_t W_FGU = W_AO + 2 * MiB;
constexpr size_t W_FDN = W_FGU + 11 * MiB;
constexpr size_t W_PLE = W_FDN + 11 * MiB / 2;
constexpr size_t W_GATE = W_PLE + 1 * MiB;
constexpr size_t W_NSA = W_GATE + 4 * MiB;
constexpr size_t W_VT = W_NSA + 9 * MiB / 2;
constexpr size_t W_PHI = W_VT + 1 * MiB;
constexpr size_t W_BO = W_PHI + 2 * MiB;
constexpr size_t W_MGU = W_BO + 2 * MiB;
constexpr size_t W_MDN = W_MGU + 44 * MiB;
constexpr size_t W_END = 108 * MiB;
static_assert(W_MDN + 22 * MiB <= W_END, "weights");
constexpr size_t X_CTL = W_END;
constexpr size_t X_CS = X_CTL + 64 * 1024;
constexpr size_t X_CB = X_CS + 512 * 1024;
constexpr size_t X_TOKE = X_CB + 4096;
constexpr size_t X_TOKW = X_TOKE + (size_t)M * 4;
constexpr size_t X_RSRC = X_TOKW + (size_t)M * 8;
constexpr size_t X_RDST = X_RSRC + (size_t)MOE_ROWS_MAX * 4;
constexpr size_t X_RW = X_RDST + (size_t)MOE_ROWS_MAX * 4;
constexpr size_t X_END = X_RW + (size_t)MOE_ROWS_MAX * 4;
static_assert(X_END <= W_END + 12 * MiB, "misc");
constexpr size_t ACT = W_END + 12 * MiB;
constexpr size_t A_MIX = ACT + 0 * MiB;
constexpr size_t O_XB = 0, O_HL = 66 * MiB;
constexpr size_t A_RKV = ACT + 192 * MiB;
constexpr size_t A_WAG = ACT + 0 * MiB;
constexpr size_t A_X1B = ACT + 0 * MiB, A_H = ACT + 64 * MiB, A_X2B = ACT + 0 * MiB, A_PB0 = ACT + 240 * MiB, A_PP0 = ACT + 64 * MiB, A_X3B = ACT + 128 * MiB;
constexpr size_t A_KC = ACT + 0 * MiB, A_VC = ACT + 17 * MiB, A_KS = ACT + 34 * MiB, A_KW = ACT + 50 * MiB, A_VTS = ACT + 66 * MiB  , A_GATES = ACT + 98 * MiB;
constexpr size_t A_HCK = ACT + 106 * MiB, A_HCV = ACT + 110 * MiB, A_KCMP = ACT + 114 * MiB, A_VCMPT = ACT + 115 * MiB;
constexpr size_t A_Q = ACT + 192 * MiB, A_QR = ACT + 256 * MiB, A_ATT = ACT + 128 * MiB;
constexpr size_t A_X4B = ACT + 320 * MiB, A_XS = ACT + 0 * MiB, A_HM = ACT + 132 * MiB, A_YS2 = ACT + 0 * MiB, A_X5B = ACT + 320 * MiB, A_PB1 = ACT + 132 * MiB, A_PP1 = ACT + 192 * MiB;
constexpr size_t WS_NEED = ACT + 385 * MiB;
constexpr int CW_CNT = 0;
constexpr int CW_CUR = 16;
constexpr int CW_DBG = 64;

__device__ __forceinline__ unsigned cvt_pk_bf16(float lo, float hi) { unsigned r; asm volatile("v_cvt_pk_bf16_f32 %0, %1, %2" : "=v"(r) : "v"(lo), "v"(hi)); return r; }
__device__ __forceinline__ float bf2f(unsigned short b) { return __uint_as_float(((unsigned)b) << 16); }
__device__ __forceinline__ float bflo(unsigned w) { return __uint_as_float(w << 16); }
__device__ __forceinline__ float bfhi(unsigned w) { return __uint_as_float(w & 0xffff0000u); }
__device__ __forceinline__ float sigmoid_f(float x) { return 1.f / (1.f + __expf(-x)); }
__device__ __forceinline__ float wave_sum(float v) {
#pragma unroll
    for (int o = 1; o < 64; o <<= 1) v += __shfl_xor(v, o);
    return v;
}
__device__ __forceinline__ float dpp_xor1(float v) { return __builtin_bit_cast(float, __builtin_amdgcn_update_dpp(0, __builtin_bit_cast(int, v), 0xB1, 0xF, 0xF, true)); }
__device__ __forceinline__ float dpp_xor2(float v) { return __builtin_bit_cast(float, __builtin_amdgcn_update_dpp(0, __builtin_bit_cast(int, v), 0x4E, 0xF, 0xF, true)); }
__device__ __forceinline__ float dpp_hmir(float v) { return __builtin_bit_cast(float, __builtin_amdgcn_update_dpp(0, __builtin_bit_cast(int, v), 0x141, 0xF, 0xF, true)); }
__device__ __forceinline__ float sum8(float v) { v += dpp_xor1(v); v += dpp_xor2(v); v += dpp_hmir(v); return v; }

constexpr int BM = 256, BK = 64, HALF = 128, HTB = HALF * BK * 2, STAGE_BYTES = 8 * HTB, NXCD = 8, WGM = 8;
__host__ __device__ __forceinline__ int lds_byte(int r, int c) { const int st = (r >> 4) * 2 + (c >> 5), rr = r & 15, cc = c & 31, ob = rr * 64 + cc * 2; return st * 1024 + (ob ^ (((ob >> 9) & 1) << 5)); }
__host__ __device__ __forceinline__ void stage_rc(int b, int& R, int& C) { const int st = b / 1024, sb = b % 1024, swz = sb ^ (((sb >> 9) & 1) << 5); R = (st >> 1) * 16 + swz / 64; C = (st & 1) * 32 + (swz % 64) / 2; }
__host__ __device__ __forceinline__ int perm32(int rho) { const int n = rho >> 4, i = rho & 15; return 8 * (i >> 2) + 4 * n + (i & 3); }

struct Unit {
    const char* A;
    const char* B;
    int nt;
    int ksplit;
    long wrapA, wrapB;
    int pm, pn, job;
};
__device__ __forceinline__ const char* ktA(const Unit& u, int t) { return u.A + (long)t * (BK * 2) + (t >= u.ksplit ? u.wrapA : 0L); }
__device__ __forceinline__ const char* ktB(const Unit& u, int t) { return u.B + (long)t * (BK * 2) + (t >= u.ksplit ? u.wrapB : 0L); }

struct JobD { const char* A; const char* B; long tileA, tileB; int nM, nN, nt, ksplit; long wrapA, wrapB, batchA, batchB; int shA, shB; };
struct StaticSched {
    JobD j0, j1; int nj; int G, c; int lda, ldb;
    __device__ __forceinline__ bool next(int i, Unit& u) const {
        long L = (long)i * G + c; const long n0 = (long)j0.nM * j0.nN; const bool second = (nj > 1) && (L >= n0);
        if (second) L -= n0;
        const int nM = second ? j1.nM : j0.nM, nN = second ? j1.nN : j0.nN;
        const int nwg = nM * nN; if (L >= nwg) return false;
        int wgid = (int)L; { const int qq = nwg / NXCD, r = nwg % NXCD, xcd = wgid % NXCD, off = wgid / NXCD; wgid = (xcd < r ? xcd * (qq + 1) : r * (qq + 1) + (xcd - r) * qq) + off; }
        const int nig = WGM * nN, gid = wgid / nig, fm = gid * WGM, gsz = (nM - fm) < WGM ? (nM - fm) : WGM;
        u.pm = fm + ((wgid % nig) % gsz); u.pn = (wgid % nig) / gsz; u.job = second ? 1 : 0;
        if (second) { u.A = j1.A + (long)u.pm * j1.tileA + (long)(u.pm >> j1.shA) * j1.batchA; u.B = j1.B + (long)u.pn * j1.tileB + (long)(u.pm >> j1.shB) * j1.batchB; u.nt = j1.nt; u.ksplit = j1.ksplit; u.wrapA = j1.wrapA; u.wrapB = j1.wrapB; }
        else { u.A = j0.A + (long)u.pm * j0.tileA + (long)(u.pm >> j0.shA) * j0.batchA; u.B = j0.B + (long)u.pn * j0.tileB + (long)(u.pm >> j0.shB) * j0.batchB; u.nt = j0.nt; u.ksplit = j0.ksplit; u.wrapA = j0.wrapA; u.wrapB = j0.wrapB; }
        return true;
    }
};

template <class Epi, class Sched>
__device__ __forceinline__ void gemm_phase(LAS unsigned char* lds, const Sched& S, const Epi& E) {
    const int tid = threadIdx.x, wid = __builtin_amdgcn_readfirstlane(tid >> 6), lane = tid & 63, wr = wid >> 2, wc = wid & 3, fr = lane & 15, fq = lane >> 4;
    unsigned voffA[2], voffB[2];
#pragma unroll
    for (int i = 0; i < 2; ++i) { int R, C; stage_rc(tid * 16 + i * 8192, R, C); const int Rb = Epi::PERM ? ((R & ~31) + perm32(R & 31)) : R;
        voffA[i] = (unsigned)(R * S.lda + C * 2); voffB[i] = (unsigned)(Rb * S.ldb + C * 2); }
    const size_t hstepA = (size_t)HALF * S.lda, hstepB = (size_t)HALF * S.ldb;
    const unsigned ldsw = (unsigned)wid * 1024u;
    const int aoff = lds_byte(wr * 64 + fr, fq * 8), boff = lds_byte(wc * 32 + fr, fq * 8);
#define PG8_SA(b, h) (((b) * 2 + (h)) * HTB)
#define PG8_SB(b, h) ((4 + (b) * 2 + (h)) * HTB)
#define PG8_STAGE(bufoff, gbase, voff) do { _Pragma("unroll") for (int _i = 0; _i < 2; ++_i) \
        __builtin_amdgcn_global_load_lds((const unsigned*)((const char*)(gbase) + (voff)[_i]), (LAS unsigned*)(lds + (bufoff) + ldsw + _i * 8192), 16, 0, 0); } while (0)
#define PG8_LDA(dst, b, h) do { _Pragma("unroll") for (int m = 0; m < 4; ++m) _Pragma("unroll") for (int k = 0; k < 2; ++k) dst[m][k] = *(const LAS bf16x8*)(lds + PG8_SA(b, h) + aoff + m * 2048 + k * 1024); } while (0)
#define PG8_LDB(dst, b, h) do { _Pragma("unroll") for (int n = 0; n < 2; ++n) _Pragma("unroll") for (int k = 0; k < 2; ++k) dst[n][k] = *(const LAS bf16x8*)(lds + PG8_SB(b, h) + boff + n * 2048 + k * 1024); } while (0)
#define PG8_MMA(ai, bj, At, Bt) do { __builtin_amdgcn_s_setprio(1); _Pragma("unroll") for (int m = 0; m < 4; ++m) _Pragma("unroll") for (int n = 0; n < 2; ++n) _Pragma("unroll") for (int k = 0; k < 2; ++k) \
        acc[ai][bj][m][n] = __builtin_amdgcn_mfma_f32_16x16x32_bf16(Bt[n][k], At[m][k], acc[ai][bj][m][n], 0, 0, 0); __builtin_amdgcn_s_setprio(0); } while (0)
#define PG8_WAIT_V(n) asm volatile("s_waitcnt vmcnt(" #n ")" ::: "memory")
#define PG8_WAIT_L(n) asm volatile("s_waitcnt lgkmcnt(" #n ")" ::: "memory")
#define PG8_BAR __builtin_amdgcn_s_barrier()
#define PG8_SCHED __builtin_amdgcn_sched_barrier(0)
    Unit cur, nxt; int ui = 0;
    if (!S.next(0, cur)) return;
    f32x4 acc[2][2][4][2];
#pragma unroll
    for (int a = 0; a < 2; ++a)
#pragma unroll
        for (int b = 0; b < 2; ++b)
#pragma unroll
            for (int m = 0; m < 4; ++m)
#pragma unroll
                for (int n = 0; n < 2; ++n) acc[a][b][m][n] = (f32x4){0.f, 0.f, 0.f, 0.f};
    bf16x8 At[4][2], B0[2][2], B1[2][2];
    {
        const char* cA = ktA(cur, 0); const char* cB = ktB(cur, 0); const char* cA1 = ktA(cur, 1); const char* cB1 = ktB(cur, 1);
        PG8_STAGE(PG8_SB(0, 0), cB, voffB); PG8_STAGE(PG8_SB(0, 1), cB + hstepB, voffB); PG8_STAGE(PG8_SA(0, 0), cA, voffA); PG8_STAGE(PG8_SA(0, 1), cA + hstepA, voffA);
        if (wr == 1) PG8_BAR;
        PG8_WAIT_V(2); PG8_BAR;
        PG8_STAGE(PG8_SB(1, 0), cB1, voffB); PG8_STAGE(PG8_SA(1, 0), cA1, voffA); PG8_STAGE(PG8_SB(1, 1), cB1 + hstepB, voffB);
        PG8_WAIT_V(6); PG8_BAR;
    }
    for (;;) {
        const bool has_next = S.next(ui + 1, nxt);
        if (!has_next) nxt = cur;
        const int nt = cur.nt;
        for (int t = 0; t < nt; t += 2) {
            const bool last = (t == nt - 2);
            const char* a1 = ktA(cur, t + 1);
            const char* a2 = last ? ktA(nxt, 0) : ktA(cur, t + 2); const char* b2 = last ? ktB(nxt, 0) : ktB(cur, t + 2);
            const char* a3 = last ? ktA(nxt, 1) : ktA(cur, t + 3); const char* b3 = last ? ktB(nxt, 1) : ktB(cur, t + 3);
            PG8_LDB(B0, 0, 0); PG8_LDB(B1, 0, 1); PG8_SCHED; PG8_LDA(At, 0, 0); PG8_STAGE(PG8_SA(1, 1), a1 + hstepA, voffA);
            PG8_WAIT_V(8); PG8_WAIT_L(0); PG8_BAR; PG8_MMA(0, 0, At, B0); PG8_MMA(0, 1, At, B1); PG8_BAR; PG8_SCHED;
            PG8_LDA(At, 0, 1); PG8_STAGE(PG8_SB(0, 0), b2, voffB); PG8_STAGE(PG8_SB(0, 1), b2 + hstepB, voffB); PG8_STAGE(PG8_SA(0, 0), a2, voffA);
            PG8_WAIT_V(8); PG8_WAIT_L(0); PG8_BAR; PG8_MMA(1, 0, At, B0); PG8_MMA(1, 1, At, B1); PG8_BAR; PG8_SCHED;
            PG8_LDB(B0, 1, 0); PG8_LDB(B1, 1, 1); PG8_SCHED; PG8_LDA(At, 1, 0); PG8_STAGE(PG8_SA(0, 1), a2 + hstepA, voffA);
            PG8_WAIT_V(8); PG8_WAIT_L(0); PG8_BAR; PG8_MMA(0, 0, At, B0); PG8_MMA(0, 1, At, B1); PG8_BAR; PG8_SCHED;
            PG8_LDA(At, 1, 1); PG8_STAGE(PG8_SB(1, 0), b3, voffB); PG8_STAGE(PG8_SB(1, 1), b3 + hstepB, voffB); PG8_STAGE(PG8_SA(1, 0), a3, voffA);
            PG8_WAIT_V(8); PG8_WAIT_L(0); PG8_BAR; PG8_MMA(1, 0, At, B0); PG8_MMA(1, 1, At, B1); PG8_BAR; PG8_SCHED;
        }
        if (wr == 0) PG8_BAR;
        E(acc, cur, wr, wc, fr, fq);
        if (!has_next) break;
#pragma unroll
        for (int a = 0; a < 2; ++a)
#pragma unroll
            for (int b = 0; b < 2; ++b)
#pragma unroll
                for (int m = 0; m < 4; ++m)
#pragma unroll
                    for (int n = 0; n < 2; ++n) acc[a][b][m][n] = (f32x4){0.f, 0.f, 0.f, 0.f};
        cur = nxt; ++ui;
        if (wr == 1) PG8_BAR;
    }
    PG8_WAIT_V(0);
    PG8_BAR;
#undef PG8_SA
#undef PG8_SB
#undef PG8_STAGE
#undef PG8_LDA
#undef PG8_LDB
#undef PG8_MMA
#undef PG8_WAIT_V
#undef PG8_WAIT_L
#undef PG8_BAR
#undef PG8_SCHED
}
}
namespace fx {
typedef const f32x4 (&AccRef)[2][2][4][2];

__device__ __forceinline__ u32x4 pack8(const f32x4 v0, const f32x4 v1) { u32x4 w; w.x = cvt_pk_bf16(v0[0], v0[1]); w.y = cvt_pk_bf16(v0[2], v0[3]); w.z = cvt_pk_bf16(v1[0], v1[1]); w.w = cvt_pk_bf16(v1[2], v1[3]); return w; }
__device__ __forceinline__ f32x4 tanh4(f32x4 v) { f32x4 o;
#pragma unroll
    for (int i = 0; i < 4; ++i) { const float e = __expf(2.f * v[i]); o[i] = 1.f - 2.f / (e + 1.f); } return o; }
__device__ __forceinline__ f32x4 sigm4(f32x4 v) { f32x4 o;
#pragma unroll
    for (int i = 0; i < 4; ++i) o[i] = 1.f / (1.f + __expf(-v[i])); return o; }
__device__ __forceinline__ f32x4 gelu4(f32x4 v) { f32x4 o;
#pragma unroll
    for (int i = 0; i < 4; ++i) { const float x = v[i]; const float u = 0.7978845608028654f * (x + 0.044715f * x * x * x); const float e = __expf(2.f * u); const float th = 1.f - 2.f / (e + 1.f); o[i] = 0.5f * x * (1.f + th); } return o; }

struct EpiP1 {
    static constexpr bool PERM = true;
    bf16_t* rkv; bf16_t* hl;
    __device__ __forceinline__ void operator()(AccRef acc, const Unit& u, int wr, int wc, int fr, int fq) const {
        const int row0 = u.pm * BM + wr * 64 + fr;
        bf16_t* base = u.job == 0 ? rkv : hl;
        const int ldc = u.job == 1 ? 256 : 1024;
        const int col0 = u.pn * BM + wc * 32 + 8 * fq;
#pragma unroll
        for (int ai = 0; ai < 2; ++ai)
#pragma unroll
            for (int m = 0; m < 4; ++m) { bf16_t* rowp = base + (size_t)(row0 + ai * HALF + m * 16) * ldc + col0;
#pragma unroll
                for (int bj = 0; bj < 2; ++bj) { f32x4 v0 = acc[ai][bj][m][0], v1 = acc[ai][bj][m][1];
                    if (u.job == 1) { if (bj == 1) { v0 = sigm4(v0); v1 = sigm4(v1); } else if (wc < 2) { v0 = tanh4(v0); v1 = tanh4(v1); } }
                    *(u32x4*)(rowp + bj * HALF) = pack8(v0, v1); } }
    }
};
struct EpiP2 {
    static constexpr bool PERM = true;
    bf16_t* wag; const float* w0; const float* a0;
    __device__ __forceinline__ void operator()(AccRef acc, const Unit& u, int wr, int wc, int fr, int fq) const {
        const int row0 = u.pm * BM + wr * 64 + fr; const int kind = u.pn >> 2; const int colt = (u.pn & 3) * BM;
        bf16_t* base = wag + (size_t)kind * M * 1024; const float* bias = kind == 0 ? w0 : a0;
        const int col0 = colt + wc * 32 + 8 * fq;
        f32x4 bv[2][2];
#pragma unroll
        for (int bj = 0; bj < 2; ++bj)
#pragma unroll
            for (int n = 0; n < 2; ++n) bv[bj][n] = kind < 2 ? *(const f32x4*)(bias + col0 + bj * HALF + 4 * n) : (f32x4){0.f, 0.f, 0.f, 0.f};
#pragma unroll
        for (int ai = 0; ai < 2; ++ai)
#pragma unroll
            for (int m = 0; m < 4; ++m) { bf16_t* rowp = base + (size_t)(row0 + ai * HALF + m * 16) * 1024 + col0;
#pragma unroll
                for (int bj = 0; bj < 2; ++bj) { f32x4 v0 = acc[ai][bj][m][0] + bv[bj][0], v1 = acc[ai][bj][m][1] + bv[bj][1];
                    if (kind == 0) { v0 = sigm4(v0) * (-0.6065306597126334f); v1 = sigm4(v1) * (-0.6065306597126334f); } else if (kind == 1) { v0 = sigm4(v0); v1 = sigm4(v1); }
                    *(u32x4*)(rowp + bj * HALF) = pack8(v0, v1); } }
    }
};
struct EpiResid {
    static constexpr bool PERM = false;
    const float* res; float* out;
    __device__ __forceinline__ void operator()(AccRef acc, const Unit& u, int wr, int wc, int fr, int fq) const {
        const int row0 = u.pm * BM + wr * 64 + fr, col0 = u.pn * BM + wc * 32 + 4 * fq;
#pragma unroll
        for (int ai = 0; ai < 2; ++ai)
#pragma unroll
            for (int m = 0; m < 4; ++m) { const size_t off = (size_t)(row0 + ai * HALF + m * 16) * 1024 + col0;
#pragma unroll
                for (int bj = 0; bj < 2; ++bj)
#pragma unroll
                    for (int n = 0; n < 2; ++n) { const f32x4 rv = *(const f32x4*)(res + off + bj * HALF + n * 16); *(f32x4*)(out + off + bj * HALF + n * 16) = rv * ALPHA + acc[ai][bj][m][n]; } }
    }
};
struct EpiGlu {
    static constexpr bool PERM = true;
    bf16_t* h; int ldh;
    __device__ __forceinline__ void operator()(AccRef acc, const Unit& u, int wr, int wc, int fr, int fq) const {
        const int row0 = u.pm * BM + wr * 64 + fr, col0 = u.pn * HALF + wc * 32 + 8 * fq;
#pragma unroll
        for (int ai = 0; ai < 2; ++ai)
#pragma unroll
            for (int m = 0; m < 4; ++m) { f32x4 o[2];
#pragma unroll
                for (int n = 0; n < 2; ++n) { const f32x4 g = acc[ai][0][m][n], up = acc[ai][1][m][n];
#pragma unroll
                    for (int i = 0; i < 4; ++i) o[n][i] = g[i] / (1.f + __expf(-g[i])) * up[i]; }
                *(u32x4*)(h + (size_t)(row0 + ai * HALF + m * 16) * ldh + col0) = pack8(o[0], o[1]); }
    }
};
struct EpiBf16 {
    static constexpr bool PERM = true;
    bf16_t* O0; bf16_t* O1; int ldc; const float* bias0; const float* bias1; int act;
    __device__ __forceinline__ void operator()(AccRef acc, const Unit& u, int wr, int wc, int fr, int fq) const {
        const int row0 = u.pm * BM + wr * 64 + fr, col0 = u.pn * BM + wc * 32 + 8 * fq;
        bf16_t* base = u.job == 0 ? O0 : O1; const float* bias = u.job == 0 ? bias0 : bias1;
        f32x4 bv[2][2];
#pragma unroll
        for (int bj = 0; bj < 2; ++bj)
#pragma unroll
            for (int n = 0; n < 2; ++n) bv[bj][n] = act ? *(const f32x4*)(bias + col0 + bj * HALF + 4 * n) : (f32x4){0.f, 0.f, 0.f, 0.f};
#pragma unroll
        for (int ai = 0; ai < 2; ++ai)
#pragma unroll
            for (int m = 0; m < 4; ++m) { bf16_t* rowp = base + (size_t)(row0 + ai * HALF + m * 16) * ldc + col0;
#pragma unroll
                for (int bj = 0; bj < 2; ++bj) { f32x4 v0 = acc[ai][bj][m][0] + bv[bj][0], v1 = acc[ai][bj][m][1] + bv[bj][1];
                    if (act) { v0 = gelu4(v0); v1 = gelu4(v1); }
                    *(u32x4*)(rowp + bj * HALF) = pack8(v0, v1); } }
    }
};
struct EpiGate {
    static constexpr bool PERM = false;
    float* xs; const bf16_t* pp; const float* gb; bf16_t* xb;
    __device__ __forceinline__ void operator()(AccRef acc, const Unit& u, int wr, int wc, int fr, int fq) const {
        const int row0 = u.pm * BM + wr * 64 + fr, col0 = u.pn * BM + wc * 32 + 4 * fq;
        f32x4 bv[2][2];
#pragma unroll
        for (int bj = 0; bj < 2; ++bj)
#pragma unroll
            for (int n = 0; n < 2; ++n) bv[bj][n] = *(const f32x4*)(gb + col0 + bj * HALF + n * 16);
#pragma unroll
        for (int ai = 0; ai < 2; ++ai)
#pragma unroll
            for (int m = 0; m < 4; ++m) { const size_t off = (size_t)(row0 + ai * HALF + m * 16) * 1024 + col0;
#pragma unroll
                for (int bj = 0; bj < 2; ++bj)
#pragma unroll
                    for (int n = 0; n < 2; ++n) { const size_t o2 = off + bj * HALF + n * 16; const f32x4 xv = *(const f32x4*)(xs + o2); const u32x2 pw = *(const u32x2*)(pp + o2);
                        const f32x4 pv = (f32x4){bflo(pw.x), bfhi(pw.x), bflo(pw.y), bfhi(pw.y)}; const f32x4 r = xv + pv * sigm4(acc[ai][bj][m][n] + bv[bj][n]);
                        *(f32x4*)(xs + o2) = r; if (xb) { u32x2 w; w.x = cvt_pk_bf16(r[0], r[1]); w.y = cvt_pk_bf16(r[2], r[3]); *(u32x2*)(xb + o2) = w; } } }
    }
};
struct EpiNsa {
    static constexpr bool PERM = true;
    unsigned char* ws;
    __device__ __forceinline__ void operator()(AccRef acc, const Unit& u, int wr, int wc, int fr, int fq) const {
        const int row0 = u.pm * BM + wr * 64 + fr; const float* cs = (const float*)(ws + X_CS);
        bf16_t* vt = (bf16_t*)(ws + A_VTS); bf16_t* q = (bf16_t*)(ws + A_Q); bf16_t* qr = (bf16_t*)(ws + A_QR); float* gates = (float*)(ws + A_GATES);
        if (u.job == 1) {
            const int col0 = u.pn * BM + wc * 32 + 8 * fq;
#pragma unroll
            for (int ai = 0; ai < 2; ++ai)
#pragma unroll
                for (int m = 0; m < 4; ++m) { bf16_t* rowp = vt + (size_t)(row0 + ai * HALF + m * 16) * M + col0;
#pragma unroll
                    for (int bj = 0; bj < 2; ++bj) *(u32x4*)(rowp + bj * HALF) = pack8(acc[ai][bj][m][0], acc[ai][bj][m][1]); }
            return;
        }
        const int pn = u.pn;
        if (pn < 2) {
            bf16_t* base = (bf16_t*)(ws + (pn == 0 ? A_KC : A_VC));
#pragma unroll
            for (int ai = 0; ai < 2; ++ai)
#pragma unroll
                for (int m = 0; m < 4; ++m) { const int row = row0 + ai * HALF + m * 16; const int b = row >> 11, t = row & 2047;
#pragma unroll
                    for (int bj = 0; bj < 2; ++bj) { const int c = 128 * bj + 32 * wc + 8 * fq; const int g = c >> 6, d = c & 63;
                        *(u32x4*)(base + ((size_t)(b * 4 + g) * T + t) * 64 + d) = pack8(acc[ai][bj][m][0], acc[ai][bj][m][1]); } }
        } else if (pn < 8) {
#pragma unroll
            for (int ai = 0; ai < 2; ++ai)
#pragma unroll
                for (int m = 0; m < 4; ++m) { const int row = row0 + ai * HALF + m * 16; const int b = row >> 11, t = row & 2047;
#pragma unroll
                    for (int bj = 0; bj < 2; ++bj) { const int hh = 2 * bj + (wc >> 1), d0 = 4 * (4 * (wc & 1) + fq);
                        const f32x4 x1 = acc[ai][bj][m][0], x2 = acc[ai][bj][m][1];
                        const f32x4 c0 = *(const f32x4*)(cs + ((size_t)t * 32 + d0) * 2), c1 = *(const f32x4*)(cs + ((size_t)t * 32 + d0) * 2 + 4);
                        const f32x4 co = (f32x4){c0[0], c0[2], c1[0], c1[2]}, si = (f32x4){c0[1], c0[3], c1[1], c1[3]};
                        const f32x4 r1 = x1 * co - x2 * si, r2 = x2 * co + x1 * si;
                        u32x2 w1, w2; w1.x = cvt_pk_bf16(r1[0], r1[1]); w1.y = cvt_pk_bf16(r1[2], r1[3]); w2.x = cvt_pk_bf16(r2[0], r2[1]); w2.y = cvt_pk_bf16(r2[2], r2[3]);
                        if (pn < 4) { bf16_t* kb = (bf16_t*)(ws + (pn == 2 ? A_KS : A_KW)) + ((size_t)(b * 4 + hh) * T + t) * 64; *(u32x2*)(kb + d0) = w1; *(u32x2*)(kb + d0 + 32) = w2; }
                        else { const size_t o = (size_t)row * 1024 + (size_t)((pn - 4) * 4 + hh) * 64;
                            *(u32x2*)(qr + o + d0) = w1; *(u32x2*)(qr + o + d0 + 32) = w2;
                            u32x2 u1, u2; u1.x = cvt_pk_bf16(x1[0], x1[1]); u1.y = cvt_pk_bf16(x1[2], x1[3]); u2.x = cvt_pk_bf16(x2[0], x2[1]); u2.y = cvt_pk_bf16(x2[2], x2[3]);
                            *(u32x2*)(q + o + d0) = u1; *(u32x2*)(q + o + d0 + 32) = u2; } } }
        } else {
            if (wc < 2) {
#pragma unroll
                for (int ai = 0; ai < 2; ++ai)
#pragma unroll
                    for (int m = 0; m < 4; ++m) { const int row = row0 + ai * HALF + m * 16; float* gp = gates + (size_t)row * 64 + 32 * wc + 8 * fq;
                        *(f32x4*)(gp) = sigm4(acc[ai][0][m][0]); *(f32x4*)(gp + 4) = sigm4(acc[ai][0][m][1]); }
            }
        }
    }
};
struct EpiMoeDown {
    static constexpr bool PERM = true;
    bf16_t* ys2; const int* row_dst; const float* row_w;
    __device__ __forceinline__ void operator()(AccRef acc, const Unit& u, int wr, int wc, int fr, int fq) const {
        const int row0 = u.pm * BM + wr * 64 + fr, col0 = u.pn * BM + wc * 32 + 8 * fq;
#pragma unroll
        for (int ai = 0; ai < 2; ++ai)
#pragma unroll
            for (int m = 0; m < 4; ++m) { const int row = row0 + ai * HALF + m * 16; const int dst = row_dst[row]; const float w = row_w[row];
                if (dst >= 0) { bf16_t* rowp = ys2 + (size_t)dst * 1024 + col0;
#pragma unroll
                    for (int bj = 0; bj < 2; ++bj) *(u32x4*)(rowp + bj * HALF) = pack8(acc[ai][bj][m][0] * w, acc[ai][bj][m][1] * w); } }
    }
};
}
namespace fx {
struct In {
    const float *x, *p, *a_mu, *a_w_rkv, *a_w0, *a_w1, *a_w2, *a_a0, *a_a1, *a_a2, *a_g1, *a_g2, *a_k_k, *a_k_a, *a_r_k, *a_gn_g, *a_gn_b, *a_w_o,
        *b_w_kv, *b_cmp_pos, *b_phi_w1, *b_phi_b1, *b_phi_w2, *b_w_in, *b_w_o, *f_w_gu, *f_w_down, *m_w_router, *m_b_router, *m_w_gu, *m_w_down,
        *ln_g, *ln_b, *ple_w, *ple_gate_w, *ple_gate_b;
};
struct Params { In in; float* out; unsigned char* ws; int ph_lo, ph_hi; };

__device__ __forceinline__ int ropeperm(int rr) { const int hh = rr >> 6, u = rr & 63; return hh * 64 + 4 * (u >> 3) + (u & 3) + 32 * ((u >> 2) & 1); }

__device__ __forceinline__ float wval(const In& I, int ty, int sub, int k, int n) {
    switch (ty) {
    case 0: return I.a_w_rkv[(size_t)sub * D * D + (size_t)k * D + n];
    case 1: { const int hi = n >> 8, c = n & 255; float w, mu;
        if (c < 64) { w = I.a_w1[k * 64 + c]; mu = I.a_mu[3 * D + k]; } else if (c < 128) { w = I.a_a1[k * 64 + c - 64]; mu = I.a_mu[4 * D + k]; } else { w = I.a_g1[k * 128 + c - 128]; mu = I.a_mu[5 * D + k]; }
        return w * (hi ? mu : 1.f - mu); }
    case 2: { const int kind = n >> 10, c = n & 1023;
        if (kind == 0) return k < 64 ? I.a_w2[k * D + c] : 0.f;
        if (kind == 1) return (k >= 64 && k < 128) ? I.a_a2[(k - 64) * D + c] : 0.f;
        return k >= 128 ? I.a_g2[(k - 128) * D + c] : 0.f; }
    case 3: return I.a_w_o[(size_t)k * D + n];
    case 4: { const int tile = n >> 8, rr = n & 255; return I.f_w_gu[(size_t)k * (2 * DFF) + (rr >> 7) * DFF + tile * 128 + (rr & 127)]; }
    case 5: return I.f_w_down[(size_t)k * D + n];
    case 6: return I.ple_w[(size_t)sub * PLE * D + (size_t)k * D + n];
    case 7: return I.ple_gate_w[(size_t)sub * D * D + (size_t)k * D + n];
    case 8: { const int tile = n >> 8, rr = n & 255; const int col = tile == 0 ? rr : (tile == 1 ? 256 + rr : (tile == 2 ? 512 + ropeperm(rr) : 1024 + ropeperm(rr))); return I.b_w_kv[(size_t)k * 1536 + col]; }
    case 9: { if (n < 1024) return I.b_w_in[(size_t)k * 1072 + (n & ~255) + ropeperm(n & 255)]; const int rr = n - 1024; return rr < 48 ? I.b_w_in[(size_t)k * 1072 + 1024 + rr] : 0.f; }
    case 10: { const int ten = n >> 8, rr = n & 255; return I.b_w_kv[(size_t)k * 1536 + (ten ? 5 : 3) * 256 + rr]; }
    case 11: return I.b_phi_w1[(size_t)sub * 2048 * 256 + (size_t)k * 256 + n];
    case 12: return I.b_w_o[(size_t)k * D + n];
    case 13: { const int tile = n >> 8, rr = n & 255; return I.m_w_gu[(size_t)sub * D * (2 * DFE) + (size_t)k * (2 * DFE) + (rr >> 7) * DFE + tile * 128 + (rr & 127)]; }
    default: return I.m_w_down[(size_t)sub * DFE * D + (size_t)k * D + n];
    }
}
__device__ __forceinline__ void wprep_item(const In& I, int ty, int sub, int K, int N, bf16_t* WT, LAS float* scr, int item, int lane) {
    const int nblk = N / 32, kb = item / nblk, nb = item % nblk, k0 = 64 * kb, n0 = 32 * nb;
#pragma unroll 4
    for (int i = 0; i < 32; ++i) { const int kk = 2 * i + (lane >> 5); scr[kk * 33 + (lane & 31)] = wval(I, ty, sub, k0 + kk, n0 + (lane & 31)); }
    asm volatile("s_waitcnt lgkmcnt(0)" ::: "memory");
    const int c = lane & 7;
#pragma unroll
    for (int j = 0; j < 4; ++j) { const int n = (lane >> 3) + 8 * j; const LAS float* s = scr + (8 * c) * 33 + n;
        u32x4 o; o.x = cvt_pk_bf16(s[0 * 33], s[1 * 33]); o.y = cvt_pk_bf16(s[2 * 33], s[3 * 33]); o.z = cvt_pk_bf16(s[4 * 33], s[5 * 33]); o.w = cvt_pk_bf16(s[6 * 33], s[7 * 33]);
        *(u32x4*)(WT + (size_t)(n0 + n) * K + k0 + 8 * c) = o; }
    asm volatile("s_waitcnt lgkmcnt(0)" ::: "memory");
}
struct WJ { int ty, sub, K, N; size_t off; };
__device__ __forceinline__ void prep_phase(const Params& P, LAS unsigned char* lds) {
    const In& I = P.in; unsigned char* ws = P.ws;
    const int tid = threadIdx.x, lane = tid & 63, wave = tid >> 6; const int G = gridDim.x;
    const int gw = blockIdx.x * 8 + wave, NGW = G * 8; const int gt = blockIdx.x * 512 + tid, NGT = G * 512;
    LAS float* scr = (LAS float*)(lds + wave * 16384);
    static constexpr WJ jobs[34] = {
        {0, 0, 1024, 1024, W_RKV}, {0, 1, 1024, 1024, W_RKV + 2 * MiB}, {0, 2, 1024, 1024, W_RKV + 4 * MiB}, {1, 0, 1024, 512, W_L1}, {2, 0, 256, 3072, W_L2}, {3, 0, 1024, 1024, W_AO},
        {4, 0, 1024, 5632, W_FGU}, {5, 0, 2816, 1024, W_FDN}, {6, 0, 256, 1024, W_PLE}, {6, 1, 256, 1024, W_PLE + MiB / 2}, {7, 0, 1024, 1024, W_GATE}, {7, 1, 1024, 1024, W_GATE + 2 * MiB},
        {8, 0, 1024, 1024, W_NSA}, {9, 0, 1024, 1280, W_NSA + 2 * MiB}, {10, 0, 1024, 512, W_VT}, {11, 0, 2048, 256, W_PHI}, {11, 1, 2048, 256, W_PHI + MiB}, {12, 0, 1024, 1024, W_BO},
        {13, 0, 1024, 2816, W_MGU}, {13, 1, 1024, 2816, W_MGU + 11 * MiB / 2}, {13, 2, 1024, 2816, W_MGU + 11 * MiB}, {13, 3, 1024, 2816, W_MGU + 33 * MiB / 2},
        {13, 4, 1024, 2816, W_MGU + 22 * MiB}, {13, 5, 1024, 2816, W_MGU + 55 * MiB / 2}, {13, 6, 1024, 2816, W_MGU + 33 * MiB}, {13, 7, 1024, 2816, W_MGU + 77 * MiB / 2},
        {14, 0, 1408, 1024, W_MDN}, {14, 1, 1408, 1024, W_MDN + 11 * MiB / 4}, {14, 2, 1408, 1024, W_MDN + 11 * MiB / 2}, {14, 3, 1408, 1024, W_MDN + 33 * MiB / 4},
        {14, 4, 1408, 1024, W_MDN + 11 * MiB}, {14, 5, 1408, 1024, W_MDN + 55 * MiB / 4}, {14, 6, 1408, 1024, W_MDN + 33 * MiB / 2}, {14, 7, 1408, 1024, W_MDN + 77 * MiB / 4}};
    {
        int start = 0;
#pragma unroll
        for (int jb = 0; jb < 34; ++jb) {
            const WJ J = jobs[jb]; const int nit = (J.K / 64) * (J.N / 32);
            int it = start + ((gw - start) % NGW + NGW) % NGW;
            for (; it < start + nit; it += NGW) wprep_item(I, J.ty, J.sub, J.K, J.N, (bf16_t*)(ws + J.off), scr, it - start, lane);
            start += nit;
        }
    }
    {
        bf16_t* mr = (bf16_t*)(ws + A_MIX); bf16_t* mk = mr + (size_t)M * D; bf16_t* mv = mk + (size_t)M * D; bf16_t* xb = (bf16_t*)((unsigned char*)P.out + O_XB);
        for (int rb = gw; rb < M / 16; rb += NGW) {
#pragma unroll 1
            for (int hf = 0; hf < 2; ++hf) {
                const int c0 = hf * 512 + lane * 8;
                f32x4 mur[2], muk[2], muv[2];
#pragma unroll
                for (int q = 0; q < 2; ++q) { mur[q] = *(const f32x4*)(I.a_mu + 0 * D + c0 + 4 * q); muk[q] = *(const f32x4*)(I.a_mu + 1 * D + c0 + 4 * q); muv[q] = *(const f32x4*)(I.a_mu + 2 * D + c0 + 4 * q); }
                const int row0 = rb * 16; f32x4 pv[2];
                if ((row0 & (T - 1)) == 0) { pv[0] = (f32x4){0.f, 0.f, 0.f, 0.f}; pv[1] = pv[0];
                    const int b = row0 >> 11; *(u32x4*)(xb + (size_t)(b * XBT) * D + c0) = (u32x4){0u, 0u, 0u, 0u}; }
                else { pv[0] = *(const f32x4*)(I.x + (size_t)(row0 - 1) * D + c0); pv[1] = *(const f32x4*)(I.x + (size_t)(row0 - 1) * D + c0 + 4); }
#pragma unroll 4
                for (int rr = 0; rr < 16; ++rr) { const int row = row0 + rr; const int b = row >> 11, t = row & (T - 1);
                    f32x4 xv[2]; xv[0] = *(const f32x4*)(I.x + (size_t)row * D + c0); xv[1] = *(const f32x4*)(I.x + (size_t)row * D + c0 + 4);
                    const f32x4 d0 = pv[0] - xv[0], d1 = pv[1] - xv[1];
                    *(u32x4*)(mr + (size_t)row * D + c0) = pack8(xv[0] + d0 * mur[0], xv[1] + d1 * mur[1]);
                    *(u32x4*)(mk + (size_t)row * D + c0) = pack8(xv[0] + d0 * muk[0], xv[1] + d1 * muk[1]);
                    *(u32x4*)(mv + (size_t)row * D + c0) = pack8(xv[0] + d0 * muv[0], xv[1] + d1 * muv[1]);
                    *(u32x4*)(xb + (size_t)(b * XBT + 1 + t) * D + c0) = pack8(xv[0], xv[1]);
                    pv[0] = xv[0]; pv[1] = xv[1]; }
            }
        }
    }
    { float* cs = (float*)(ws + X_CS);
        for (int i = gt; i < T * 32; i += NGT) { const int t = i >> 5, j = i & 31; const float inv = powf(10000.f, -(float)j / 32.f); const float ang = (float)t * inv;
            const double a = (double)ang; const double n = rint(a * 0.15915494309189535); const float rf = (float)(a - n * 6.283185307179586476925); cs[2 * i] = cosf(rf); cs[2 * i + 1] = sinf(rf); } }
    { float* cb = (float*)(ws + X_CB);
        for (int o = gw; o < 512; o += NGW) { const int j = o >> 8, c = o & 255; float s = 0.f;
            for (int k = lane; k < 2048; k += 64) s += I.b_cmp_pos[j * 2048 + k] * I.b_phi_w1[(size_t)j * 2048 * 256 + (size_t)k * 256 + c];
            s = wave_sum(s); if (lane == 0) cb[o] = s + I.b_phi_b1[o]; } }
    { int* rs = (int*)(ws + X_RSRC); int* rd = (int*)(ws + X_RDST); float* rw = (float*)(ws + X_RW);
        for (int i = gt; i < MOE_ROWS_MAX; i += NGT) { rs[i] = 0; rd[i] = -1; rw[i] = 0.f; } }
}

__device__ __forceinline__ void unpack8(const u32x4 w, float (&f)[8]) { f[0] = bflo(w.x); f[1] = bfhi(w.x); f[2] = bflo(w.y); f[3] = bfhi(w.y); f[4] = bflo(w.z); f[5] = bfhi(w.z); f[6] = bflo(w.w); f[7] = bfhi(w.w); }
__device__ __forceinline__ void scan_phase(const Params& P, LAS unsigned char* lds) {
    const In& I = P.in; unsigned char* ws = P.ws;
    const bf16_t* gr = (const bf16_t*)(ws + A_RKV); const bf16_t* gk = gr + (size_t)M * D; const bf16_t* gv = gk + (size_t)M * D;
    const bf16_t* gwl = (const bf16_t*)(ws + A_WAG); const bf16_t* ga = gwl + (size_t)M * D; const bf16_t* gg = ga + (size_t)M * D; bf16_t* og = (bf16_t*)(ws + A_RKV);
    LAS float* sR = (LAS float*)lds; LAS float* sKM = sR + 4096; LAS float* sDD = sKM + 4096; LAS float* sKK = sDD + 4096; LAS float* sBB = sKK + 4096; LAS float* sVV = sBB + 4096; LAS float* sOUT = sVV + 4096; LAS float* sBON = sOUT + 4096;
    const int tid = threadIdx.x, row = tid >> 3, jg = tid & 7;
    for (int item = blockIdx.x; item < NB * 16; item += gridDim.x) {
        const int b = item >> 4, h = item & 15; const int cb = h * 64 + jg * 8;
        const size_t base = (size_t)b * T * D + cb;
        float kkc[8], kac[8], rkc[8];
#pragma unroll
        for (int i = 0; i < 8; ++i) { kkc[i] = I.a_k_k[cb + i]; kac[i] = I.a_k_a[cb + i]; rkc[i] = I.a_r_k[cb + i]; }
        f32x2 S[4];
#pragma unroll
        for (int i = 0; i < 4; ++i) S[i] = (f32x2){0.f, 0.f};
        u32x4 pr, pk, pv, pw, pa, pg;
        { const size_t o = base + (size_t)row * D; pr = *(const u32x4*)(gr + o); pk = *(const u32x4*)(gk + o); pv = *(const u32x4*)(gv + o); pw = *(const u32x4*)(gwl + o); pa = *(const u32x4*)(ga + o); }
#pragma unroll 1
        for (int c = 0; c < T / 64; ++c) {
            const int t0 = c * 64;
            {
                float rf[8], kf[8], vf[8], wf[8], af[8]; unpack8(pr, rf); unpack8(pk, kf); unpack8(pv, vf); unpack8(pw, wf); unpack8(pa, af);
                float kk[8], km[8], dd[8], bb[8]; float ss = 0.f, bon = 0.f;
#pragma unroll
                for (int i = 0; i < 8; ++i) { kk[i] = kf[i] * kkc[i]; ss += kk[i] * kk[i]; km[i] = kf[i] * (1.f + (af[i] - 1.f) * kac[i]); dd[i] = __expf(wf[i]); bon += rf[i] * km[i] * rkc[i]; }
                ss = sum8(ss); bon = sum8(bon); const float inv = 1.f / fmaxf(sqrtf(ss), 1e-12f);
#pragma unroll
                for (int i = 0; i < 8; ++i) { kk[i] *= inv; bb[i] = kk[i] * af[i]; }
                const int o = row * 64 + jg * 8;
                *(LAS f32x4*)(sR + o) = (f32x4){rf[0], rf[1], rf[2], rf[3]}; *(LAS f32x4*)(sR + o + 4) = (f32x4){rf[4], rf[5], rf[6], rf[7]};
                *(LAS f32x4*)(sKM + o) = (f32x4){km[0], km[1], km[2], km[3]}; *(LAS f32x4*)(sKM + o + 4) = (f32x4){km[4], km[5], km[6], km[7]};
                *(LAS f32x4*)(sDD + o) = (f32x4){dd[0], dd[1], dd[2], dd[3]}; *(LAS f32x4*)(sDD + o + 4) = (f32x4){dd[4], dd[5], dd[6], dd[7]};
                *(LAS f32x4*)(sKK + o) = (f32x4){kk[0], kk[1], kk[2], kk[3]}; *(LAS f32x4*)(sKK + o + 4) = (f32x4){kk[4], kk[5], kk[6], kk[7]};
                *(LAS f32x4*)(sBB + o) = (f32x4){bb[0], bb[1], bb[2], bb[3]}; *(LAS f32x4*)(sBB + o + 4) = (f32x4){bb[4], bb[5], bb[6], bb[7]};
                *(LAS f32x4*)(sVV + o) = (f32x4){vf[0], vf[1], vf[2], vf[3]}; *(LAS f32x4*)(sVV + o + 4) = (f32x4){vf[4], vf[5], vf[6], vf[7]};
                if (jg == 0) sBON[row] = bon;
            }
            __syncthreads();
            {
                const size_t o = base + (size_t)(t0 + row) * D; pg = *(const u32x4*)(gg + o);
                if (c + 1 < T / 64) { const size_t o2 = o + (size_t)64 * D; pr = *(const u32x4*)(gr + o2); pk = *(const u32x4*)(gk + o2); pv = *(const u32x4*)(gv + o2); pw = *(const u32x4*)(gwl + o2); pa = *(const u32x4*)(ga + o2); }
            }
#pragma unroll 2
            for (int s = 0; s < 64; ++s) {
                const int o = s * 64 + jg * 8;
                const f32x4 k0 = *(const LAS f32x4*)(sKK + o), k1 = *(const LAS f32x4*)(sKK + o + 4);
                const f32x4 d0 = *(const LAS f32x4*)(sDD + o), d1 = *(const LAS f32x4*)(sDD + o + 4);
                const f32x4 b0 = *(const LAS f32x4*)(sBB + o), b1 = *(const LAS f32x4*)(sBB + o + 4);
                const f32x4 m0 = *(const LAS f32x4*)(sKM + o), m1 = *(const LAS f32x4*)(sKM + o + 4);
                const f32x4 r0 = *(const LAS f32x4*)(sR + o), r1 = *(const LAS f32x4*)(sR + o + 4);
                const float vi = sVV[s * 64 + row];
                f32x2 dp = S[0] * (f32x2){k0[0], k0[1]}; dp = S[1] * (f32x2){k0[2], k0[3]} + dp; dp = S[2] * (f32x2){k1[0], k1[1]} + dp; dp = S[3] * (f32x2){k1[2], k1[3]} + dp;
                const float dot = sum8(dp.x + dp.y);
                const f32x2 nd = (f32x2){-dot, -dot}, vv = (f32x2){vi, vi};
                S[0] = S[0] * (f32x2){d0[0], d0[1]} + (nd * (f32x2){b0[0], b0[1]} + vv * (f32x2){m0[0], m0[1]});
                S[1] = S[1] * (f32x2){d0[2], d0[3]} + (nd * (f32x2){b0[2], b0[3]} + vv * (f32x2){m0[2], m0[3]});
                S[2] = S[2] * (f32x2){d1[0], d1[1]} + (nd * (f32x2){b1[0], b1[1]} + vv * (f32x2){m1[0], m1[1]});
                S[3] = S[3] * (f32x2){d1[2], d1[3]} + (nd * (f32x2){b1[2], b1[3]} + vv * (f32x2){m1[2], m1[3]});
                f32x2 op = S[0] * (f32x2){r0[0], r0[1]}; op = S[1] * (f32x2){r0[2], r0[3]} + op; op = S[2] * (f32x2){r1[0], r1[1]} + op; op = S[3] * (f32x2){r1[2], r1[3]} + op;
                const float ov = sum8(op.x + op.y);
                if (jg == 0) sOUT[s * 64 + row] = ov;
            }
            __syncthreads();
            {
                const int o = row * 64 + jg * 8; const f32x4 o0 = *(const LAS f32x4*)(sOUT + o), o1 = *(const LAS f32x4*)(sOUT + o + 4);
                float ov[8] = {o0[0], o0[1], o0[2], o0[3], o1[0], o1[1], o1[2], o1[3]}; float sm = 0.f;
#pragma unroll
                for (int i = 0; i < 8; ++i) sm += ov[i];
                const float mean = sum8(sm) * (1.f / 64.f); float q = 0.f;
#pragma unroll
                for (int i = 0; i < 8; ++i) { ov[i] -= mean; q += ov[i] * ov[i]; }
                const float rs = rsqrtf(sum8(q) * (1.f / 64.f) + GN_EPS); const float bon = sBON[row];
                const f32x4 v0 = *(const LAS f32x4*)(sVV + o), v1 = *(const LAS f32x4*)(sVV + o + 4); const float vv[8] = {v0[0], v0[1], v0[2], v0[3], v1[0], v1[1], v1[2], v1[3]};
                float gf[8]; unpack8(pg, gf); float y[8];
#pragma unroll
                for (int i = 0; i < 8; ++i) y[i] = (ov[i] * rs * I.a_gn_g[cb + i] + I.a_gn_b[cb + i] + bon * vv[i]) * gf[i];
                u32x4 w; w.x = cvt_pk_bf16(y[0], y[1]); w.y = cvt_pk_bf16(y[2], y[3]); w.z = cvt_pk_bf16(y[4], y[5]); w.w = cvt_pk_bf16(y[6], y[7]);
                *(u32x4*)(og + base + (size_t)(t0 + row) * D) = w;
            }
            __syncthreads();
        }
    }
}

__device__ __forceinline__ void ln_phase(const Params& P, LAS unsigned char* lds, int lni, bf16_t* xb, const bf16_t* ys2, bool router, const float* psrc, bf16_t* pdst) {
    const In& I = P.in; float* xs = P.out; unsigned char* ws = P.ws;
    const int tid = threadIdx.x, lane = tid & 63, wave = tid >> 6; const int gw = blockIdx.x * 8 + wave, NGW = gridDim.x * 8;
    LAS float* wrT = (LAS float*)lds;
    LAS unsigned* hist = (LAS unsigned*)(lds + 32768);
    if (router) { for (int i = tid; i < 8192; i += 512) { const int k = i >> 3, e = i & 7; wrT[e * 1024 + k] = I.m_w_router[i]; } if (tid < 8) hist[tid] = 0u; __syncthreads(); }
    f32x4 gv[4], bv[4];
#pragma unroll
    for (int j = 0; j < 4; ++j) { gv[j] = *(const f32x4*)(I.ln_g + lni * D + 4 * lane + 256 * j); bv[j] = *(const f32x4*)(I.ln_b + lni * D + 4 * lane + 256 * j); }
    for (int rb = gw; rb < M / 16; rb += NGW) {
#pragma unroll 1
        for (int rr = 0; rr < 16; ++rr) { const int row = rb * 16 + rr; float* xr = xs + (size_t)row * D + 4 * lane;
            f32x4 v[4]; float s = 0.f;
#pragma unroll
            for (int j = 0; j < 4; ++j) v[j] = *(const f32x4*)(xr + 256 * j);
            if (ys2) {
#pragma unroll
                for (int j = 0; j < 4; ++j) { const u32x2 a = *(const u32x2*)(ys2 + (size_t)(2 * row) * D + 4 * lane + 256 * j), b2 = *(const u32x2*)(ys2 + (size_t)(2 * row + 1) * D + 4 * lane + 256 * j);
                    v[j] = v[j] * ALPHA + ((f32x4){bflo(a.x), bfhi(a.x), bflo(a.y), bfhi(a.y)} + (f32x4){bflo(b2.x), bfhi(b2.x), bflo(b2.y), bfhi(b2.y)}); }
            }
#pragma unroll
            for (int j = 0; j < 4; ++j) s += (v[j][0] + v[j][1]) + (v[j][2] + v[j][3]);
            const float mean = wave_sum(s) * (1.f / D); float q = 0.f;
#pragma unroll
            for (int j = 0; j < 4; ++j) { v[j] = v[j] - mean; q += (v[j][0] * v[j][0] + v[j][1] * v[j][1]) + (v[j][2] * v[j][2] + v[j][3] * v[j][3]); }
            const float rstd = rsqrtf(wave_sum(q) * (1.f / D) + LN_EPS);
#pragma unroll
            for (int j = 0; j < 4; ++j) { v[j] = v[j] * rstd * gv[j] + bv[j]; *(f32x4*)(xr + 256 * j) = v[j];
                u32x2 w; w.x = cvt_pk_bf16(v[j][0], v[j][1]); w.y = cvt_pk_bf16(v[j][2], v[j][3]); *(u32x2*)(xb + (size_t)row * D + 4 * lane + 256 * j) = w; }
            if (router) {
                float lg[8];
#pragma unroll
                for (int e = 0; e < 8; ++e) { float a = 0.f;
#pragma unroll
                    for (int j = 0; j < 4; ++j) { const f32x4 w4 = *(const LAS f32x4*)(wrT + e * 1024 + 4 * lane + 256 * j); a += (v[j][0] * w4[0] + v[j][1] * w4[1]) + (v[j][2] * w4[2] + v[j][3] * w4[3]); }
                    lg[e] = wave_sum(a) + I.m_b_router[e]; }
                int e1 = 0; float v1 = lg[0];
#pragma unroll
                for (int e = 1; e < 8; ++e) if (lg[e] > v1) { v1 = lg[e]; e1 = e; }
                int e2 = -1; float v2 = 0.f;
#pragma unroll
                for (int e = 0; e < 8; ++e) if (e != e1 && (e2 < 0 || lg[e] > v2)) { v2 = lg[e]; e2 = e; }
                const float p2 = __expf(v2 - v1); const float w1 = 1.f / (1.f + p2), w2 = p2 / (1.f + p2);
                if (lane == 0) { ((unsigned*)(ws + X_TOKE))[row] = (unsigned)e1 | ((unsigned)e2 << 8); ((f32x2*)(ws + X_TOKW))[row] = (f32x2){w1, w2}; __hip_atomic_fetch_add(&hist[e1], 1u, __ATOMIC_RELAXED, __HIP_MEMORY_SCOPE_WORKGROUP); __hip_atomic_fetch_add(&hist[e2], 1u, __ATOMIC_RELAXED, __HIP_MEMORY_SCOPE_WORKGROUP); }
            }
        }
    }
    if (router) { __syncthreads(); if (tid < 8) atomicAdd((unsigned*)(ws + X_CTL) + CW_CNT + tid, hist[tid]); }
    if (psrc) { const int gt = blockIdx.x * 512 + tid, NGT = gridDim.x * 512;
        for (int i = gt; i < M * PLE / 8; i += NGT) { const f32x4 a = *(const f32x4*)(psrc + (size_t)i * 8), b2 = *(const f32x4*)(psrc + (size_t)i * 8 + 4); *(u32x4*)(pdst + (size_t)i * 8) = pack8(a, b2); } }
}

__device__ __forceinline__ void moe_gather_phase(const Params& P) {
    unsigned char* ws = P.ws; const unsigned* cnt = (const unsigned*)(ws + X_CTL) + CW_CNT; unsigned* cur = (unsigned*)(ws + X_CTL) + CW_CUR;
    const unsigned* toke = (const unsigned*)(ws + X_TOKE); const f32x2* tokw = (const f32x2*)(ws + X_TOKW);
    int* rs = (int*)(ws + X_RSRC); int* rd = (int*)(ws + X_RDST); float* rw = (float*)(ws + X_RW);
    const bf16_t* x4b = (const bf16_t*)(ws + A_X4B); bf16_t* xs = (bf16_t*)(ws + A_XS);
    const int tid = threadIdx.x, lane = tid & 63, wave = tid >> 6; const int gw = blockIdx.x * 8 + wave, NGW = gridDim.x * 8;
    unsigned pstart[8]; { unsigned acc = 0;
#pragma unroll
        for (int e = 0; e < 8; ++e) { pstart[e] = acc; acc += (cnt[e] + 255u) / 256u * 256u; } }
    for (int tb = gw; tb < M / 16; tb += NGW) {
        const int tok = tb * 16 + ((lane & 31) >> 1), slot = lane & 1; int e = -1; float w = 0.f;
        if (lane < 32) { const unsigned te = toke[tok]; const f32x2 tw = tokw[tok]; e = slot ? (int)((te >> 8) & 0xff) : (int)(te & 0xff); w = slot ? tw.y : tw.x; }
        int dest = 0;
#pragma unroll
        for (int q = 0; q < 8; ++q) { const unsigned long long mk = __ballot(e == q); if (mk) { unsigned bs = 0; if (lane == 0) bs = atomicAdd(&cur[q], (unsigned)__popcll(mk)); bs = __shfl(bs, 0);
                if (e == q) dest = (int)(pstart[q] + bs + (unsigned)__popcll(mk & ((1ull << lane) - 1ull))); } }
        if (lane < 32) { rs[dest] = tok; rd[dest] = tok * 2 + slot; rw[dest] = w; }
#pragma unroll 4
        for (int q = 0; q < 32; ++q) { const int dq = __shfl(dest, q); const int tq = tb * 16 + (q >> 1);
            const u32x4* src = (const u32x4*)(x4b + (size_t)tq * D); u32x4* dst = (u32x4*)(xs + (size_t)dq * D); dst[lane] = src[lane]; dst[lane + 64] = src[lane + 64]; }
    }
}
struct MoeSched {
    const char* A; const char* B; long tileA, tileB, strideE; int nN, nt; int G, c, lda, ldb; int pend[8]; int nblk;
    __device__ __forceinline__ void init(const unsigned* cnt) { int acc = 0;
#pragma unroll
        for (int e = 0; e < 8; ++e) { acc += (int)((cnt[e] + 255u) / 256u); pend[e] = acc; } nblk = acc; }
    __device__ __forceinline__ bool next(int i, Unit& u) const {
        const long L = (long)i * G + c; if (L >= (long)nblk * nN) return false;
        const int rb = (int)(L / nN), pn = (int)(L % nN); int e = 0;
#pragma unroll
        for (int q = 0; q < 7; ++q) e += (rb >= pend[q]) ? 1 : 0;
        u.pm = rb; u.pn = pn; u.job = e; u.A = A + (long)rb * tileA; u.B = B + (long)e * strideE + (long)pn * tileB; u.nt = nt; u.ksplit = 1 << 30; u.wrapA = 0; u.wrapB = 0; return true;
    }
};

__device__ __forceinline__ void cmp2_phase(const Params& P) {
    const In& I = P.in; unsigned char* ws = P.ws; const int lane = threadIdx.x & 63, wave = threadIdx.x >> 6; const int gw = blockIdx.x * 8 + wave, NGW = gridDim.x * 8;
    bf16_t* kcmp = (bf16_t*)(ws + A_KCMP); bf16_t* vcT = (bf16_t*)(ws + A_VCMPT);
    for (int o = gw; o < 2 * 8192; o += NGW) { const int j = o >> 13, row = o & 8191; const unsigned* hp = (const unsigned*)(ws + (j ? A_HCV : A_HCK)) + (size_t)row * 128; const float* w2 = I.b_phi_w2 + (size_t)j * 256 * 64;
        float acc = 0.f;
#pragma unroll 8
        for (int c2 = 0; c2 < 128; ++c2) { const unsigned w = hp[c2]; acc += bflo(w) * w2[(2 * c2) * 64 + lane] + bfhi(w) * w2[(2 * c2 + 1) * 64 + lane]; }
        const unsigned short hb = (unsigned short)(cvt_pk_bf16(acc, 0.f) & 0xffffu);
        if (j == 0) kcmp[(size_t)row * 64 + lane] = hb; else { const int bg = row >> 7, n = row & 127; vcT[((size_t)bg * 64 + lane) * 128 + n] = hb; } }
}
}
namespace fx {
__device__ __forceinline__ bf16x8 ldg8(const bf16_t* p) { return *(const bf16x8*)p; }
__device__ __forceinline__ bf16x8 ldg4x2(const bf16_t* p) { const bf16x4 a = *(const bf16x4*)p, b = *(const bf16x4*)(p + 8); return (bf16x8){a[0], a[1], a[2], a[3], b[0], b[1], b[2], b[3]}; }
__device__ __forceinline__ bf16x8 packp(const f32x16& p, int s2) { u32x4 w; w.x = cvt_pk_bf16(p[8 * s2 + 0], p[8 * s2 + 1]); w.y = cvt_pk_bf16(p[8 * s2 + 2], p[8 * s2 + 3]); w.z = cvt_pk_bf16(p[8 * s2 + 4], p[8 * s2 + 5]); w.w = cvt_pk_bf16(p[8 * s2 + 6], p[8 * s2 + 7]); return __builtin_bit_cast(bf16x8, w); }
__device__ __forceinline__ int or8(int v) { v |= __builtin_amdgcn_update_dpp(0, v, 0xB1, 0xF, 0xF, true); v |= __builtin_amdgcn_update_dpp(0, v, 0x4E, 0xF, 0xF, true); v |= __builtin_amdgcn_update_dpp(0, v, 0x141, 0xF, 0xF, true); return v; }
#define MFMA32(a, b, c) __builtin_amdgcn_mfma_f32_32x32x16_bf16((a), (b), (c), 0, 0, 0)
constexpr float SCL = 0.125f * LOG2E;

__device__ __forceinline__ void attn_tile(const bf16_t* kp, const bf16_t* vt, size_t vts, const bf16x8 (&qf)[4], int ql, int hh, bool mine, int key0, int t, int winlim, float& m, float& lsum, f32x16 (&o)[2]) {
    f32x16 sa;
#pragma unroll
    for (int i = 0; i < 16; ++i) sa[i] = 0.f;
#pragma unroll
    for (int s = 0; s < 4; ++s) sa = MFMA32(ldg8(kp + (size_t)ql * 64 + 16 * s + 8 * hh), qf[s], sa);
    float mt = -1e30f; bool vd[16];
#pragma unroll
    for (int i = 0; i < 16; ++i) { { const int key = key0 + (i & 3) + 8 * (i >> 2) + 4 * hh; vd[i] = mine && key <= t && (t - key) < winlim; } sa[i] = vd[i] ? sa[i] * SCL : -1e30f; mt = fmaxf(mt, sa[i]); }
    mt = fmaxf(mt, __shfl_xor(mt, 32)); const float mn = fmaxf(m, mt); const float alpha = __builtin_amdgcn_exp2f(m - mn); float ps = 0.f;
#pragma unroll
    for (int i = 0; i < 16; ++i) { sa[i] = vd[i] ? __builtin_amdgcn_exp2f(sa[i] - mn) : 0.f; ps += sa[i]; }
    lsum = lsum * alpha + ps; m = mn;
#pragma unroll
    for (int dt = 0; dt < 2; ++dt)
#pragma unroll
        for (int i = 0; i < 16; ++i) o[dt][i] *= alpha;
#pragma unroll
    for (int s2 = 0; s2 < 2; ++s2) { const bf16x8 pf = packp(sa, s2);
#pragma unroll
        for (int dt = 0; dt < 2; ++dt) o[dt] = MFMA32(ldg4x2(vt + (size_t)(dt * 32 + ql) * vts + 16 * s2 + 4 * hh), pf, o[dt]); }
}

__device__ __forceinline__ void attn_phase(const Params& P, LAS unsigned char* lds) {
    unsigned char* ws = P.ws;
    const bf16_t* q = (const bf16_t*)(ws + A_Q); const bf16_t* qr = (const bf16_t*)(ws + A_QR); const bf16_t* kcmp = (const bf16_t*)(ws + A_KCMP); const bf16_t* vcT = (const bf16_t*)(ws + A_VCMPT);
    const bf16_t* ks = (const bf16_t*)(ws + A_KS); const bf16_t* kw = (const bf16_t*)(ws + A_KW); const bf16_t* vts = (const bf16_t*)(ws + A_VTS); const bf16_t* vtw = vts + (size_t)256 * M;
    const float* gates = (const float*)(ws + A_GATES); bf16_t* att = (bf16_t*)(ws + A_ATT);
    LAS float* impw = (LAS float*)lds; LAS float* impf = impw + 8192; LAS unsigned* selm = (LAS unsigned*)(impf + 2048); LAS float* invs = (LAS float*)(selm + 64);
    const int tid = threadIdx.x, lane = tid & 63, wid = tid >> 6, r = wid & 3, c2 = wid >> 2, ql = lane & 31, hh = lane >> 5;
    for (int it = blockIdx.x; it < 2048; it += gridDim.x) {
        const int j = it >> 8, w = it & 255, wq = w >> 6; const int qb = 31 - ((j & 1) ? (3 - wq) : wq) - 4 * j; const int bg = w & 63, b = bg >> 2, g = bg & 3;
        const int head = g * 4 + r, t = qb * 64 + c2 * 32 + ql; const size_t qoff = (size_t)(b * T + t) * 1024 + head * 64;
        const float g0 = gates[(size_t)(b * T + t) * 64 + head * 3 + 0], g1 = gates[(size_t)(b * T + t) * 64 + head * 3 + 1], g2 = gates[(size_t)(b * T + t) * 64 + head * 3 + 2];
        f32x16 ot[2];
        {
            bf16x8 qf[4];
#pragma unroll
            for (int s = 0; s < 4; ++s) qf[s] = ldg8(q + qoff + 16 * s + 8 * hh);
            const bf16_t* kcb = kcmp + (size_t)bg * 128 * 64; const bf16_t* vcb = vcT + (size_t)bg * 64 * 128;
            float mt = -1e30f;
#pragma unroll 1
            for (int tl = 0; tl < 4; ++tl) { f32x16 a;
#pragma unroll
                for (int i = 0; i < 16; ++i) a[i] = 0.f;
#pragma unroll
                for (int s = 0; s < 4; ++s) a = MFMA32(ldg8(kcb + (size_t)(tl * 32 + ql) * 64 + 16 * s + 8 * hh), qf[s], a);
#pragma unroll
                for (int i = 0; i < 16; ++i) { const int n = tl * 32 + (i & 3) + 8 * (i >> 2) + 4 * hh; mt = fmaxf(mt, (n * 16 + 31 <= t) ? a[i] * SCL : -1e30f); } }
            mt = fmaxf(mt, __shfl_xor(mt, 32));
            float ls = 0.f, ecarry = 0.f; f32x16 oc[2];
#pragma unroll
            for (int dt = 0; dt < 2; ++dt)
#pragma unroll
                for (int i = 0; i < 16; ++i) oc[dt][i] = 0.f;
            LAS float* iw = impw + (size_t)(r * 64 + c2 * 32 + ql) * 32;
#pragma unroll 1
            for (int tl = 0; tl < 4; ++tl) { f32x16 a;
#pragma unroll
                for (int i = 0; i < 16; ++i) a[i] = 0.f;
#pragma unroll
                for (int s = 0; s < 4; ++s) a = MFMA32(ldg8(kcb + (size_t)(tl * 32 + ql) * 64 + 16 * s + 8 * hh), qf[s], a);
#pragma unroll
                for (int i = 0; i < 16; ++i) { const int n = tl * 32 + (i & 3) + 8 * (i >> 2) + 4 * hh; const float pv = (n * 16 + 31 <= t) ? __builtin_amdgcn_exp2f(a[i] * SCL - mt) : 0.f; a[i] = pv; ls += pv; }
                float ep[4];
#pragma unroll
                for (int gg = 0; gg < 4; ++gg) ep[gg] = __shfl_xor(a[4 * gg + 3], 32);
#pragma unroll
                for (int gg = 0; gg < 4; ++gg) { const float Gs = (a[4 * gg] + a[4 * gg + 1]) + (a[4 * gg + 2] + a[4 * gg + 3]);
                    const float eprev0 = gg > 0 ? ep[gg > 0 ? gg - 1 : 0] : ecarry; const float e = hh ? ep[gg] : eprev0; iw[tl * 8 + 2 * gg + hh] = Gs + e; }
                ecarry = ep[3];
#pragma unroll
                for (int s2 = 0; s2 < 2; ++s2) { const bf16x8 pf = packp(a, s2);
#pragma unroll
                    for (int dt = 0; dt < 2; ++dt) oc[dt] = MFMA32(ldg4x2(vcb + (size_t)(dt * 32 + ql) * 128 + tl * 32 + 16 * s2 + 4 * hh), pf, oc[dt]); } }
            ls += __shfl_xor(ls, 32); const float inv = ls > 0.f ? 1.f / ls : 0.f;
            if (hh == 0) invs[r * 64 + c2 * 32 + ql] = inv;
            const float sc0 = inv * g0;
#pragma unroll
            for (int dt = 0; dt < 2; ++dt)
#pragma unroll
                for (int i = 0; i < 16; ++i) ot[dt][i] = oc[dt][i] * sc0;
        }
        __syncthreads();
        {
            const int qq = tid >> 3, sg = tid & 7;
#pragma unroll
            for (int i = 0; i < 4; ++i) { const int s = sg * 4 + i; const float tot = ((impw[(0 * 64 + qq) * 32 + s] * invs[qq] + impw[(1 * 64 + qq) * 32 + s] * invs[64 + qq]) + impw[(2 * 64 + qq) * 32 + s] * invs[128 + qq]) + impw[(3 * 64 + qq) * 32 + s] * invs[192 + qq];
                const bool forced = (s == 0) || (s == qb) || (s == qb - 1); impf[qq * 32 + s] = forced ? 1e4f : (s <= qb ? tot : -1e30f); }
        }
        __syncthreads();
        {
            const int qq = tid >> 3, sg = tid & 7; float vals[32];
#pragma unroll
            for (int i = 0; i < 8; ++i) { const f32x4 x = *(const LAS f32x4*)(impf + qq * 32 + 4 * i); vals[4 * i] = x[0]; vals[4 * i + 1] = x[1]; vals[4 * i + 2] = x[2]; vals[4 * i + 3] = x[3]; }
            int bits = 0;
#pragma unroll
            for (int i = 0; i < 4; ++i) { int rank = 0;
                float own = 0.f;
#pragma unroll
                for (int s2 = 0; s2 < 32; ++s2) own = (s2 == sg * 4 + i) ? vals[s2] : own;
#pragma unroll
                for (int s2 = 0; s2 < 32; ++s2) rank += (vals[s2] > own || (vals[s2] == own && s2 < sg * 4 + i)) ? 1 : 0;
                bits |= (rank < 8) ? (1 << (sg * 4 + i)) : 0; }
            bits = or8(bits); if (sg == 0) selm[qq] = (unsigned)bits;
        }
        __syncthreads();
        const unsigned sel = selm[c2 * 32 + ql];
        bf16x8 qf[4];
#pragma unroll
        for (int s = 0; s < 4; ++s) qf[s] = ldg8(qr + qoff + 16 * s + 8 * hh);
#ifndef ATT_NO_SLC
        {
            float m = -1e30f, ls = 0.f; f32x16 o[2];
#pragma unroll
            for (int dt = 0; dt < 2; ++dt)
#pragma unroll
                for (int i = 0; i < 16; ++i) o[dt][i] = 0.f;
            const bf16_t* kb = ks + (size_t)bg * T * 64; const bf16_t* vb = vts + (size_t)(g * 64) * M + (size_t)b * T;
#pragma unroll 1
            for (int sb = 0; sb <= qb; ++sb) { const bool mine = (sel >> sb) & 1u; if (__ballot(mine) == 0ull) continue;
#pragma unroll 1
                for (int tl = 0; tl < 2; ++tl) { const int key0 = sb * 64 + tl * 32;
                    attn_tile(kb + (size_t)key0 * 64, vb + key0, (size_t)M, qf, ql, hh, mine, key0, t, 1 << 30, m, ls, o); } }
            ls += __shfl_xor(ls, 32); const float sc1 = ls > 0.f ? g1 / ls : 0.f;
#pragma unroll
            for (int dt = 0; dt < 2; ++dt)
#pragma unroll
                for (int i = 0; i < 16; ++i) ot[dt][i] += o[dt][i] * sc1;
        }
#endif
#ifndef ATT_NO_WIN
        {
            float m = -1e30f, ls = 0.f; f32x16 o[2];
#pragma unroll
            for (int dt = 0; dt < 2; ++dt)
#pragma unroll
                for (int i = 0; i < 16; ++i) o[dt][i] = 0.f;
            const bf16_t* kb = kw + (size_t)bg * T * 64; const bf16_t* vb = vtw + (size_t)(g * 64) * M + (size_t)b * T;
            const int t0 = qb * 64 + c2 * 32; const int kstart = t0 - 512 > 0 ? t0 - 512 : 0;
#pragma unroll 1
            for (int key0 = kstart; key0 <= t0; key0 += 32)
                attn_tile(kb + (size_t)key0 * 64, vb + key0, (size_t)M, qf, ql, hh, true, key0, t, 512, m, ls, o);
            ls += __shfl_xor(ls, 32); const float sc2 = ls > 0.f ? g2 / ls : 0.f;
#pragma unroll
            for (int dt = 0; dt < 2; ++dt)
#pragma unroll
                for (int i = 0; i < 16; ++i) ot[dt][i] += o[dt][i] * sc2;
        }
#endif
#pragma unroll
        for (int dt = 0; dt < 2; ++dt)
#pragma unroll
            for (int g4 = 0; g4 < 4; ++g4) { u32x2 wv; wv.x = cvt_pk_bf16(ot[dt][4 * g4], ot[dt][4 * g4 + 1]); wv.y = cvt_pk_bf16(ot[dt][4 * g4 + 2], ot[dt][4 * g4 + 3]);
                *(u32x2*)(att + qoff + dt * 32 + 8 * g4 + 4 * hh) = wv; }
    }
}

__device__ __forceinline__ JobD job(const void* A, const void* B, long tileA, long tileB, int nM, int nN, int nt) { JobD j; j.A = (const char*)A; j.B = (const char*)B; j.tileA = tileA; j.tileB = tileB; j.nM = nM; j.nN = nN; j.nt = nt; j.ksplit = 1 << 30; j.wrapA = 0; j.wrapB = 0; j.batchA = 0; j.batchB = 0; j.shA = 0; j.shB = 0; return j; }
constexpr int NPHASE = 23;
constexpr int LDS_BYTES = 147456;
__global__ void __launch_bounds__(512, 2) mega(Params P) {
    extern __shared__ __attribute__((aligned(16))) unsigned char lds_raw[];
    LAS unsigned char* lds = (LAS unsigned char*)lds_raw;
    cooperative_groups::grid_group grid = cooperative_groups::this_grid();
    const In& I = P.in; unsigned char* ws = P.ws; const int G = gridDim.x, c = blockIdx.x;
    const int lo = P.ph_lo, hi = P.ph_hi;
#ifndef PHMASK
#define PHMASK 0xffffffffu
#endif
#define IN(k) ((((PHMASK) >> (k)) & 1u) && lo <= (k) && (k) < hi)
#define SEAM(k) do { if (IN(k) && IN((k) + 1)) grid.sync(); } while (0)
    const long T1K = 256L * 1024 * 2;
    if (IN(0)) { prep_phase(P, lds); } SEAM(0);
    if (IN(1)) { StaticSched S; S.G = G; S.c = c; S.lda = 2048; S.ldb = 2048; S.nj = 2;
        S.j0 = job(ws + A_MIX, ws + W_RKV, T1K, T1K, 384, 4, 16); S.j0.shB = 7; S.j0.batchB = 2 * MiB;
        S.j1 = job((unsigned char*)P.out + O_XB + 2048, ws + W_L1, T1K, T1K, 128, 1, 32); S.j1.ksplit = 16; S.j1.wrapA = -(16L * 128 + 2048); S.j1.wrapB = 256L * 1024 * 2 - 16L * 128; S.j1.shA = 3; S.j1.batchA = 2048;
        EpiP1 E{(bf16_t*)(ws + A_RKV), (bf16_t*)((unsigned char*)P.out + O_HL)};
        gemm_phase(lds, S, E); } SEAM(1);
    if (IN(2)) { StaticSched S; S.G = G; S.c = c; S.lda = 512; S.ldb = 512; S.nj = 1; S.j0 = job((unsigned char*)P.out + O_HL, ws + W_L2, 256L * 256 * 2, 256L * 256 * 2, 128, 12, 4); S.j1 = S.j0;
        EpiP2 E{(bf16_t*)(ws + A_WAG), I.a_w0, I.a_a0}; gemm_phase(lds, S, E); } SEAM(2);
    if (IN(3)) { scan_phase(P, lds); } SEAM(3);
    if (IN(4)) { StaticSched S; S.G = G; S.c = c; S.lda = 2048; S.ldb = 2048; S.nj = 1; S.j0 = job(ws + A_RKV, ws + W_AO, T1K, T1K, 128, 4, 16); S.j1 = S.j0; EpiResid E{I.x, P.out}; gemm_phase(lds, S, E); } SEAM(4);
    if (IN(5)) { ln_phase(P, lds, 0, (bf16_t*)(ws + A_X1B), nullptr, false, nullptr, nullptr); } SEAM(5);
    if (IN(6)) { StaticSched S; S.G = G; S.c = c; S.lda = 2048; S.ldb = 2048; S.nj = 1; S.j0 = job(ws + A_X1B, ws + W_FGU, T1K, T1K, 128, 22, 16); S.j1 = S.j0; EpiGlu E{(bf16_t*)(ws + A_H), DFF}; gemm_phase(lds, S, E); } SEAM(6);
    if (IN(7)) { StaticSched S; S.G = G; S.c = c; S.lda = DFF * 2; S.ldb = DFF * 2; S.nj = 1; S.j0 = job(ws + A_H, ws + W_FDN, 256L * DFF * 2, 256L * DFF * 2, 128, 4, 44); S.j1 = S.j0; EpiResid E{P.out, P.out}; gemm_phase(lds, S, E); } SEAM(7);
    if (IN(8)) { ln_phase(P, lds, 1, (bf16_t*)(ws + A_X2B), nullptr, false, I.p, (bf16_t*)(ws + A_PB0)); } SEAM(8);
    if (IN(9)) { StaticSched S; S.G = G; S.c = c; S.lda = 512; S.ldb = 512; S.nj = 1; S.j0 = job(ws + A_PB0, ws + W_PLE, 256L * 256 * 2, 256L * 256 * 2, 128, 4, 4); S.j1 = S.j0; EpiBf16 E{(bf16_t*)(ws + A_PP0), nullptr, 1024, nullptr, nullptr, 0}; gemm_phase(lds, S, E); } SEAM(9);
    if (IN(10)) { StaticSched S; S.G = G; S.c = c; S.lda = 2048; S.ldb = 2048; S.nj = 1; S.j0 = job(ws + A_X2B, ws + W_GATE, T1K, T1K, 128, 4, 16); S.j1 = S.j0; EpiGate E{P.out, (const bf16_t*)(ws + A_PP0), I.ple_gate_b, (bf16_t*)(ws + A_X3B)}; gemm_phase(lds, S, E); } SEAM(10);
    if (IN(11)) { StaticSched S; S.G = G; S.c = c; S.lda = 2048; S.ldb = 2048; S.nj = 2; S.j0 = job(ws + A_X3B, ws + W_NSA, T1K, T1K, 128, 9, 16); S.j1 = job(ws + W_VT, ws + A_X3B, T1K, T1K, 2, 128, 16);
        EpiNsa E{ws}; gemm_phase(lds, S, E); } SEAM(11);
    if (IN(12)) { StaticSched S; S.G = G; S.c = c; S.lda = 2048; S.ldb = 4096; S.nj = 2; S.j0 = job(ws + A_KC, ws + W_PHI, T1K, 256L * 2048 * 2, 32, 1, 32); S.j1 = job(ws + A_VC, ws + W_PHI + MiB, T1K, 256L * 2048 * 2, 32, 1, 32);
        EpiBf16 E{(bf16_t*)(ws + A_HCK), (bf16_t*)(ws + A_HCV), 256, (const float*)(ws + X_CB), (const float*)(ws + X_CB) + 256, 1}; gemm_phase(lds, S, E); } SEAM(12);
    if (IN(13)) { cmp2_phase(P); } SEAM(13);
    if (IN(14)) { attn_phase(P, lds); } SEAM(14);
    if (IN(15)) { StaticSched S; S.G = G; S.c = c; S.lda = 2048; S.ldb = 2048; S.nj = 1; S.j0 = job(ws + A_ATT, ws + W_BO, T1K, T1K, 128, 4, 16); S.j1 = S.j0; EpiResid E{P.out, P.out}; gemm_phase(lds, S, E); } SEAM(15);
    if (IN(16)) { ln_phase(P, lds, 2, (bf16_t*)(ws + A_X4B), nullptr, true, nullptr, nullptr); } SEAM(16);
    if (IN(17)) { moe_gather_phase(P); } SEAM(17);
    if (IN(18)) { MoeSched S; S.A = (const char*)(ws + A_XS); S.B = (const char*)(ws + W_MGU); S.tileA = T1K; S.tileB = T1K; S.strideE = 2816L * 1024 * 2; S.nN = 11; S.nt = 16; S.G = G; S.c = c; S.lda = 2048; S.ldb = 2048; S.init((const unsigned*)(ws + X_CTL) + CW_CNT);
        EpiGlu E{(bf16_t*)(ws + A_HM), DFE}; gemm_phase(lds, S, E); } SEAM(18);
    if (IN(19)) { MoeSched S; S.A = (const char*)(ws + A_HM); S.B = (const char*)(ws + W_MDN); S.tileA = 256L * DFE * 2; S.tileB = 256L * DFE * 2; S.strideE = 1024L * DFE * 2; S.nN = 4; S.nt = 22; S.G = G; S.c = c; S.lda = DFE * 2; S.ldb = DFE * 2; S.init((const unsigned*)(ws + X_CTL) + CW_CNT);
        EpiMoeDown E{(bf16_t*)(ws + A_YS2), (const int*)(ws + X_RDST), (const float*)(ws + X_RW)}; gemm_phase(lds, S, E); } SEAM(19);
    if (IN(20)) { ln_phase(P, lds, 3, (bf16_t*)(ws + A_X5B), (const bf16_t*)(ws + A_YS2), false, I.p + (size_t)M * PLE, (bf16_t*)(ws + A_PB1)); } SEAM(20);
    if (IN(21)) { StaticSched S; S.G = G; S.c = c; S.lda = 512; S.ldb = 512; S.nj = 1; S.j0 = job(ws + A_PB1, ws + W_PLE + MiB / 2, 256L * 256 * 2, 256L * 256 * 2, 128, 4, 4); S.j1 = S.j0; EpiBf16 E{(bf16_t*)(ws + A_PP1), nullptr, 1024, nullptr, nullptr, 0}; gemm_phase(lds, S, E); } SEAM(21);
    if (IN(22)) { StaticSched S; S.G = G; S.c = c; S.lda = 2048; S.ldb = 2048; S.nj = 1; S.j0 = job(ws + A_X5B, ws + W_GATE + 2 * MiB, T1K, T1K, 128, 4, 16); S.j1 = S.j0; EpiGate E{P.out, (const bf16_t*)(ws + A_PP1), I.ple_gate_b + D, nullptr}; gemm_phase(lds, S, E); }
#undef IN
#undef SEAM
}

static int g_grid = 0;
static bool fast_setup(size_t ws_size) {
    if (g_grid) return g_grid > 0;
    int dev = 0, cus = 0, per_cu = 0;
    if (ws_size < WS_NEED) { fprintf(stderr, "kernel_launch: workspace too small: %zu < %zu\n", ws_size, (size_t)WS_NEED); g_grid = -1; return false; }
    (void)hipGetDevice(&dev); (void)hipDeviceGetAttribute(&cus, hipDeviceAttributeMultiprocessorCount, dev);
    if (hipFuncSetAttribute((const void*)mega, hipFuncAttributeMaxDynamicSharedMemorySize, LDS_BYTES) != hipSuccess) { fprintf(stderr, "hipFuncSetAttribute failed\n"); g_grid = -1; return false; }
    if (hipOccupancyMaxActiveBlocksPerMultiprocessor(&per_cu, (const void*)mega, 512, LDS_BYTES) != hipSuccess || per_cu < 1) { fprintf(stderr, "occupancy query failed (%d)\n", per_cu); g_grid = -1; return false; }
    g_grid = cus * 1;
    fprintf(stderr, "fast_setup: cus %d per_cu %d grid %d ws %zu need %zu\n", cus, per_cu, g_grid, ws_size, (size_t)WS_NEED);
    return true;
}
static void fast_launch(void* const* d_in, void* d_out, void* d_ws, hipStream_t stream, int lo, int hi) {
    Params p{}; const float** f = (const float**)&p.in; for (int i = 0; i < 36; ++i) f[i] = (const float*)d_in[i];
    p.out = (float*)d_out; p.ws = (unsigned char*)d_ws; p.ph_lo = lo; p.ph_hi = hi;
    void* args[] = {&p};
    hipError_t e = hipLaunchCooperativeKernel((const void*)mega, dim3(g_grid), dim3(512), args, LDS_BYTES, stream);
    if (e != hipSuccess) fprintf(stderr, "cooperative launch failed: %s (grid %d)\n", hipGetErrorString(e), g_grid);
}
}
extern "C" void kernel_launch(void* const* d_in, const int* in_sizes, int n_in, void* d_out, int out_size, void* d_ws, size_t ws_size, hipStream_t stream) {
    if (!fx::fast_setup(ws_size)) return;
    (void)hipMemsetAsync((char*)d_ws + fx::X_CTL, 0, 65536, stream);
#if defined(PER_PHASE)
    for (int ph = 0; ph < fx::NPHASE; ++ph) fx::fast_launch(d_in, d_out, d_ws, stream, ph, ph + 1);
#else
    fx::fast_launch(d_in, d_out, d_ws, stream, 0, fx::NPHASE);
#endif
}
```

```cpp
#include <hip/hip_runtime.h>
#include <hip/hip_cooperative_groups.h>
#include <cstdio>
#include <cstdint>
namespace fx {
#define LAS __attribute__((address_space(3)))
typedef unsigned short bf16_t;
typedef short bf16x8 __attribute__((ext_vector_type(8)));
typedef short bf16x4 __attribute__((ext_vector_type(4)));
typedef float f32x4 __attribute__((ext_vector_type(4)));
typedef float f32x2 __attribute__((ext_vector_type(2)));
typedef float f32x16 __attribute__((ext_vector_type(16)));
typedef unsigned u32x4 __attribute__((ext_vector_type(4)));
typedef unsigned u32x2 __attribute__((ext_vector_type(2)));
typedef _Float16 h16x4 __attribute__((ext_vector_type(4)));
__device__ __forceinline__ f32x4 ldh4(const _Float16* p) { const h16x4 h = *(const h16x4*)p; return __builtin_convertvector(h, f32x4); }
__device__ __forceinline__ void sth4(_Float16* p, const f32x4 v) { *(h16x4*)p = __builtin_convertvector(v, h16x4); }

constexpr int D = 1024, NB = 16, T = 2048, M = NB * T, PLE = 256;
constexpr int DFF = 2816, DFE = 1408, NE = 8;
constexpr int XBT = T + 1;
constexpr int MOE_ROWS_MAX = 264 * 256;
constexpr float ALPHA = 1.4142135623730951f, LN_EPS = 1e-5f, GN_EPS = 64e-5f;
constexpr float LOG2E = 1.4426950408889634f;

constexpr size_t MiB = 1u << 20;
constexpr size_t W_RKV = 0;
constexpr size_t W_L1 = W_RKV + 3 * 2 * MiB;
constexpr size_t W_L2 = W_L1 + 1 * MiB;
constexpr size_t W_AO = W_L2 + 3 * MiB / 2;
constexpr size_t W_FGU = W_AO + 2 * MiB;
constexpr size_t W_FDN = W_FGU + 11 * MiB;
constexpr size_t W_PLE = W_FDN + 11 * MiB / 2;
constexpr size_t W_GATE = W_PLE + 1 * MiB;
constexpr size_t W_NSA = W_GATE + 4 * MiB;
constexpr size_t W_VT = W_NSA + 9 * MiB / 2;
constexpr size_t W_PHI = W_VT + 1 * MiB;
constexpr size_t W_BO = W_PHI + 2 * MiB;
constexpr size_t W_MGU = W_BO + 2 * MiB;
constexpr size_t W_MDN = W_MGU + 44 * MiB;
constexpr size_t W_END = 108 * MiB;
static_assert(W_MDN + 22 * MiB <= W_END, "weights");
constexpr size_t X_CTL = W_END;
constexpr size_t X_BAR = X_CTL + 16 * 1024;
constexpr size_t X_CS = X_CTL + 64 * 1024;
constexpr size_t X_CB = X_CS + 512 * 1024;
constexpr size_t X_TOKE = X_CB + 4096;
constexpr size_t X_TOKW = X_TOKE + (size_t)M * 4;
constexpr size_t X_RSRC = X_TOKW + (size_t)M * 8;
constexpr size_t X_RDST = X_RSRC + (size_t)MOE_ROWS_MAX * 4;
constexpr size_t X_RW = X_RDST + (size_t)MOE_ROWS_MAX * 4;
constexpr size_t X_STAT = X_RW + (size_t)MOE_ROWS_MAX * 4;
constexpr size_t X_END = X_STAT + (size_t)4 * M * 8;
static_assert(X_END <= W_END + 12 * MiB, "misc");
constexpr size_t ACT = W_END + 12 * MiB;
constexpr size_t A_MIX = ACT + 0 * MiB;
constexpr size_t O_XB = 0, O_HL = 66 * MiB;
constexpr size_t A_RKV = ACT + 192 * MiB;
constexpr size_t A_WAG = ACT + 0 * MiB;
constexpr size_t A_X1B = ACT + 0 * MiB, A_H = ACT + 64 * MiB, A_X2B = ACT + 0 * MiB, A_PB0 = ACT + 240 * MiB, A_PP0 = ACT + 64 * MiB, A_X3B = ACT + 128 * MiB;
constexpr size_t A_KC = ACT + 0 * MiB, A_VC = ACT + 17 * MiB, A_KS = ACT + 34 * MiB, A_KW = ACT + 50 * MiB, A_VTS = ACT + 66 * MiB  , A_GATES = ACT + 98 * MiB;
constexpr size_t A_HCP = ACT + 320 * MiB;
constexpr size_t A_HCK = ACT + 106 * MiB, A_HCV = ACT + 110 * MiB, A_KCMP = ACT + 114 * MiB, A_VCMPT = ACT + 115 * MiB;
constexpr size_t A_Q = ACT + 192 * MiB, A_QR = ACT + 256 * MiB, A_ATT = ACT + 128 * MiB;
constexpr size_t A_X4B = ACT + 320 * MiB, A_XS = ACT + 0 * MiB, A_HM = ACT + 132 * MiB, A_YS2 = ACT + 0 * MiB, A_X5B = ACT + 320 * MiB, A_PB1 = W_RKV  , A_PP1 = ACT + 192 * MiB;
constexpr size_t A_STREAM2 = ACT + 256 * MiB;
constexpr size_t WS_NEED = ACT + 385 * MiB;
constexpr int CW_CNT = 0;
constexpr int CW_CUR = 16;
constexpr int CW_DBG = 64;

__device__ __forceinline__ unsigned cvt_pk_bf16(float lo, float hi) { unsigned r; asm volatile("v_cvt_pk_bf16_f32 %0, %1, %2" : "=v"(r) : "v"(lo), "v"(hi)); return r; }
__device__ __forceinline__ float bf2f(unsigned short b) { return __uint_as_float(((unsigned)b) << 16); }
__device__ __forceinline__ float bflo(unsigned w) { return __uint_as_float(w << 16); }
__device__ __forceinline__ float bfhi(unsigned w) { return __uint_as_float(w & 0xffff0000u); }
__device__ __forceinline__ float sigmoid_f(float x) { return 1.f / (1.f + __expf(-x)); }
__device__ __forceinline__ float wave_sum(float v) {
#pragma unroll
    for (int o = 1; o < 64; o <<= 1) v += __shfl_xor(v, o);
    return v;
}
__device__ __forceinline__ float dpp_xor1(float v) { return __builtin_bit_cast(float, __builtin_amdgcn_update_dpp(0, __builtin_bit_cast(int, v), 0xB1, 0xF, 0xF, true)); }
__device__ __forceinline__ float dpp_xor2(float v) { return __builtin_bit_cast(float, __builtin_amdgcn_update_dpp(0, __builtin_bit_cast(int, v), 0x4E, 0xF, 0xF, true)); }
__device__ __forceinline__ float dpp_hmir(float v) { return __builtin_bit_cast(float, __builtin_amdgcn_update_dpp(0, __builtin_bit_cast(int, v), 0x141, 0xF, 0xF, true)); }
__device__ __forceinline__ float max8(float v) { v = fmaxf(v, dpp_xor1(v)); v = fmaxf(v, dpp_xor2(v)); v = fmaxf(v, dpp_hmir(v)); return v; }
__device__ __forceinline__ int imin8(int v) { int t = __builtin_amdgcn_update_dpp(0, v, 0xB1, 0xF, 0xF, true); v = t < v ? t : v; t = __builtin_amdgcn_update_dpp(0, v, 0x4E, 0xF, 0xF, true); v = t < v ? t : v; t = __builtin_amdgcn_update_dpp(0, v, 0x141, 0xF, 0xF, true); v = t < v ? t : v; return v; }
__device__ __forceinline__ float dpp_ror8(float v) { return __builtin_bit_cast(float, __builtin_amdgcn_update_dpp(0, __builtin_bit_cast(int, v), 0x128, 0xF, 0xF, true)); }
__device__ __forceinline__ float sum16(float v) { v += dpp_xor1(v); v += dpp_xor2(v); v += dpp_hmir(v); v += dpp_ror8(v); return v; }
__device__ __forceinline__ float xhalf(float v) { return __shfl_xor(v, 32); }
__device__ __forceinline__ float max_xhalf(float v) { return fmaxf(v, __shfl_xor(v, 32)); }
__device__ __forceinline__ float sum_xhalf(float v) { return v + __shfl_xor(v, 32); }
__device__ __forceinline__ float sum8(float v) { v += dpp_xor1(v); v += dpp_xor2(v); v += dpp_hmir(v); return v; }

constexpr int BM = 256, BK = 64, HALF = 128, HTB = HALF * BK * 2, STAGE_BYTES = 8 * HTB, NXCD = 8, WGM = 8;
__host__ __device__ __forceinline__ int lds_byte(int r, int c) { const int st = (r >> 4) * 2 + (c >> 5), rr = r & 15, cc = c & 31, ob = rr * 64 + cc * 2; return st * 1024 + (ob ^ (((ob >> 9) & 1) << 5)); }
__host__ __device__ __forceinline__ void stage_rc(int b, int& R, int& C) { const int st = b / 1024, sb = b % 1024, swz = sb ^ (((sb >> 9) & 1) << 5); R = (st >> 1) * 16 + swz / 64; C = (st & 1) * 32 + (swz % 64) / 2; }
__host__ __device__ __forceinline__ int perm32(int rho) { const int n = rho >> 4, i = rho & 15; return 8 * (i >> 2) + 4 * n + (i & 3); }

struct Unit {
    const char* A;
    const char* B;
    int nt;
    int ksplit;
    long wrapA, wrapB;
    int pm, pn, job;
};
__device__ __forceinline__ const char* ktA(const Unit& u, int t) { return u.A + (long)t * (BK * 2) + (t >= u.ksplit ? u.wrapA : 0L); }
__device__ __forceinline__ const char* ktB(const Unit& u, int t) { return u.B + (long)t * (BK * 2) + (t >= u.ksplit ? u.wrapB : 0L); }

struct JobD { const char* A; const char* B; long tileA, tileB; int nM, nN, nt, ksplit; long wrapA, wrapB, batchA, batchB, tileBm; int shA, shB; };
struct StaticSched {
    JobD j0, j1; int nj; int G, c; int lda, ldb;
    __device__ __forceinline__ bool next(int i, Unit& u) const {
        long L = (long)i * G + c; const long n0 = (long)j0.nM * j0.nN; const bool second = (nj > 1) && (L >= n0);
        if (second) L -= n0;
        const int nM = second ? j1.nM : j0.nM, nN = second ? j1.nN : j0.nN;
        const int nwg = nM * nN; if (L >= nwg) return false;
        int wgid = (int)L; { const int qq = nwg / NXCD, r = nwg % NXCD, xcd = wgid % NXCD, off = wgid / NXCD; wgid = (xcd < r ? xcd * (qq + 1) : r * (qq + 1) + (xcd - r) * qq) + off; }
        const int nig = WGM * nN, gid = wgid / nig, fm = gid * WGM, gsz = (nM - fm) < WGM ? (nM - fm) : WGM;
        u.pm = fm + ((wgid % nig) % gsz); u.pn = (wgid % nig) / gsz; u.job = second ? 1 : 0;
        if (second) { u.A = j1.A + (long)u.pm * j1.tileA + (long)(u.pm >> j1.shA) * j1.batchA; u.B = j1.B + (long)u.pn * j1.tileB + (long)(u.pm >> j1.shB) * j1.batchB + (long)u.pm * j1.tileBm; u.nt = j1.nt; u.ksplit = j1.ksplit; u.wrapA = j1.wrapA; u.wrapB = j1.wrapB; }
        else { u.A = j0.A + (long)u.pm * j0.tileA + (long)(u.pm >> j0.shA) * j0.batchA; u.B = j0.B + (long)u.pn * j0.tileB + (long)(u.pm >> j0.shB) * j0.batchB + (long)u.pm * j0.tileBm; u.nt = j0.nt; u.ksplit = j0.ksplit; u.wrapA = j0.wrapA; u.wrapB = j0.wrapB; }
        return true;
    }
};

template <class Epi, class Sched>
__device__ __forceinline__ void gemm_phase(LAS unsigned char* lds, const Sched& S, const Epi& E) {
    const int tid = threadIdx.x, wid = __builtin_amdgcn_readfirstlane(tid >> 6), lane = tid & 63, wr = wid >> 2, wc = wid & 3, fr = lane & 15, fq = lane >> 4;
    unsigned voffA[2], voffB[2];
#pragma unroll
    for (int i = 0; i < 2; ++i) { int R, C; stage_rc(tid * 16 + i * 8192, R, C); const int Rb = Epi::PERM ? ((R & ~31) + perm32(R & 31)) : R;
        voffA[i] = (unsigned)(R * S.lda + C * 2); voffB[i] = (unsigned)(Rb * S.ldb + C * 2); }
    const size_t hstepA = (size_t)HALF * S.lda, hstepB = (size_t)HALF * S.ldb;
    const unsigned ldsw = (unsigned)wid * 1024u;
    const int aoff = lds_byte(wr * 64 + fr, fq * 8), boff = lds_byte(wc * 32 + fr, fq * 8);
#define PG8_SA(b, h) (((b) * 2 + (h)) * HTB)
#define PG8_SB(b, h) ((4 + (b) * 2 + (h)) * HTB)
#define PG8_STAGE(bufoff, gbase, voff) do { _Pragma("unroll") for (int _i = 0; _i < 2; ++_i) \
        __builtin_amdgcn_global_load_lds((const unsigned*)((const char*)(gbase) + (voff)[_i]), (LAS unsigned*)(lds + (bufoff) + ldsw + _i * 8192), 16, 0, 0); } while (0)
#define PG8_LDA(dst, b, h) do { _Pragma("unroll") for (int m = 0; m < 4; ++m) _Pragma("unroll") for (int k = 0; k < 2; ++k) dst[m][k] = *(const LAS bf16x8*)(lds + PG8_SA(b, h) + aoff + m * 2048 + k * 1024); } while (0)
#define PG8_LDB(dst, b, h) do { _Pragma("unroll") for (int n = 0; n < 2; ++n) _Pragma("unroll") for (int k = 0; k < 2; ++k) dst[n][k] = *(const LAS bf16x8*)(lds + PG8_SB(b, h) + boff + n * 2048 + k * 1024); } while (0)
#define PG8_MMA(ai, bj, At, Bt) do { __builtin_amdgcn_s_setprio(1); _Pragma("unroll") for (int m = 0; m < 4; ++m) _Pragma("unroll") for (int n = 0; n < 2; ++n) _Pragma("unroll") for (int k = 0; k < 2; ++k) \
        acc[ai][bj][m][n] = __builtin_amdgcn_mfma_f32_16x16x32_bf16(Bt[n][k], At[m][k], acc[ai][bj][m][n], 0, 0, 0); __builtin_amdgcn_s_setprio(0); } while (0)
#define PG8_WAIT_V(n) asm volatile("s_waitcnt vmcnt(" #n ")" ::: "memory")
#define PG8_WAIT_L(n) asm volatile("s_waitcnt lgkmcnt(" #n ")" ::: "memory")
#define PG8_BAR __builtin_amdgcn_s_barrier()
#define PG8_SCHED __builtin_amdgcn_sched_barrier(0)
    Unit cur, nxt; int ui = 0;
    if (!S.next(0, cur)) return;
    f32x4 acc[2][2][4][2];
#pragma unroll
    for (int a = 0; a < 2; ++a)
#pragma unroll
        for (int b = 0; b < 2; ++b)
#pragma unroll
            for (int m = 0; m < 4; ++m)
#pragma unroll
                for (int n = 0; n < 2; ++n) acc[a][b][m][n] = (f32x4){0.f, 0.f, 0.f, 0.f};
    bf16x8 At[4][2], B0[2][2], B1[2][2];
    {
        const char* cA = ktA(cur, 0); const char* cB = ktB(cur, 0); const char* cA1 = ktA(cur, 1); const char* cB1 = ktB(cur, 1);
        PG8_STAGE(PG8_SB(0, 0), cB, voffB); PG8_STAGE(PG8_SB(0, 1), cB + hstepB, voffB); PG8_STAGE(PG8_SA(0, 0), cA, voffA); PG8_STAGE(PG8_SA(0, 1), cA + hstepA, voffA);
        if (wr == 1) PG8_BAR;
        PG8_WAIT_V(2); PG8_BAR;
        PG8_STAGE(PG8_SB(1, 0), cB1, voffB); PG8_STAGE(PG8_SA(1, 0), cA1, voffA); PG8_STAGE(PG8_SB(1, 1), cB1 + hstepB, voffB);
        PG8_WAIT_V(6); PG8_BAR;
    }
    for (;;) {
        const bool has_next = S.next(ui + 1, nxt);
        if (!has_next) nxt = cur;
        const int nt = cur.nt;
        for (int t = 0; t < nt; t += 2) {
            const bool last = (t == nt - 2);
            const char* a1 = ktA(cur, t + 1);
            const char* a2 = last ? ktA(nxt, 0) : ktA(cur, t + 2); const char* b2 = last ? ktB(nxt, 0) : ktB(cur, t + 2);
            const char* a3 = last ? ktA(nxt, 1) : ktA(cur, t + 3); const char* b3 = last ? ktB(nxt, 1) : ktB(cur, t + 3);
            PG8_LDB(B0, 0, 0); PG8_LDB(B1, 0, 1); PG8_SCHED; PG8_LDA(At, 0, 0); PG8_STAGE(PG8_SA(1, 1), a1 + hstepA, voffA);
            PG8_WAIT_V(8); PG8_WAIT_L(0); PG8_BAR; PG8_MMA(0, 0, At, B0); PG8_MMA(0, 1, At, B1); PG8_BAR; PG8_SCHED;
            PG8_LDA(At, 0, 1); PG8_STAGE(PG8_SB(0, 0), b2, voffB); PG8_STAGE(PG8_SB(0, 1), b2 + hstepB, voffB); PG8_STAGE(PG8_SA(0, 0), a2, voffA);
            PG8_WAIT_V(8); PG8_WAIT_L(0); PG8_BAR; PG8_MMA(1, 0, At, B0); PG8_MMA(1, 1, At, B1); PG8_BAR; PG8_SCHED;
            PG8_LDB(B0, 1, 0); PG8_LDB(B1, 1, 1); PG8_SCHED; PG8_LDA(At, 1, 0); PG8_STAGE(PG8_SA(0, 1), a2 + hstepA, voffA);
            PG8_WAIT_V(8); PG8_WAIT_L(0); PG8_BAR; PG8_MMA(0, 0, At, B0); PG8_MMA(0, 1, At, B1); PG8_BAR; PG8_SCHED;
            PG8_LDA(At, 1, 1); PG8_STAGE(PG8_SB(1, 0), b3, voffB); PG8_STAGE(PG8_SB(1, 1), b3 + hstepB, voffB); PG8_STAGE(PG8_SA(1, 0), a3, voffA);
            PG8_WAIT_V(8); PG8_WAIT_L(0); PG8_BAR; PG8_MMA(1, 0, At, B0); PG8_MMA(1, 1, At, B1); PG8_BAR; PG8_SCHED;
        }
        if (wr == 0) PG8_BAR;
        E(acc, cur, wr, wc, fr, fq);
        if (!has_next) break;
#pragma unroll
        for (int a = 0; a < 2; ++a)
#pragma unroll
            for (int b = 0; b < 2; ++b)
#pragma unroll
                for (int m = 0; m < 4; ++m)
#pragma unroll
                    for (int n = 0; n < 2; ++n) acc[a][b][m][n] = (f32x4){0.f, 0.f, 0.f, 0.f};
        cur = nxt; ++ui;
        if (wr == 1) PG8_BAR;
    }
    PG8_WAIT_V(0);
    PG8_BAR;
#undef PG8_SA
#undef PG8_SB
#undef PG8_STAGE
#undef PG8_LDA
#undef PG8_LDB
#undef PG8_MMA
#undef PG8_WAIT_V
#undef PG8_WAIT_L
#undef PG8_BAR
#undef PG8_SCHED
}
}
namespace fx {
typedef const f32x4 (&AccRef)[2][2][4][2];

__device__ __forceinline__ u32x4 pack8(const f32x4 v0, const f32x4 v1) { u32x4 w; w.x = cvt_pk_bf16(v0[0], v0[1]); w.y = cvt_pk_bf16(v0[2], v0[3]); w.z = cvt_pk_bf16(v1[0], v1[1]); w.w = cvt_pk_bf16(v1[2], v1[3]); return w; }
__device__ __forceinline__ f32x4 tanh4(f32x4 v) { f32x4 o;
#pragma unroll
    for (int i = 0; i < 4; ++i) { const float e = __expf(2.f * v[i]); o[i] = 1.f - 2.f * __builtin_amdgcn_rcpf(e + 1.f); } return o; }
__device__ __forceinline__ f32x4 sigm4(f32x4 v) { f32x4 o;
#pragma unroll
    for (int i = 0; i < 4; ++i) o[i] = __builtin_amdgcn_rcpf(1.f + __expf(-v[i])); return o; }
__device__ __forceinline__ f32x4 gelu4(f32x4 v) { f32x4 o;
#pragma unroll
    for (int i = 0; i < 4; ++i) { const float x = v[i]; const float u = 0.7978845608028654f * (x + 0.044715f * x * x * x); const float e = __expf(2.f * u); const float th = 1.f - 2.f * __builtin_amdgcn_rcpf(e + 1.f); o[i] = 0.5f * x * (1.f + th); } return o; }

struct EpiP1 {
    static constexpr bool PERM = true;
    bf16_t* rkv; bf16_t* hl;
    __device__ __forceinline__ void operator()(AccRef acc, const Unit& u, int wr, int wc, int fr, int fq) const {
        const int row0 = u.pm * BM + wr * 64 + fr;
        bf16_t* base = u.job == 0 ? rkv : hl;
        const int ldc = u.job == 1 ? 256 : 1024;
        const int col0 = u.pn * BM + wc * 32 + 8 * fq;
#pragma unroll
        for (int ai = 0; ai < 2; ++ai)
#pragma unroll
            for (int m = 0; m < 4; ++m) { bf16_t* rowp = base + (size_t)(row0 + ai * HALF + m * 16) * ldc + col0;
#pragma unroll
                for (int bj = 0; bj < 2; ++bj) { f32x4 v0 = acc[ai][bj][m][0], v1 = acc[ai][bj][m][1];
                    if (u.job == 1) { if (bj == 1) { v0 = sigm4(v0); v1 = sigm4(v1); } else if (wc < 2) { v0 = tanh4(v0); v1 = tanh4(v1); } }
                    *(u32x4*)(rowp + bj * HALF) = pack8(v0, v1); } }
    }
};
struct EpiP2 {
    static constexpr bool PERM = true;
    bf16_t* wag; const float* w0; const float* a0;
    __device__ __forceinline__ void operator()(AccRef acc, const Unit& u, int wr, int wc, int fr, int fq) const {
        const int row0 = u.pm * BM + wr * 64 + fr; const int kind = u.pn >> 2; const int colt = (u.pn & 3) * BM;
        bf16_t* base = wag + (size_t)kind * M * 1024; const float* bias = kind == 0 ? w0 : a0;
        const int col0 = colt + wc * 32 + 8 * fq;
        f32x4 bv[2][2];
#pragma unroll
        for (int bj = 0; bj < 2; ++bj)
#pragma unroll
            for (int n = 0; n < 2; ++n) bv[bj][n] = kind < 2 ? *(const f32x4*)(bias + col0 + bj * HALF + 4 * n) : (f32x4){0.f, 0.f, 0.f, 0.f};
#pragma unroll
        for (int ai = 0; ai < 2; ++ai)
#pragma unroll
            for (int m = 0; m < 4; ++m) { bf16_t* rowp = base + (size_t)(row0 + ai * HALF + m * 16) * 1024 + col0;
#pragma unroll
                for (int bj = 0; bj < 2; ++bj) { f32x4 v0 = acc[ai][bj][m][0] + bv[bj][0], v1 = acc[ai][bj][m][1] + bv[bj][1];
                    if (kind == 0) { v0 = sigm4(v0) * (-0.6065306597126334f); v1 = sigm4(v1) * (-0.6065306597126334f); } else if (kind == 1) { v0 = sigm4(v0); v1 = sigm4(v1); }
                    *(u32x4*)(rowp + bj * HALF) = pack8(v0, v1); } }
    }
};
struct EpiResid {
    static constexpr bool PERM = false; static constexpr int ID = 3;
    const float* resf; const _Float16* resh; _Float16* out; const f32x2* st; const float* lg; const float* lb;
    __device__ __forceinline__ void operator()(AccRef acc, const Unit& u, int wr, int wc, int fr, int fq) const {
        const int row0 = u.pm * BM + wr * 64 + fr, col0 = u.pn * BM + wc * 32 + 4 * fq;
        f32x4 gvv[2][2], bvv[2][2];
#pragma unroll
        for (int bj = 0; bj < 2; ++bj)
#pragma unroll
            for (int n = 0; n < 2; ++n) { if (st) { gvv[bj][n] = *(const f32x4*)(lg + col0 + bj * HALF + n * 16); bvv[bj][n] = *(const f32x4*)(lb + col0 + bj * HALF + n * 16); } else { gvv[bj][n] = bvv[bj][n] = (f32x4){0.f, 0.f, 0.f, 0.f}; } }
#pragma unroll
        for (int ai = 0; ai < 2; ++ai)
#pragma unroll
            for (int m = 0; m < 4; ++m) { const int row = row0 + ai * HALF + m * 16; const size_t off = (size_t)row * 1024 + col0;
                f32x2 sv = (f32x2){0.f, 1.f}; if (st) sv = st[row];
#pragma unroll
                for (int bj = 0; bj < 2; ++bj)
#pragma unroll
                    for (int n = 0; n < 2; ++n) { f32x4 rv = resf ? *(const f32x4*)(resf + off + bj * HALF + n * 16) : ldh4(resh + off + bj * HALF + n * 16);
                        if (st) rv = (rv - sv.x) * sv.y * gvv[bj][n] + bvv[bj][n];
                        sth4(out + off + bj * HALF + n * 16, rv * ALPHA + acc[ai][bj][m][n]); } }
    }
};
struct EpiGlu {
    static constexpr bool PERM = true;
    bf16_t* h; int ldh;
    __device__ __forceinline__ void operator()(AccRef acc, const Unit& u, int wr, int wc, int fr, int fq) const {
        const int row0 = u.pm * BM + wr * 64 + fr, col0 = u.pn * HALF + wc * 32 + 8 * fq;
#pragma unroll
        for (int ai = 0; ai < 2; ++ai)
#pragma unroll
            for (int m = 0; m < 4; ++m) { f32x4 o[2];
#pragma unroll
                for (int n = 0; n < 2; ++n) { const f32x4 g = acc[ai][0][m][n], up = acc[ai][1][m][n];
#pragma unroll
                    for (int i = 0; i < 4; ++i) o[n][i] = g[i] * __builtin_amdgcn_rcpf(1.f + __expf(-g[i])) * up[i]; }
                *(u32x4*)(h + (size_t)(row0 + ai * HALF + m * 16) * ldh + col0) = pack8(o[0], o[1]); }
    }
};
struct EpiBf16 {
    static constexpr bool PERM = true;
    bf16_t* O0; bf16_t* O1; int ldc; const float* bias0; const float* bias1; int act;
    __device__ __forceinline__ void operator()(AccRef acc, const Unit& u, int wr, int wc, int fr, int fq) const {
        const int row0 = u.pm * BM + wr * 64 + fr, col0 = u.pn * BM + wc * 32 + 8 * fq;
        bf16_t* base = u.job == 0 ? O0 : O1; const float* bias = u.job == 0 ? bias0 : bias1;
        f32x4 bv[2][2];
#pragma unroll
        for (int bj = 0; bj < 2; ++bj)
#pragma unroll
            for (int n = 0; n < 2; ++n) bv[bj][n] = act ? *(const f32x4*)(bias + col0 + bj * HALF + 4 * n) : (f32x4){0.f, 0.f, 0.f, 0.f};
#pragma unroll
        for (int ai = 0; ai < 2; ++ai)
#pragma unroll
            for (int m = 0; m < 4; ++m) { bf16_t* rowp = base + (size_t)(row0 + ai * HALF + m * 16) * ldc + col0;
#pragma unroll
                for (int bj = 0; bj < 2; ++bj) { f32x4 v0 = acc[ai][bj][m][0] + bv[bj][0], v1 = acc[ai][bj][m][1] + bv[bj][1];
                    if (act) { v0 = gelu4(v0); v1 = gelu4(v1); }
                    *(u32x4*)(rowp + bj * HALF) = pack8(v0, v1); } }
    }
};
struct EpiPart {
    static constexpr bool PERM = false;
    float* part;
    __device__ __forceinline__ void operator()(AccRef acc, const Unit& u, int wr, int wc, int fr, int fq) const {
        const int rt = u.pm >> 2, ks = u.pm & 3; const int row0 = rt * BM + wr * 64 + fr, col0 = wc * 32 + 4 * fq;
        float* base = part + ((size_t)(u.job * 4 + ks) * 8192) * 256;
#pragma unroll
        for (int ai = 0; ai < 2; ++ai)
#pragma unroll
            for (int m = 0; m < 4; ++m) { float* rowp = base + (size_t)(row0 + ai * HALF + m * 16) * 256 + col0;
#pragma unroll
                for (int bj = 0; bj < 2; ++bj)
#pragma unroll
                    for (int n = 0; n < 2; ++n) *(f32x4*)(rowp + bj * HALF + n * 16) = acc[ai][bj][m][n]; }
    }
};
struct EpiGate {
    static constexpr bool PERM = false;
    const _Float16* xs; _Float16* xo; float* outf; const bf16_t* pp; const float* gb; bf16_t* xb; const f32x2* st; const float* lg; const float* lb;
    __device__ __forceinline__ void operator()(AccRef acc, const Unit& u, int wr, int wc, int fr, int fq) const {
        const int row0 = u.pm * BM + wr * 64 + fr, col0 = u.pn * BM + wc * 32 + 4 * fq;
        f32x4 bv[2][2];
#pragma unroll
        for (int bj = 0; bj < 2; ++bj)
#pragma unroll
            for (int n = 0; n < 2; ++n) bv[bj][n] = *(const f32x4*)(gb + col0 + bj * HALF + n * 16);
        f32x4 gvv[2][2], bvv[2][2];
#pragma unroll
        for (int bj = 0; bj < 2; ++bj)
#pragma unroll
            for (int n = 0; n < 2; ++n) { gvv[bj][n] = *(const f32x4*)(lg + col0 + bj * HALF + n * 16); bvv[bj][n] = *(const f32x4*)(lb + col0 + bj * HALF + n * 16); }
#pragma unroll
        for (int ai = 0; ai < 2; ++ai)
#pragma unroll
            for (int m = 0; m < 4; ++m) { const int row = row0 + ai * HALF + m * 16; const size_t off = (size_t)row * 1024 + col0; const f32x2 sv = st[row];
#pragma unroll
                for (int bj = 0; bj < 2; ++bj)
#pragma unroll
                    for (int n = 0; n < 2; ++n) { const size_t o2 = off + bj * HALF + n * 16; const f32x4 xv = (ldh4(xs + o2) - sv.x) * sv.y * gvv[bj][n] + bvv[bj][n]; const u32x2 pw = *(const u32x2*)(pp + o2);
                        const f32x4 pv = (f32x4){bflo(pw.x), bfhi(pw.x), bflo(pw.y), bfhi(pw.y)}; const f32x4 r = xv + pv * sigm4(acc[ai][bj][m][n] + bv[bj][n]);
                        if (outf) *(f32x4*)(outf + o2) = r; else sth4(xo + o2, r);
                        if (xb) { u32x2 w; w.x = cvt_pk_bf16(r[0], r[1]); w.y = cvt_pk_bf16(r[2], r[3]); *(u32x2*)(xb + o2) = w; } } }
    }
};
constexpr float QSCL = 0.125f * 1.4426950408889634f;
struct EpiNsa {
    static constexpr bool PERM = true;
    unsigned char* ws;
    __device__ __forceinline__ void operator()(AccRef acc, const Unit& u, int wr, int wc, int fr, int fq) const {
        const int row0 = u.pm * BM + wr * 64 + fr; const float* cs = (const float*)(ws + X_CS);
        bf16_t* vt = (bf16_t*)(ws + A_VTS); bf16_t* q = (bf16_t*)(ws + A_Q); bf16_t* qr = (bf16_t*)(ws + A_QR); float* gates = (float*)(ws + A_GATES);
        if (u.job == 1) {
            const int col0 = u.pn * BM + wc * 32 + 8 * fq;
#pragma unroll
            for (int ai = 0; ai < 2; ++ai)
#pragma unroll
                for (int m = 0; m < 4; ++m) { bf16_t* rowp = vt + (size_t)(row0 + ai * HALF + m * 16) * M + col0;
#pragma unroll
                    for (int bj = 0; bj < 2; ++bj) *(u32x4*)(rowp + bj * HALF) = pack8(acc[ai][bj][m][0], acc[ai][bj][m][1]); }
            return;
        }
        const int pn = u.pn;
        if (pn < 2) {
            bf16_t* base = (bf16_t*)(ws + (pn == 0 ? A_KC : A_VC));
#pragma unroll
            for (int ai = 0; ai < 2; ++ai)
#pragma unroll
                for (int m = 0; m < 4; ++m) { const int row = row0 + ai * HALF + m * 16; const int b = row >> 11, t = row & 2047;
#pragma unroll
                    for (int bj = 0; bj < 2; ++bj) { const int c = 128 * bj + 32 * wc + 8 * fq; const int g = c >> 6, d = c & 63;
                        *(u32x4*)(base + ((size_t)(b * 4 + g) * T + t) * 64 + d) = pack8(acc[ai][bj][m][0], acc[ai][bj][m][1]); } }
        } else if (pn < 8) {
#pragma unroll
            for (int ai = 0; ai < 2; ++ai)
#pragma unroll
                for (int m = 0; m < 4; ++m) { const int row = row0 + ai * HALF + m * 16; const int b = row >> 11, t = row & 2047; const int d0 = 4 * (4 * (wc & 1) + fq);
                    const f32x4 c0 = *(const f32x4*)(cs + ((size_t)t * 32 + d0) * 2), c1 = *(const f32x4*)(cs + ((size_t)t * 32 + d0) * 2 + 4);
                    const f32x4 co = (f32x4){c0[0], c0[2], c1[0], c1[2]}, si = (f32x4){c0[1], c0[3], c1[1], c1[3]};
#pragma unroll
                    for (int bj = 0; bj < 2; ++bj) { const int hh = 2 * bj + (wc >> 1);
                        f32x4 x1 = acc[ai][bj][m][0], x2 = acc[ai][bj][m][1]; if (pn >= 4) { x1 = x1 * QSCL; x2 = x2 * QSCL; }
                        const f32x4 r1 = x1 * co - x2 * si, r2 = x2 * co + x1 * si;
                        u32x2 w1, w2; w1.x = cvt_pk_bf16(r1[0], r1[1]); w1.y = cvt_pk_bf16(r1[2], r1[3]); w2.x = cvt_pk_bf16(r2[0], r2[1]); w2.y = cvt_pk_bf16(r2[2], r2[3]);
                        if (pn < 4) { bf16_t* kb = (bf16_t*)(ws + (pn == 2 ? A_KS : A_KW)) + ((size_t)(b * 4 + hh) * T + t) * 64; *(u32x2*)(kb + d0) = w1; *(u32x2*)(kb + d0 + 32) = w2; }
                        else { const size_t o = (size_t)row * 1024 + (size_t)((pn - 4) * 4 + hh) * 64;
                            *(u32x2*)(qr + o + d0) = w1; *(u32x2*)(qr + o + d0 + 32) = w2;
                            u32x2 u1, u2; u1.x = cvt_pk_bf16(x1[0], x1[1]); u1.y = cvt_pk_bf16(x1[2], x1[3]); u2.x = cvt_pk_bf16(x2[0], x2[1]); u2.y = cvt_pk_bf16(x2[2], x2[3]);
                            *(u32x2*)(q + o + d0) = u1; *(u32x2*)(q + o + d0 + 32) = u2; } } }
        } else {
            if (wc < 2) {
#pragma unroll
                for (int ai = 0; ai < 2; ++ai)
#pragma unroll
                    for (int m = 0; m < 4; ++m) { const int row = row0 + ai * HALF + m * 16; float* gp = gates + (size_t)row * 64 + 32 * wc + 8 * fq;
                        *(f32x4*)(gp) = sigm4(acc[ai][0][m][0]); *(f32x4*)(gp + 4) = sigm4(acc[ai][0][m][1]); }
            }
        }
    }
};
struct EpiMoeDown {
    static constexpr bool PERM = true;
    bf16_t* ys2; const int* row_dst; const float* row_w;
    __device__ __forceinline__ void operator()(AccRef acc, const Unit& u, int wr, int wc, int fr, int fq) const {
        const int row0 = u.pm * BM + wr * 64 + fr, col0 = u.pn * BM + wc * 32 + 8 * fq;
        int dst8[8]; float w8[8];
#pragma unroll
        for (int ai = 0; ai < 2; ++ai)
#pragma unroll
            for (int m = 0; m < 4; ++m) { const int row = row0 + ai * HALF + m * 16; dst8[ai * 4 + m] = row_dst[row]; w8[ai * 4 + m] = row_w[row]; }
#pragma unroll
        for (int ai = 0; ai < 2; ++ai)
#pragma unroll
            for (int m = 0; m < 4; ++m) { const int dst = dst8[ai * 4 + m]; const float w = w8[ai * 4 + m];
                if (dst >= 0) { bf16_t* rowp = ys2 + (size_t)dst * 1024 + col0;
#pragma unroll
                    for (int bj = 0; bj < 2; ++bj) *(u32x4*)(rowp + bj * HALF) = pack8(acc[ai][bj][m][0] * w, acc[ai][bj][m][1] * w); } }
    }
};
}
namespace fx {
struct In {
    const float *x, *p, *a_mu, *a_w_rkv, *a_w0, *a_w1, *a_w2, *a_a0, *a_a1, *a_a2, *a_g1, *a_g2, *a_k_k, *a_k_a, *a_r_k, *a_gn_g, *a_gn_b, *a_w_o,
        *b_w_kv, *b_cmp_pos, *b_phi_w1, *b_phi_b1, *b_phi_w2, *b_w_in, *b_w_o, *f_w_gu, *f_w_down, *m_w_router, *m_b_router, *m_w_gu, *m_w_down,
        *ln_g, *ln_b, *ple_w, *ple_gate_w, *ple_gate_b;
};
struct Params { In in; float* out; unsigned char* ws; int ph_lo, ph_hi, li, pad; };

__device__ __forceinline__ int ropeperm(int rr) { const int hh = rr >> 6, u = rr & 63; return hh * 64 + 4 * (u >> 3) + (u & 3) + 32 * ((u >> 2) & 1); }

struct WSrc { const float* base; const float* mu; int ldw, klo, khi, muhi; };
__device__ __forceinline__ WSrc wsrc(const In& I, int ty, int sub, int n0, int K) {
    WSrc w; w.mu = nullptr; w.klo = 0; w.khi = K; w.muhi = 0; w.ldw = D; w.base = nullptr;
    switch (ty) {
    case 0: w.base = I.a_w_rkv + (size_t)sub * D * D; break;
    case 1: { const int c = n0 & 255; w.muhi = n0 >> 8; if (c < 64) { w.base = I.a_w1; w.ldw = 64; w.mu = I.a_mu + 3 * D; } else if (c < 128) { w.base = I.a_a1; w.ldw = 64; w.mu = I.a_mu + 4 * D; } else { w.base = I.a_g1; w.ldw = 128; w.mu = I.a_mu + 5 * D; } break; }
    case 2: { const int kind = n0 >> 10; if (kind == 0) { w.base = I.a_w2; w.klo = 0; w.khi = 64; } else if (kind == 1) { w.base = I.a_a2; w.klo = 64; w.khi = 128; } else { w.base = I.a_g2; w.klo = 128; w.khi = 256; } break; }
    case 3: w.base = I.a_w_o; break;
    case 4: w.base = I.f_w_gu; w.ldw = 2 * DFF; break;
    case 5: w.base = I.f_w_down; break;
    case 6: w.base = I.ple_w + (size_t)sub * PLE * D; break;
    case 7: w.base = I.ple_gate_w + (size_t)sub * D * D; break;
    case 8: w.base = I.b_w_kv; w.ldw = 1536; break;
    case 9: w.base = I.b_w_in; w.ldw = 1072; break;
    case 10: w.base = I.b_w_kv; w.ldw = 1536; break;
    case 11: w.base = I.b_phi_w1 + (size_t)sub * 2048 * 256; w.ldw = 256; break;
    case 12: w.base = I.b_w_o; break;
    case 13: w.base = I.m_w_gu + (size_t)sub * D * (2 * DFE); w.ldw = 2 * DFE; break;
    default: w.base = I.m_w_down + (size_t)sub * DFE * D; break;
    }
    return w;
}
__device__ __forceinline__ int wcol(int ty, int n) {
    switch (ty) {
    case 1: { const int c = n & 255; return c < 64 ? c : (c < 128 ? c - 64 : c - 128); }
    case 2: return n & 1023;
    case 4: { const int tile = n >> 8, rr = n & 255; return (rr >> 7) * DFF + tile * 128 + (rr & 127); }
    case 8: { const int tile = n >> 8, rr = n & 255; return tile == 0 ? rr : (tile == 1 ? 256 + rr : (tile == 2 ? 512 + ropeperm(rr) : 1024 + ropeperm(rr))); }
    case 9: { if (n < 1024) return (n & ~255) + ropeperm(n & 255); const int rr = n - 1024; return rr < 48 ? 1024 + rr : -1; }
    case 10: { const int ten = n >> 8, rr = n & 255; return (ten ? 5 : 3) * 256 + rr; }
    case 13: { const int tile = n >> 8, rr = n & 255; return (rr >> 7) * DFE + tile * 128 + (rr & 127); }
    default: return n;
    }
}
__device__ __forceinline__ void wprep_item(const In& I, int ty, int sub, int K, int N, bf16_t* WT, LAS float* scr, int item, int lane) {
    const int nblk = N / 64, kb = item / nblk, nb = item % nblk, k0 = 64 * kb, n0 = 64 * nb;
    const WSrc w = wsrc(I, ty, sub, n0, K);
    int col[4];
#pragma unroll
    for (int e = 0; e < 4; ++e) col[e] = wcol(ty, n0 + 4 * (lane & 15) + e);
    float v[16][4];
    const bool contig = (ty != 8 && ty != 9);
    if (contig) {
#pragma unroll
        for (int i = 0; i < 16; ++i) { const int k = k0 + 4 * i + (lane >> 4); const bool kin = k >= w.klo && k < w.khi; const float* rowp = w.base + (size_t)(k - w.klo) * w.ldw;
            const f32x4 x = kin ? *(const f32x4*)(rowp + col[0]) : (f32x4){0.f, 0.f, 0.f, 0.f}; v[i][0] = x[0]; v[i][1] = x[1]; v[i][2] = x[2]; v[i][3] = x[3]; }
    } else {
#pragma unroll
        for (int i = 0; i < 16; ++i) { const int k = k0 + 4 * i + (lane >> 4); const bool kin = k >= w.klo && k < w.khi; const float* rowp = w.base + (size_t)(k - w.klo) * w.ldw;
#pragma unroll
            for (int e = 0; e < 4; ++e) v[i][e] = (kin && col[e] >= 0) ? rowp[col[e]] : 0.f; }
    }
    if (w.mu) {
#pragma unroll
        for (int i = 0; i < 16; ++i) { const float m = w.mu[k0 + 4 * i + (lane >> 4)]; const float sc = w.muhi ? m : 1.f - m;
#pragma unroll
            for (int e = 0; e < 4; ++e) v[i][e] *= sc; }
    }
#pragma unroll
    for (int i = 0; i < 16; ++i) { const int kk = 4 * i + (lane >> 4);
#pragma unroll
        for (int e = 0; e < 4; ++e) scr[kk * 65 + 4 * (lane & 15) + e] = v[i][e]; }
    asm volatile("s_waitcnt lgkmcnt(0)" ::: "memory");
    const int c = lane & 7;
#pragma unroll
    for (int j = 0; j < 8; ++j) { const int n = (lane >> 3) + 8 * j; const LAS float* s = scr + (8 * c) * 65 + n;
        u32x4 o; o.x = cvt_pk_bf16(s[0 * 65], s[1 * 65]); o.y = cvt_pk_bf16(s[2 * 65], s[3 * 65]); o.z = cvt_pk_bf16(s[4 * 65], s[5 * 65]); o.w = cvt_pk_bf16(s[6 * 65], s[7 * 65]);
        *(u32x4*)(WT + (size_t)(n0 + n) * K + k0 + 8 * c) = o; }
    asm volatile("s_waitcnt lgkmcnt(0)" ::: "memory");
}
struct WJ { int ty, sub, K, N; size_t off; };
__device__ const WJ wjobs[34] = {
        {0, 0, 1024, 1024, W_RKV}, {0, 1, 1024, 1024, W_RKV + 2 * MiB}, {0, 2, 1024, 1024, W_RKV + 4 * MiB}, {1, 0, 1024, 512, W_L1}, {2, 0, 256, 3072, W_L2}, {3, 0, 1024, 1024, W_AO},
        {4, 0, 1024, 5632, W_FGU}, {5, 0, 2816, 1024, W_FDN}, {6, 0, 256, 1024, W_PLE}, {6, 1, 256, 1024, W_PLE + MiB / 2}, {7, 0, 1024, 1024, W_GATE}, {7, 1, 1024, 1024, W_GATE + 2 * MiB},
        {8, 0, 1024, 1024, W_NSA}, {9, 0, 1024, 1280, W_NSA + 2 * MiB}, {10, 0, 1024, 512, W_VT}, {11, 0, 2048, 256, W_PHI}, {11, 1, 2048, 256, W_PHI + MiB}, {12, 0, 1024, 1024, W_BO},
        {13, 0, 1024, 2816, W_MGU}, {13, 1, 1024, 2816, W_MGU + 11 * MiB / 2}, {13, 2, 1024, 2816, W_MGU + 11 * MiB}, {13, 3, 1024, 2816, W_MGU + 33 * MiB / 2},
        {13, 4, 1024, 2816, W_MGU + 22 * MiB}, {13, 5, 1024, 2816, W_MGU + 55 * MiB / 2}, {13, 6, 1024, 2816, W_MGU + 33 * MiB}, {13, 7, 1024, 2816, W_MGU + 77 * MiB / 2},
        {14, 0, 1408, 1024, W_MDN}, {14, 1, 1408, 1024, W_MDN + 11 * MiB / 4}, {14, 2, 1408, 1024, W_MDN + 11 * MiB / 2}, {14, 3, 1408, 1024, W_MDN + 33 * MiB / 4},
        {14, 4, 1408, 1024, W_MDN + 11 * MiB}, {14, 5, 1408, 1024, W_MDN + 55 * MiB / 4}, {14, 6, 1408, 1024, W_MDN + 33 * MiB / 2}, {14, 7, 1408, 1024, W_MDN + 77 * MiB / 4}};
__device__ __forceinline__ void prep_phase(const Params& P, LAS unsigned char* lds) {
    const In& I = P.in; unsigned char* ws = P.ws;
    const int tid = threadIdx.x, lane = tid & 63, wave = tid >> 6; const int G = gridDim.x;
    const int gw = blockIdx.x * 8 + wave, NGW = G * 8; const int gt = blockIdx.x * 512 + tid, NGT = G * 512;
    LAS float* scr = (LAS float*)(lds + wave * 16896);
    {
        int start = 0;
#pragma unroll 1
        for (int jb = 0; jb < 34; ++jb) {
            const int ty = wjobs[jb].ty, sub = wjobs[jb].sub, K = wjobs[jb].K, N = wjobs[jb].N; const size_t off = wjobs[jb].off; const int nit = (K / 64) * (N / 64);
            int it = start + ((gw - start) % NGW + NGW) % NGW;
#pragma unroll 1
            for (; it < start + nit; it += NGW) wprep_item(I, ty, sub, K, N, (bf16_t*)(ws + off), scr, it - start, lane);
            start += nit;
        }
    }
    {
        bf16_t* mr = (bf16_t*)(ws + A_MIX); bf16_t* mk = mr + (size_t)M * D; bf16_t* mv = mk + (size_t)M * D; bf16_t* xb = (bf16_t*)((unsigned char*)P.out + O_XB);
        for (int rb = gw; rb < M / 16; rb += NGW) {
#pragma unroll 1
            for (int hf = 0; hf < 2; ++hf) {
                const int c0 = hf * 512 + lane * 8;
                f32x4 mur[2], muk[2], muv[2];
#pragma unroll
                for (int q = 0; q < 2; ++q) { mur[q] = *(const f32x4*)(I.a_mu + 0 * D + c0 + 4 * q); muk[q] = *(const f32x4*)(I.a_mu + 1 * D + c0 + 4 * q); muv[q] = *(const f32x4*)(I.a_mu + 2 * D + c0 + 4 * q); }
                const int row0 = rb * 16; f32x4 pv[2];
                if ((row0 & (T - 1)) == 0) { pv[0] = (f32x4){0.f, 0.f, 0.f, 0.f}; pv[1] = pv[0];
                    const int b = row0 >> 11; *(u32x4*)(xb + (size_t)(b * XBT) * D + c0) = (u32x4){0u, 0u, 0u, 0u}; }
                else { pv[0] = *(const f32x4*)(I.x + (size_t)(row0 - 1) * D + c0); pv[1] = *(const f32x4*)(I.x + (size_t)(row0 - 1) * D + c0 + 4); }
#pragma unroll 8
                for (int rr = 0; rr < 16; ++rr) { const int row = row0 + rr; const int b = row >> 11, t = row & (T - 1);
                    f32x4 xv[2]; xv[0] = *(const f32x4*)(I.x + (size_t)row * D + c0); xv[1] = *(const f32x4*)(I.x + (size_t)row * D + c0 + 4);
                    const f32x4 d0 = pv[0] - xv[0], d1 = pv[1] - xv[1];
                    *(u32x4*)(mr + (size_t)row * D + c0) = pack8(xv[0] + d0 * mur[0], xv[1] + d1 * mur[1]);
                    *(u32x4*)(mk + (size_t)row * D + c0) = pack8(xv[0] + d0 * muk[0], xv[1] + d1 * muk[1]);
                    *(u32x4*)(mv + (size_t)row * D + c0) = pack8(xv[0] + d0 * muv[0], xv[1] + d1 * muv[1]);
                    *(u32x4*)(xb + (size_t)(b * XBT + 1 + t) * D + c0) = pack8(xv[0], xv[1]);
                    pv[0] = xv[0]; pv[1] = xv[1]; }
            }
        }
    }
    { float* cs = (float*)(ws + X_CS);
        for (int i = gt; i < T * 32; i += NGT) { const int t = i >> 5, j = i & 31; const float inv = powf(10000.f, -(float)j / 32.f); const float ang = (float)t * inv;
            const double a = (double)ang; const double n = rint(a * 0.15915494309189535); const float rf = (float)(a - n * 6.283185307179586476925); cs[2 * i] = cosf(rf); cs[2 * i + 1] = sinf(rf); } }
    { float* cb = (float*)(ws + X_CB);
        for (int o = gw; o < 512; o += NGW) { const int j = o >> 8, c = o & 255; float s = 0.f;
            for (int k = lane; k < 2048; k += 64) s += I.b_cmp_pos[j * 2048 + k] * I.b_phi_w1[(size_t)j * 2048 * 256 + (size_t)k * 256 + c];
            s = wave_sum(s); if (lane == 0) cb[o] = s + I.b_phi_b1[o]; } }
    { int* rs = (int*)(ws + X_RSRC); int* rd = (int*)(ws + X_RDST); float* rw = (float*)(ws + X_RW);
        for (int i = gt; i < MOE_ROWS_MAX; i += NGT) { rs[i] = 0; rd[i] = -1; rw[i] = 0.f; } }
}

__device__ __forceinline__ void unpack8(const u32x4 w, float (&f)[8]) { f[0] = bflo(w.x); f[1] = bfhi(w.x); f[2] = bflo(w.y); f[3] = bfhi(w.y); f[4] = bflo(w.z); f[5] = bfhi(w.z); f[6] = bflo(w.w); f[7] = bfhi(w.w); }
constexpr int SC_L = 32;
constexpr int SC_ARR = SC_L * 64;
constexpr int SC_BUF = 7 * SC_ARR + 64;
#ifdef SCAN_AMP
#define SAMP_T0(sec) unsigned long long _s0_##sec = __builtin_amdgcn_s_memrealtime()
#define SAMP_T1(sec) do { if (SCAN_AMP == sec) samp_acc += __builtin_amdgcn_s_memrealtime() - _s0_##sec; } while (0)
#else
#define SAMP_T0(sec) do { } while (0)
#define SAMP_T1(sec) do { } while (0)
#endif
__device__ __forceinline__ void scan_phase(const Params& P, LAS unsigned char* lds, bf16_t* og) {
    const In& I = P.in; unsigned char* ws = P.ws; unsigned long long samp_acc = 0; (void)samp_acc;
    const bf16_t* gr = (const bf16_t*)(ws + A_RKV); const bf16_t* gk = gr + (size_t)M * D; const bf16_t* gv = gk + (size_t)M * D;
    const bf16_t* gwl = (const bf16_t*)(ws + A_WAG); const bf16_t* ga = gwl + (size_t)M * D; const bf16_t* gg = ga + (size_t)M * D;
    LAS float* L0 = (LAS float*)lds;
    const int tid = threadIdx.x; const bool helper = tid >= 256; const int ht = tid & 255, row = ht >> 3, jg = ht & 7;
    constexpr int NCH = T / SC_L;
    SAMP_T0(9);
    for (int item = blockIdx.x; item < NB * 16; item += gridDim.x) {
        const int b = item >> 4, h = item & 15; const int cb = h * 64 + jg * 8;
        const size_t base = (size_t)b * T * D + cb;
        if (helper) {
            float kkc[8], kac[8], rkc[8], gng[8], gnb[8];
#pragma unroll
            for (int i = 0; i < 8; ++i) { kkc[i] = I.a_k_k[cb + i]; kac[i] = I.a_k_a[cb + i]; rkc[i] = I.a_r_k[cb + i]; gng[i] = I.a_gn_g[cb + i]; gnb[i] = I.a_gn_b[cb + i]; }
            u32x4 pr, pk, pv, pw, pa, pg;
#define SC_LOAD(c) do { const size_t _o = base + (size_t)((c) * SC_L + row) * D; pr = *(const u32x4*)(gr + _o); pk = *(const u32x4*)(gk + _o); pv = *(const u32x4*)(gv + _o); pw = *(const u32x4*)(gwl + _o); pa = *(const u32x4*)(ga + _o); } while (0)
#define SC_PRE(c) do { LAS float* Lb = L0 + ((c) & 1) * SC_BUF; \
                float rf[8], kf[8], vf[8], wf[8], af[8]; unpack8(pr, rf); unpack8(pk, kf); unpack8(pv, vf); unpack8(pw, wf); unpack8(pa, af); \
                float kk[8], km[8], dd[8], bb[8]; float ss = 0.f, bon = 0.f; \
                _Pragma("unroll") for (int i = 0; i < 8; ++i) { kk[i] = kf[i] * kkc[i]; ss += kk[i] * kk[i]; km[i] = kf[i] * (1.f + (af[i] - 1.f) * kac[i]); dd[i] = __expf(wf[i]); bon += rf[i] * km[i] * rkc[i]; } \
                ss = sum8(ss); bon = sum8(bon); const float inv = 1.f / fmaxf(sqrtf(ss), 1e-12f); \
                _Pragma("unroll") for (int i = 0; i < 8; ++i) { kk[i] *= inv; bb[i] = kk[i] * af[i]; } \
                const int o = row * 64 + jg * 8; \
                *(LAS f32x4*)(Lb + 0 * SC_ARR + o) = (f32x4){rf[0], rf[1], rf[2], rf[3]}; *(LAS f32x4*)(Lb + 0 * SC_ARR + o + 4) = (f32x4){rf[4], rf[5], rf[6], rf[7]}; \
                *(LAS f32x4*)(Lb + 1 * SC_ARR + o) = (f32x4){km[0], km[1], km[2], km[3]}; *(LAS f32x4*)(Lb + 1 * SC_ARR + o + 4) = (f32x4){km[4], km[5], km[6], km[7]}; \
                *(LAS f32x4*)(Lb + 2 * SC_ARR + o) = (f32x4){dd[0], dd[1], dd[2], dd[3]}; *(LAS f32x4*)(Lb + 2 * SC_ARR + o + 4) = (f32x4){dd[4], dd[5], dd[6], dd[7]}; \
                *(LAS f32x4*)(Lb + 3 * SC_ARR + o) = (f32x4){kk[0], kk[1], kk[2], kk[3]}; *(LAS f32x4*)(Lb + 3 * SC_ARR + o + 4) = (f32x4){kk[4], kk[5], kk[6], kk[7]}; \
                *(LAS f32x4*)(Lb + 4 * SC_ARR + o) = (f32x4){bb[0], bb[1], bb[2], bb[3]}; *(LAS f32x4*)(Lb + 4 * SC_ARR + o + 4) = (f32x4){bb[4], bb[5], bb[6], bb[7]}; \
                *(LAS f32x4*)(Lb + 5 * SC_ARR + o) = (f32x4){vf[0], vf[1], vf[2], vf[3]}; *(LAS f32x4*)(Lb + 5 * SC_ARR + o + 4) = (f32x4){vf[4], vf[5], vf[6], vf[7]}; \
                if (jg == 0) Lb[7 * SC_ARR + row] = bon; } while (0)
#define SC_POST(c) do { const LAS float* Lb = L0 + ((c) & 1) * SC_BUF; const int o = row * 64 + jg * 8; \
                const f32x4 o0 = *(const LAS f32x4*)(Lb + 6 * SC_ARR + o), o1 = *(const LAS f32x4*)(Lb + 6 * SC_ARR + o + 4); \
                float ov[8] = {o0[0], o0[1], o0[2], o0[3], o1[0], o1[1], o1[2], o1[3]}; float sm = 0.f; \
                _Pragma("unroll") for (int i = 0; i < 8; ++i) sm += ov[i]; \
                const float mean = sum8(sm) * (1.f / 64.f); float q = 0.f; \
                _Pragma("unroll") for (int i = 0; i < 8; ++i) { ov[i] -= mean; q += ov[i] * ov[i]; } \
                const float rs = rsqrtf(sum8(q) * (1.f / 64.f) + GN_EPS); const float bon = Lb[7 * SC_ARR + row]; \
                const f32x4 v0 = *(const LAS f32x4*)(Lb + 5 * SC_ARR + o), v1 = *(const LAS f32x4*)(Lb + 5 * SC_ARR + o + 4); const float vv[8] = {v0[0], v0[1], v0[2], v0[3], v1[0], v1[1], v1[2], v1[3]}; \
                float gf[8]; unpack8(pg, gf); float y[8]; \
                _Pragma("unroll") for (int i = 0; i < 8; ++i) y[i] = (ov[i] * rs * gng[i] + gnb[i] + bon * vv[i]) * gf[i]; \
                u32x4 w; w.x = cvt_pk_bf16(y[0], y[1]); w.y = cvt_pk_bf16(y[2], y[3]); w.z = cvt_pk_bf16(y[4], y[5]); w.w = cvt_pk_bf16(y[6], y[7]); \
                *(u32x4*)(og + base + (size_t)((c) * SC_L + row) * D) = w; } while (0)
            SC_LOAD(0); SC_PRE(0); SC_LOAD(1);
            __syncthreads();
#pragma unroll 1
            for (int c = 0; c < NCH; ++c) {
                SAMP_T0(1);
                if (c >= 1) SC_POST(c - 1);
                pg = *(const u32x4*)(gg + base + (size_t)(c * SC_L + row) * D);
                if (c + 1 < NCH) SC_PRE(c + 1);
                if (c + 2 < NCH) SC_LOAD(c + 2);
                SAMP_T1(1);
                __syncthreads();
            }
            SC_POST(NCH - 1);
#undef SC_LOAD
#undef SC_PRE
#undef SC_POST
        } else {
            f32x2 SA[4], SB[4];
#pragma unroll
            for (int i = 0; i < 4; ++i) { SA[i] = (f32x2){0.f, 0.f}; SB[i] = (f32x2){0.f, 0.f}; }
            __syncthreads();
#pragma unroll 1
            for (int c = 0; c < NCH; ++c) {
                SAMP_T0(2);
                const LAS float* Lb = L0 + (c & 1) * SC_BUF; LAS float* Lo = L0 + (c & 1) * SC_BUF + 6 * SC_ARR;
                const LAS float* sR = Lb, *sKM = Lb + SC_ARR, *sDD = Lb + 2 * SC_ARR, *sKK = Lb + 3 * SC_ARR, *sBB = Lb + 4 * SC_ARR, *sVV = Lb + 5 * SC_ARR;
                const int ob = jg * 8;
                f32x4 k0 = *(const LAS f32x4*)(sKK + ob), k1 = *(const LAS f32x4*)(sKK + ob + 4), d0 = *(const LAS f32x4*)(sDD + ob), d1 = *(const LAS f32x4*)(sDD + ob + 4);
                f32x4 b0 = *(const LAS f32x4*)(sBB + ob), b1 = *(const LAS f32x4*)(sBB + ob + 4), m0 = *(const LAS f32x4*)(sKM + ob), m1 = *(const LAS f32x4*)(sKM + ob + 4);
                f32x4 r0 = *(const LAS f32x4*)(sR + ob), r1 = *(const LAS f32x4*)(sR + ob + 4); float va = sVV[row], vb = sVV[row + 32];
#pragma unroll 1
                for (int s8 = 0; s8 < SC_L / 8; ++s8) {
                    float keepa = 0.f, keepb = 0.f;
#pragma unroll
                    for (int u = 0; u < 8; ++u) {
                        const int sn = (s8 * 8 + u + 1) & (SC_L - 1); const int o = sn * 64 + ob;
                        const f32x4 nk0 = *(const LAS f32x4*)(sKK + o), nk1 = *(const LAS f32x4*)(sKK + o + 4), nd0 = *(const LAS f32x4*)(sDD + o), nd1 = *(const LAS f32x4*)(sDD + o + 4);
                        const f32x4 nb0 = *(const LAS f32x4*)(sBB + o), nb1 = *(const LAS f32x4*)(sBB + o + 4), nm0 = *(const LAS f32x4*)(sKM + o), nm1 = *(const LAS f32x4*)(sKM + o + 4);
                        const f32x4 nr0 = *(const LAS f32x4*)(sR + o), nr1 = *(const LAS f32x4*)(sR + o + 4); const float nva = sVV[sn * 64 + row], nvb = sVV[sn * 64 + row + 32];
                        const f32x2 kk0 = (f32x2){k0[0], k0[1]}, kk1 = (f32x2){k0[2], k0[3]}, kk2 = (f32x2){k1[0], k1[1]}, kk3 = (f32x2){k1[2], k1[3]};
                        const f32x2 pa = (SA[0] * kk0 + SA[2] * kk2) + (SA[1] * kk1 + SA[3] * kk3), pb = (SB[0] * kk0 + SB[2] * kk2) + (SB[1] * kk1 + SB[3] * kk3);
                        const float dota = sum8(pa.x + pa.y), dotb = sum8(pb.x + pb.y);
                        const f32x2 na = (f32x2){-dota, -dota}, nb = (f32x2){-dotb, -dotb}, wa = (f32x2){va, va}, wb = (f32x2){vb, vb};
                        const f32x2 dd0 = (f32x2){d0[0], d0[1]}, dd1 = (f32x2){d0[2], d0[3]}, dd2 = (f32x2){d1[0], d1[1]}, dd3 = (f32x2){d1[2], d1[3]};
                        const f32x2 bb0 = (f32x2){b0[0], b0[1]}, bb1 = (f32x2){b0[2], b0[3]}, bb2 = (f32x2){b1[0], b1[1]}, bb3 = (f32x2){b1[2], b1[3]};
                        const f32x2 mm0 = (f32x2){m0[0], m0[1]}, mm1 = (f32x2){m0[2], m0[3]}, mm2 = (f32x2){m1[0], m1[1]}, mm3 = (f32x2){m1[2], m1[3]};
                        SA[0] = SA[0] * dd0 + (na * bb0 + wa * mm0); SA[1] = SA[1] * dd1 + (na * bb1 + wa * mm1); SA[2] = SA[2] * dd2 + (na * bb2 + wa * mm2); SA[3] = SA[3] * dd3 + (na * bb3 + wa * mm3);
                        SB[0] = SB[0] * dd0 + (nb * bb0 + wb * mm0); SB[1] = SB[1] * dd1 + (nb * bb1 + wb * mm1); SB[2] = SB[2] * dd2 + (nb * bb2 + wb * mm2); SB[3] = SB[3] * dd3 + (nb * bb3 + wb * mm3);
                        const f32x2 rr0 = (f32x2){r0[0], r0[1]}, rr1 = (f32x2){r0[2], r0[3]}, rr2 = (f32x2){r1[0], r1[1]}, rr3 = (f32x2){r1[2], r1[3]};
                        const f32x2 qa = (SA[0] * rr0 + SA[2] * rr2) + (SA[1] * rr1 + SA[3] * rr3), qb = (SB[0] * rr0 + SB[2] * rr2) + (SB[1] * rr1 + SB[3] * rr3);
                        const float oa = sum8(qa.x + qa.y), obv = sum8(qb.x + qb.y);
                        keepa = (u == jg) ? oa : keepa; keepb = (u == jg) ? obv : keepb;
                        k0 = nk0; k1 = nk1; d0 = nd0; d1 = nd1; b0 = nb0; b1 = nb1; m0 = nm0; m1 = nm1; r0 = nr0; r1 = nr1; va = nva; vb = nvb;
                    }
                    Lo[(s8 * 8 + jg) * 64 + row] = keepa; Lo[(s8 * 8 + jg) * 64 + row + 32] = keepb;
                }
                SAMP_T1(2);
                __syncthreads();
            }
        }
        __syncthreads();
    }
    SAMP_T1(9);
#ifdef SCAN_AMP
    { const unsigned long long ts = __builtin_amdgcn_s_memrealtime(); while (__builtin_amdgcn_s_memrealtime() - ts < samp_acc) __builtin_amdgcn_s_sleep(8); }
#endif
}

__device__ __forceinline__ void ln_phase(const Params& P, LAS unsigned char* lds, int lni, bf16_t* xb, const bf16_t* ys2, bool router, const float* psrc, bf16_t* pdst, const _Float16* sin16, _Float16* sout16) {
    const In& I = P.in; unsigned char* ws = P.ws;
    const int tid = threadIdx.x, lane = tid & 63, wave = tid >> 6; const int gw = blockIdx.x * 8 + wave, NGW = gridDim.x * 8;
    LAS float* wrT = (LAS float*)lds;
    LAS unsigned* hist = (LAS unsigned*)(lds + 32768);
    if (router) { for (int i = tid; i < 8192; i += 512) { const int k = i >> 3, e = i & 7; wrT[e * 1024 + k] = I.m_w_router[i]; } if (tid < 8) hist[tid] = 0u; __syncthreads(); }
    f32x4 gv[4], bv[4]; f32x2* stats = (f32x2*)(ws + X_STAT) + (size_t)lni * M;
#pragma unroll
    for (int j = 0; j < 4; ++j) { gv[j] = *(const f32x4*)(I.ln_g + lni * D + 4 * lane + 256 * j); bv[j] = *(const f32x4*)(I.ln_b + lni * D + 4 * lane + 256 * j); }
    for (int rb = gw; rb < M / 16; rb += NGW) {
#pragma unroll 1
        for (int rr = 0; rr < 16; ++rr) { const int row = rb * 16 + rr; const _Float16* xr = sin16 + (size_t)row * D + 4 * lane; _Float16* xw = sout16 + (size_t)row * D + 4 * lane;
            f32x4 v[4]; float s = 0.f;
#pragma unroll
            for (int j = 0; j < 4; ++j) v[j] = ldh4(xr + 256 * j);
            if (ys2) {
                const f32x2 ps = ((const f32x2*)(ws + X_STAT) + (size_t)(lni - 1) * M)[row];
#pragma unroll
                for (int j = 0; j < 4; ++j) { const u32x2 a = *(const u32x2*)(ys2 + (size_t)(2 * row) * D + 4 * lane + 256 * j), b2 = *(const u32x2*)(ys2 + (size_t)(2 * row + 1) * D + 4 * lane + 256 * j);
                    const f32x4 x4 = (v[j] - ps.x) * ps.y * *(const f32x4*)(I.ln_g + (lni - 1) * D + 4 * lane + 256 * j) + *(const f32x4*)(I.ln_b + (lni - 1) * D + 4 * lane + 256 * j);
                    v[j] = x4 * ALPHA + ((f32x4){bflo(a.x), bfhi(a.x), bflo(a.y), bfhi(a.y)} + (f32x4){bflo(b2.x), bfhi(b2.x), bflo(b2.y), bfhi(b2.y)}); { const h16x4 hv = __builtin_convertvector(v[j], h16x4); *(h16x4*)(xw + 256 * j) = hv; v[j] = __builtin_convertvector(hv, f32x4); } }
            }
#pragma unroll
            for (int j = 0; j < 4; ++j) s += (v[j][0] + v[j][1]) + (v[j][2] + v[j][3]);
            const float mean = wave_sum(s) * (1.f / D); float q = 0.f;
#pragma unroll
            for (int j = 0; j < 4; ++j) { v[j] = v[j] - mean; q += (v[j][0] * v[j][0] + v[j][1] * v[j][1]) + (v[j][2] * v[j][2] + v[j][3] * v[j][3]); }
            const float rstd = rsqrtf(wave_sum(q) * (1.f / D) + LN_EPS);
            if (lane == 0) stats[row] = (f32x2){mean, rstd};
#pragma unroll
            for (int j = 0; j < 4; ++j) { v[j] = v[j] * rstd * gv[j] + bv[j];
                u32x2 w; w.x = cvt_pk_bf16(v[j][0], v[j][1]); w.y = cvt_pk_bf16(v[j][2], v[j][3]); *(u32x2*)(xb + (size_t)row * D + 4 * lane + 256 * j) = w; }
            if (router) {
                float lg[8];
#pragma unroll
                for (int e = 0; e < 8; ++e) { float a = 0.f;
#pragma unroll
                    for (int j = 0; j < 4; ++j) { const f32x4 w4 = *(const LAS f32x4*)(wrT + e * 1024 + 4 * lane + 256 * j); a += (v[j][0] * w4[0] + v[j][1] * w4[1]) + (v[j][2] * w4[2] + v[j][3] * w4[3]); }
                    lg[e] = wave_sum(a) + I.m_b_router[e]; }
                int e1 = 0; float v1 = lg[0];
#pragma unroll
                for (int e = 1; e < 8; ++e) if (lg[e] > v1) { v1 = lg[e]; e1 = e; }
                int e2 = -1; float v2 = 0.f;
#pragma unroll
                for (int e = 0; e < 8; ++e) if (e != e1 && (e2 < 0 || lg[e] > v2)) { v2 = lg[e]; e2 = e; }
                const float p2 = __expf(v2 - v1); const float w1 = 1.f / (1.f + p2), w2 = p2 / (1.f + p2);
                if (lane == 0) { ((unsigned*)(ws + X_TOKE))[row] = (unsigned)e1 | ((unsigned)e2 << 8); ((f32x2*)(ws + X_TOKW))[row] = (f32x2){w1, w2}; __hip_atomic_fetch_add(&hist[e1], 1u, __ATOMIC_RELAXED, __HIP_MEMORY_SCOPE_WORKGROUP); __hip_atomic_fetch_add(&hist[e2], 1u, __ATOMIC_RELAXED, __HIP_MEMORY_SCOPE_WORKGROUP); }
            }
        }
    }
    if (router) { __syncthreads(); if (tid < 8) atomicAdd((unsigned*)(ws + X_CTL) + CW_CNT + tid, hist[tid]); }
    if (psrc) { const int gt = blockIdx.x * 512 + tid, NGT = gridDim.x * 512;
        for (int i = gt; i < M * PLE / 8; i += NGT) { const f32x4 a = *(const f32x4*)(psrc + (size_t)i * 8), b2 = *(const f32x4*)(psrc + (size_t)i * 8 + 4); *(u32x4*)(pdst + (size_t)i * 8) = pack8(a, b2); } }
}

__device__ __forceinline__ void moe_gather_phase(const Params& P) {
    unsigned char* ws = P.ws; const unsigned* cnt = (const unsigned*)(ws + X_CTL) + CW_CNT; unsigned* cur = (unsigned*)(ws + X_CTL) + CW_CUR;
    const unsigned* toke = (const unsigned*)(ws + X_TOKE); const f32x2* tokw = (const f32x2*)(ws + X_TOKW);
    int* rs = (int*)(ws + X_RSRC); int* rd = (int*)(ws + X_RDST); float* rw = (float*)(ws + X_RW);
    const bf16_t* x4b = (const bf16_t*)(ws + A_X4B); bf16_t* xs = (bf16_t*)(ws + A_XS);
    const int tid = threadIdx.x, lane = tid & 63, wave = tid >> 6; const int gw = blockIdx.x * 8 + wave, NGW = gridDim.x * 8;
    unsigned pstart[8]; { unsigned acc = 0;
#pragma unroll
        for (int e = 0; e < 8; ++e) { pstart[e] = acc; acc += (cnt[e] + 255u) / 256u * 256u; } }
    for (int tb = gw; tb < M / 16; tb += NGW) {
        const int tok = tb * 16 + ((lane & 31) >> 1), slot = lane & 1; int e = -1; float w = 0.f;
        if (lane < 32) { const unsigned te = toke[tok]; const f32x2 tw = tokw[tok]; e = slot ? (int)((te >> 8) & 0xff) : (int)(te & 0xff); w = slot ? tw.y : tw.x; }
        int dest = 0;
#pragma unroll
        for (int q = 0; q < 8; ++q) { const unsigned long long mk = __ballot(e == q); if (mk) { unsigned bs = 0; if (lane == 0) bs = atomicAdd(&cur[q], (unsigned)__popcll(mk)); bs = __shfl(bs, 0);
                if (e == q) dest = (int)(pstart[q] + bs + (unsigned)__popcll(mk & ((1ull << lane) - 1ull))); } }
        if (lane < 32) { rs[dest] = tok; rd[dest] = tok * 2 + slot; rw[dest] = w; }
#pragma unroll 4
        for (int q = 0; q < 32; ++q) { const int dq = __shfl(dest, q); const int tq = tb * 16 + (q >> 1);
            const u32x4* src = (const u32x4*)(x4b + (size_t)tq * D); u32x4* dst = (u32x4*)(xs + (size_t)dq * D); dst[lane] = src[lane]; dst[lane + 64] = src[lane + 64]; }
    }
}
struct MoeSched {
    const char* A; const char* B; long tileA, tileB, strideE; int nN, nt; int G, c, lda, ldb; int pend[8]; int nblk;
    __device__ __forceinline__ void init(const unsigned* cnt) { int acc = 0;
#pragma unroll
        for (int e = 0; e < 8; ++e) { acc += (int)((cnt[e] + 255u) / 256u); pend[e] = acc; } nblk = acc; }
    __device__ __forceinline__ bool next(int i, Unit& u) const {
        const long L = (long)i * G + c; if (L >= (long)nblk * nN) return false;
        const int rb = (int)(L / nN), pn = (int)(L % nN); int e = 0;
#pragma unroll
        for (int q = 0; q < 7; ++q) e += (rb >= pend[q]) ? 1 : 0;
        u.pm = rb; u.pn = pn; u.job = e; u.A = A + (long)rb * tileA; u.B = B + (long)e * strideE + (long)pn * tileB; u.nt = nt; u.ksplit = 1 << 30; u.wrapA = 0; u.wrapB = 0; return true;
    }
};

__device__ __forceinline__ void cmp2_phase(const Params& P, LAS unsigned char* lds) {
    const In& I = P.in; unsigned char* ws = P.ws; const int lane = threadIdx.x & 63, wave = threadIdx.x >> 6; const int gw = blockIdx.x * 8 + wave, NGW = gridDim.x * 8;
    bf16_t* kcmp = (bf16_t*)(ws + A_KCMP); bf16_t* vcT = (bf16_t*)(ws + A_VCMPT); const float* part = (const float*)(ws + A_HCP); const float* cb = (const float*)(ws + X_CB);
    LAS float* hb = (LAS float*)(lds + wave * 1024);
    for (int o = gw; o < 2 * 8192; o += NGW) { const int j = o >> 13, row = o & 8191; const float* w2 = I.b_phi_w2 + (size_t)j * 256 * 64;
        f32x4 h = *(const f32x4*)(cb + j * 256 + 4 * lane);
#pragma unroll
        for (int ks = 0; ks < 4; ++ks) h += *(const f32x4*)(part + ((size_t)(j * 4 + ks) * 8192 + row) * 256 + 4 * lane);
        h = gelu4(h); *(LAS f32x4*)(hb + 4 * lane) = h;
        asm volatile("s_waitcnt lgkmcnt(0)" ::: "memory");
        float acc = 0.f;
#pragma unroll 8
        for (int c4 = 0; c4 < 64; ++c4) { const f32x4 hv = *(const LAS f32x4*)(hb + 4 * c4); acc += hv[0] * w2[(4 * c4) * 64 + lane] + hv[1] * w2[(4 * c4 + 1) * 64 + lane] + hv[2] * w2[(4 * c4 + 2) * 64 + lane] + hv[3] * w2[(4 * c4 + 3) * 64 + lane]; }
        asm volatile("s_waitcnt lgkmcnt(0)" ::: "memory");
        const unsigned short ob = (unsigned short)(cvt_pk_bf16(acc, 0.f) & 0xffffu);
        if (j == 0) kcmp[(size_t)row * 64 + lane] = ob; else { const int bg = row >> 7, n = row & 127; vcT[((size_t)bg * 64 + lane) * 128 + n] = ob; } }
}
}
namespace fx {
namespace cs {
constexpr int PT = 144, PW = 80;
constexpr int S_KT = 0, S_RT = 2304, S_WV = 4608, S_BKT = 9728, S_TT = 14848, S_MXT = 16128, S_PQT = 17408, S_GL = 18688, SET_BYTES = 18944, NS = 4;
constexpr int L_SP = 0, L_OB = 4 * 3072, L_CV = L_OB + 3 * 4096, L_SETS = L_CV + 1280, L_HP = L_SETS + NS * SET_BYTES;
constexpr int HP_BT = 0, HP_KK = 2304, HP_LW = 4608, HP_NF = 8704, HP_BON = 9728, HP_BYTES = 9856;
constexpr int L_SP_UNUSED = 0;
constexpr int SP_SB = 0, SP_RB = 2304, SP_BYTES = 3072;
constexpr int L_END = L_HP + 4 * HP_BYTES;
static_assert(L_END <= 147456 - 64, "chunked scan LDS");
typedef float f32x4v __attribute__((ext_vector_type(4)));
#define MFMA16(a, b, c) __builtin_amdgcn_mfma_f32_16x16x32_bf16((a), (b), (c), 0, 0, 0)
__device__ __forceinline__ unsigned short bf1(float x) { return __builtin_bit_cast(unsigned short, (__bf16)x); }
__device__ __forceinline__ void unpack16(const u32x4 a, const u32x4 b, float (&f)[16]) { f[0] = bflo(a.x); f[1] = bfhi(a.x); f[2] = bflo(a.y); f[3] = bfhi(a.y); f[4] = bflo(a.z); f[5] = bfhi(a.z); f[6] = bflo(a.w); f[7] = bfhi(a.w);
    f[8] = bflo(b.x); f[9] = bfhi(b.x); f[10] = bflo(b.y); f[11] = bfhi(b.y); f[12] = bflo(b.z); f[13] = bfhi(b.z); f[14] = bflo(b.w); f[15] = bfhi(b.w); }
}

#ifdef CS_AMP
#define CAMP_T0(sec) unsigned long long _c0_##sec = __builtin_amdgcn_s_memrealtime()
#define CAMP_T1(sec) do { if (CS_AMP == sec) camp_acc += __builtin_amdgcn_s_memrealtime() - _c0_##sec; } while (0)
#else
#define CAMP_T0(sec) do { } while (0)
#define CAMP_T1(sec) do { } while (0)
#endif
__device__ __forceinline__ void scan_chunked(const Params& P, LAS unsigned char* lds, bf16_t* og) {
    using namespace cs; unsigned long long camp_acc = 0; (void)camp_acc;
    const In& I = P.in; unsigned char* ws = P.ws;
    const bf16_t* gr = (const bf16_t*)(ws + A_RKV); const bf16_t* gk = gr + (size_t)M * D; const bf16_t* gv = gk + (size_t)M * D;
    const bf16_t* gwl = (const bf16_t*)(ws + A_WAG); const bf16_t* ga = gwl + (size_t)M * D; const bf16_t* gg = ga + (size_t)M * D;
    const int tid = threadIdx.x, lane = tid & 63, wv = tid >> 6; const bool helper = wv >= 4;
    constexpr int NCH = T / 16, NINT = NCH + 4;
    for (int item = blockIdx.x; item < NB * 16; item += gridDim.x) {
        const int b = item >> 4, h = item & 15; const size_t hb = (size_t)b * T * D + h * 64;
        { LAS float* cv = (LAS float*)(lds + L_CV); if (tid < 64) { cv[tid] = I.a_k_k[h * 64 + tid]; cv[64 + tid] = I.a_k_a[h * 64 + tid]; cv[128 + tid] = I.a_r_k[h * 64 + tid]; cv[192 + tid] = I.a_gn_g[h * 64 + tid]; cv[256 + tid] = I.a_gn_b[h * 64 + tid]; }
          for (int i = tid; i < NS * SET_BYTES / 4; i += 512) ((LAS unsigned*)(lds + L_SETS))[i] = 0u;
          for (int i = tid; i < 4 * SP_BYTES / 4; i += 512) ((LAS unsigned*)(lds + L_SP))[i] = 0u; }
        __syncthreads();
        if (helper) {
            const int hw = wv - 4; LAS unsigned char* hp = lds + L_HP + hw * HP_BYTES; const LAS float* cv = (const LAS float*)(lds + L_CV);
            const int t = lane >> 2, jq = lane & 3, j0 = jq * 16;
            u32x4 nr[2], nk[2], nv[2], nw[2], na[2];
#define CS_PREFETCH(cc) do { const size_t _go = hb + (size_t)((cc) * 16 + t) * D + j0; _Pragma("unroll") for (int q = 0; q < 2; ++q) { nr[q] = *(const u32x4*)(gr + _go + 8 * q); nk[q] = *(const u32x4*)(gk + _go + 8 * q); \
                nv[q] = *(const u32x4*)(gv + _go + 8 * q); nw[q] = *(const u32x4*)(gwl + _go + 8 * q); na[q] = *(const u32x4*)(ga + _go + 8 * q); } } while (0)
            CS_PREFETCH(hw);
            for (int g = 0; g < hw; ++g) __syncthreads();
#pragma unroll 1
            for (int c = hw; c < NCH; c += 4) {
                LAS unsigned char* st = lds + L_SETS + (c % NS) * SET_BYTES;
                CAMP_T0(10);
                u32x4 xr[2], xk[2], xv[2], xw[2], xa[2];
#pragma unroll
                for (int q = 0; q < 2; ++q) { xr[q] = nr[q]; xk[q] = nk[q]; xv[q] = nv[q]; xw[q] = nw[q]; xa[q] = na[q]; }
                u32x4 pv2[2], pg2[2];
                if (c >= 4) { const size_t po = hb + (size_t)((c - 4) * 16 + t) * D + j0;
#pragma unroll
                    for (int q = 0; q < 2; ++q) { pv2[q] = *(const u32x4*)(gv + po + 8 * q); pg2[q] = *(const u32x4*)(gg + po + 8 * q); } }
                else { pv2[0] = pv2[1] = pg2[0] = pg2[1] = (u32x4){0u, 0u, 0u, 0u}; }
                { LAS float* lw = (LAS float*)(hp + HP_LW);
#pragma unroll
                  for (int q = 0; q < 2; ++q) { float f[8]; unpack8(xw[q], f); *(LAS f32x4*)(lw + t * 64 + j0 + 8 * q) = (f32x4){f[0], f[1], f[2], f[3]}; *(LAS f32x4*)(lw + t * 64 + j0 + 8 * q + 4) = (f32x4){f[4], f[5], f[6], f[7]}; }
                  asm volatile("s_waitcnt lgkmcnt(0)" ::: "memory");
                  float wv16[16];
#pragma unroll
                  for (int s = 0; s < 16; ++s) wv16[s] = lw[s * 64 + lane];
                  float run = 0.f;
#pragma unroll
                  for (int s = 0; s < 16; ++s) { run += wv16[s]; lw[s * 64 + lane] = __expf(run); }
                  asm volatile("s_waitcnt lgkmcnt(0)" ::: "memory"); }
                CAMP_T1(10);
                __syncthreads();
                CAMP_T0(11);
                {
                    const LAS float* lw = (const LAS float*)(hp + HP_LW);
                    float rf[16], kf[16], vf[16], af[16]; unpack16(xr[0], xr[1], rf); unpack16(xk[0], xk[1], kf); unpack16(xv[0], xv[1], vf); unpack16(xa[0], xa[1], af);
                    float kk[16], km[16]; float ss = 0.f, bon = 0.f;
#pragma unroll
                    for (int i = 0; i < 16; ++i) { kk[i] = kf[i] * cv[j0 + i]; ss += kk[i] * kk[i]; km[i] = kf[i] * (1.f + (af[i] - 1.f) * cv[64 + j0 + i]); bon += rf[i] * km[i] * cv[128 + j0 + i]; }
                    ss += dpp_xor1(ss); ss += dpp_xor2(ss); bon += dpp_xor1(bon); bon += dpp_xor2(bon); const float inv = 1.f / fmaxf(sqrtf(ss), 1e-12f);
                    if (jq == 0) ((LAS float*)(hp + HP_BON))[((c >> 2) & 1) * 16 + t] = bon;
                    LAS unsigned short* KTp = (LAS unsigned short*)(st + S_KT + t * PT) + j0; LAS unsigned short* RTp = (LAS unsigned short*)(st + S_RT + t * PT) + j0;
                    LAS unsigned short* BTp = (LAS unsigned short*)(hp + HP_BT + t * PT) + j0; LAS unsigned short* KKp = (LAS unsigned short*)(hp + HP_KK + t * PT) + j0;
                    float gt16[16], gp16[16];
#pragma unroll
                    for (int q = 0; q < 4; ++q) { const f32x4 x = *(const LAS f32x4*)(lw + t * 64 + j0 + 4 * q); gt16[4 * q] = x[0]; gt16[4 * q + 1] = x[1]; gt16[4 * q + 2] = x[2]; gt16[4 * q + 3] = x[3];
                        f32x4 y = (f32x4){1.f, 1.f, 1.f, 1.f}; if (t > 0) y = *(const LAS f32x4*)(lw + (t - 1) * 64 + j0 + 4 * q); gp16[4 * q] = y[0]; gp16[4 * q + 1] = y[1]; gp16[4 * q + 2] = y[2]; gp16[4 * q + 3] = y[3]; }
#pragma unroll
                    for (int i = 0; i < 16; i += 2) {
                        float kt2[2], rt2[2], bt2[2], kk2[2];
#pragma unroll
                        for (int e = 0; e < 2; ++e) { const int j = j0 + i + e; const float gt = gt16[i + e], gi = __builtin_amdgcn_rcpf(gt), gp = gp16[i + e]; const float kn = kk[i + e] * inv;
                            kt2[e] = kn * gp; rt2[e] = rf[i + e] * gt; bt2[e] = kn * af[i + e] * gi; kk2[e] = km[i + e] * gi;
                            ((LAS unsigned short*)(st + S_BKT + j * PW))[t] = bf1(-bt2[e]); ((LAS unsigned short*)(st + S_BKT + j * PW))[16 + t] = bf1(kk2[e]);
                            ((LAS unsigned short*)(st + S_WV + j * PW))[16 + t] = bf1(vf[i + e]);
                            if (t == 15) ((LAS float*)(st + S_GL))[j] = gt; }
                        *(LAS unsigned*)(KTp + i) = cvt_pk_bf16(kt2[0], kt2[1]); *(LAS unsigned*)(RTp + i) = cvt_pk_bf16(rt2[0], rt2[1]);
                        *(LAS unsigned*)(BTp + i) = cvt_pk_bf16(bt2[0], bt2[1]); *(LAS unsigned*)(KKp + i) = cvt_pk_bf16(kk2[0], kk2[1]); }
                    asm volatile("s_waitcnt lgkmcnt(0)" ::: "memory");
                }
                CAMP_T1(11);
                __syncthreads();
                CAMP_T0(12);
                if (c >= 4) {
                    const int cp = c - 4; const LAS float* ob = (const LAS float*)(lds + L_OB + (cp % 3) * 4096); const LAS float* bonp = (const LAS float*)(hp + HP_BON) + (((c >> 2) + 1) & 1) * 16;
                    const size_t po = hb + (size_t)(cp * 16 + t) * D + j0;
                    float ov[16]; float sm = 0.f;
#pragma unroll
                    for (int q = 0; q < 4; ++q) { const f32x4 x = *(const LAS f32x4*)(ob + t * 64 + j0 + 4 * q); ov[4 * q] = x[0]; ov[4 * q + 1] = x[1]; ov[4 * q + 2] = x[2]; ov[4 * q + 3] = x[3]; sm += (x[0] + x[1]) + (x[2] + x[3]); }
                    sm += dpp_xor1(sm); sm += dpp_xor2(sm); const float mean = sm * (1.f / 64.f); float qv = 0.f;
#pragma unroll
                    for (int i = 0; i < 16; ++i) { ov[i] -= mean; qv += ov[i] * ov[i]; }
                    qv += dpp_xor1(qv); qv += dpp_xor2(qv); const float rs = rsqrtf(qv * (1.f / 64.f) + GN_EPS); const float bon = bonp[t];
#pragma unroll
                    for (int q = 0; q < 2; ++q) { float vf[8], gf[8], y[8]; unpack8(pv2[q], vf); unpack8(pg2[q], gf);
#pragma unroll
                        for (int i = 0; i < 8; ++i) y[i] = (ov[8 * q + i] * rs * cv[192 + j0 + 8 * q + i] + cv[256 + j0 + 8 * q + i] + bon * vf[i]) * gf[i];
                        u32x4 w; w.x = cvt_pk_bf16(y[0], y[1]); w.y = cvt_pk_bf16(y[2], y[3]); w.z = cvt_pk_bf16(y[4], y[5]); w.w = cvt_pk_bf16(y[6], y[7]); *(u32x4*)(og + po + 8 * q) = w; }
                }
                {
                    const int fr = lane & 15, fq = lane >> 4;
                    f32x4 cN = {0.f, 0.f, 0.f, 0.f}, cM = cN, cP = cN, cQ = cN;
#pragma unroll
                    for (int ks = 0; ks < 2; ++ks) { const int off = fr * PT + (8 * fq + 32 * ks) * 2;
                        const bf16x8 aB = *(const LAS bf16x8*)(hp + HP_BT + off), aK = *(const LAS bf16x8*)(hp + HP_KK + off), bK = *(const LAS bf16x8*)(st + S_KT + off), bR = *(const LAS bf16x8*)(st + S_RT + off);
                        cN = MFMA16(aB, bK, cN); cM = MFMA16(aK, bK, cM); cP = MFMA16(aB, bR, cP); cQ = MFMA16(aK, bR, cQ); }
                    float mx[4], pp[4], qq[4]; LAS float* nf = (LAS float*)(hp + HP_NF);
#pragma unroll
                    for (int rg = 0; rg < 4; ++rg) { const int s = 4 * fq + rg; nf[s * 16 + fr] = s < fr ? cN[rg] : 0.f; mx[rg] = s < fr ? cM[rg] : 0.f; pp[rg] = s <= fr ? -cP[rg] : 0.f; qq[rg] = s <= fr ? cQ[rg] : 0.f; }
                    LAS unsigned char* mxt = st + S_MXT + fr * PW; LAS unsigned char* pqt = st + S_PQT + fr * PW;
                    *(LAS u32x2*)(mxt + 32 + 8 * fq) = (u32x2){cvt_pk_bf16(mx[0], mx[1]), cvt_pk_bf16(mx[2], mx[3])};
                    *(LAS u32x2*)(pqt + 8 * fq) = (u32x2){cvt_pk_bf16(pp[0], pp[1]), cvt_pk_bf16(pp[2], pp[3])};
                    *(LAS u32x2*)(pqt + 32 + 8 * fq) = (u32x2){cvt_pk_bf16(qq[0], qq[1]), cvt_pk_bf16(qq[2], qq[3])};
                    asm volatile("s_waitcnt lgkmcnt(0)" ::: "memory");
                }
                CAMP_T1(12);
                __syncthreads();
                CAMP_T0(13);
                {
                    const LAS float* nf = (const LAS float*)(hp + HP_NF); const int col = lane & 15; float Tc[16];
#pragma unroll
                    for (int s = 15; s >= 0; --s) { float acc = (s == col) ? 1.f : 0.f;
#pragma unroll
                        for (int u2 = s + 1; u2 < 16; ++u2) acc -= nf[s * 16 + u2] * Tc[u2];
#if defined(DBG_TID) && DBG_TID == 1
                        acc = (s == col) ? 1.f : 0.f;
#elif defined(DBG_TID) && DBG_TID == 2
                        acc = (s == col) ? 1.f : ((s < col) ? -nf[s * 16 + col] : 0.f);
#endif
                        Tc[s] = acc; }
                    if (lane < 16) { LAS unsigned char* tt = st + S_TT + col * PW;
#pragma unroll
                        for (int q = 0; q < 4; ++q) *(LAS u32x2*)(tt + 8 * q) = (u32x2){cvt_pk_bf16(Tc[4 * q], Tc[4 * q + 1]), cvt_pk_bf16(Tc[4 * q + 2], Tc[4 * q + 3])}; }
                    asm volatile("s_waitcnt lgkmcnt(0)" ::: "memory");
                }
                if (c + 4 < NCH) CS_PREFETCH(c + 4);
                CAMP_T1(13);
                __syncthreads();
            }
#undef CS_PREFETCH
            {
                const int cl = NCH - 4 + hw; __syncthreads();
                const LAS float* ob = (const LAS float*)(lds + L_OB + (cl % 3) * 4096); const LAS float* bonp = (const LAS float*)(hp + HP_BON) + ((cl >> 2) & 1) * 16; const size_t po = hb + (size_t)(cl * 16 + t) * D + j0;
                float ov[16]; float sm = 0.f;
#pragma unroll
                for (int q = 0; q < 4; ++q) { const f32x4 x = *(const LAS f32x4*)(ob + t * 64 + j0 + 4 * q); ov[4 * q] = x[0]; ov[4 * q + 1] = x[1]; ov[4 * q + 2] = x[2]; ov[4 * q + 3] = x[3]; sm += (x[0] + x[1]) + (x[2] + x[3]); }
                sm += dpp_xor1(sm); sm += dpp_xor2(sm); const float mean = sm * (1.f / 64.f); float qv = 0.f;
#pragma unroll
                for (int i = 0; i < 16; ++i) { ov[i] -= mean; qv += ov[i] * ov[i]; }
                qv += dpp_xor1(qv); qv += dpp_xor2(qv); const float rs = rsqrtf(qv * (1.f / 64.f) + GN_EPS); const float bon = bonp[t];
#pragma unroll
                for (int q = 0; q < 2; ++q) { const u32x4 pv2 = *(const u32x4*)(gv + po + 8 * q), pg2 = *(const u32x4*)(gg + po + 8 * q); float vf[8], gf[8], y[8]; unpack8(pv2, vf); unpack8(pg2, gf);
#pragma unroll
                    for (int i = 0; i < 8; ++i) y[i] = (ov[8 * q + i] * rs * cv[192 + j0 + 8 * q + i] + cv[256 + j0 + 8 * q + i] + bon * vf[i]) * gf[i];
                    u32x4 w; w.x = cvt_pk_bf16(y[0], y[1]); w.y = cvt_pk_bf16(y[2], y[3]); w.z = cvt_pk_bf16(y[4], y[5]); w.w = cvt_pk_bf16(y[6], y[7]); *(u32x4*)(og + po + 8 * q) = w; }
                for (int g = 0; g < 3 - hw; ++g) __syncthreads();
            }
        } else {
            const int fr = lane & 15, fq = lane >> 4, i0 = wv * 16; LAS unsigned char* sp = lds + L_SP + wv * SP_BYTES;
            f32x4 Sacc[4];
#pragma unroll
            for (int c4 = 0; c4 < 4; ++c4) Sacc[c4] = (f32x4){0.f, 0.f, 0.f, 0.f};
            for (int g = 0; g < 4; ++g) __syncthreads();
#pragma unroll 1
            for (int c = 0; c < NCH; ++c) {
                CAMP_T0(20);
                const LAS unsigned char* st = lds + L_SETS + (c % NS) * SET_BYTES; LAS unsigned char* stw = lds + L_SETS + (c % NS) * SET_BYTES;
                const bf16x8 aS0 = *(const LAS bf16x8*)(sp + SP_SB + fr * PT + (8 * fq) * 2), aS1 = *(const LAS bf16x8*)(sp + SP_SB + fr * PT + (8 * fq + 32) * 2);
                const bf16x8 bK0 = *(const LAS bf16x8*)(st + S_KT + fr * PT + (8 * fq) * 2), bK1 = *(const LAS bf16x8*)(st + S_KT + fr * PT + (8 * fq + 32) * 2);
                const bf16x8 bR0 = *(const LAS bf16x8*)(st + S_RT + fr * PT + (8 * fq) * 2), bR1 = *(const LAS bf16x8*)(st + S_RT + fr * PT + (8 * fq + 32) * 2);
                f32x4 G = MFMA16(aS0, bK0, ((f32x4){0.f, 0.f, 0.f, 0.f})); G = MFMA16(aS1, bK1, G);
                f32x4 O = MFMA16(aS0, bR0, ((f32x4){0.f, 0.f, 0.f, 0.f})); O = MFMA16(aS1, bR1, O);
                const bf16x8 aWV0 = *(const LAS bf16x8*)(st + S_WV + (i0 + fr) * PW + 16 * fq);
                const bf16x8 bMX = *(const LAS bf16x8*)(st + S_MXT + fr * PW + 16 * fq);
                G = MFMA16(aWV0, bMX, G);
                { LAS unsigned short* rb = (LAS unsigned short*)(sp + SP_RB);
#pragma unroll
                  for (int rg = 0; rg < 4; ++rg) rb[(4 * fq + rg) * 24 + fr] = bf1(G[rg]);
                  asm volatile("s_waitcnt lgkmcnt(0)" ::: "memory"); }
                bf16x8 aRH = *(const LAS bf16x8*)(sp + SP_RB + fr * 48 + 16 * (fq & 1)); if (fq >= 2) aRH = (bf16x8){0, 0, 0, 0, 0, 0, 0, 0};
#if defined(DBG_ARH)
                aRH = (fq >= 2) ? (bf16x8){0, 0, 0, 0, 0, 0, 0, 0} : (bf16x8){0x3f80, 0x3f80, 0x3f80, 0x3f80, 0x3f80, 0x3f80, 0x3f80, 0x3f80};
#endif
#if defined(DBG_BTT)
                const bf16x8 bTT = (fq >= 2) ? (bf16x8){0, 0, 0, 0, 0, 0, 0, 0} : (bf16x8){0x3f80, 0, 0, 0, 0, 0, 0, 0};
#else
                const bf16x8 bTT = *(const LAS bf16x8*)(st + S_TT + fr * PW + 16 * fq);
#endif
                const f32x4 W = MFMA16(aRH, bTT, ((f32x4){0.f, 0.f, 0.f, 0.f}));
                {
#pragma unroll
                  for (int rg = 0; rg < 4; ++rg) ((LAS unsigned short*)(stw + S_WV + (i0 + 4 * fq + rg) * PW))[fr] = bf1(W[rg]);
                  asm volatile("s_waitcnt lgkmcnt(0)" ::: "memory"); }
                const bf16x8 aWV = *(const LAS bf16x8*)(st + S_WV + (i0 + fr) * PW + 16 * fq);
                const bf16x8 bPQ = *(const LAS bf16x8*)(st + S_PQT + fr * PW + 16 * fq);
                O = MFMA16(aWV, bPQ, O);
#if defined(DBG_OSEL) && DBG_OSEL == 1
                O = G;
#elif defined(DBG_OSEL) && DBG_OSEL == 2
                O = W;
#elif defined(DBG_OSEL) && DBG_OSEL == 4
                O = (f32x4){bf2f((unsigned short)aRH[0]), bf2f((unsigned short)aRH[1]), bf2f((unsigned short)aRH[2]), bf2f((unsigned short)aRH[3])};
#elif defined(DBG_OSEL) && DBG_OSEL == 5
                O = (f32x4){bf2f(bf1(G[0])), bf2f(bf1(G[1])), bf2f(bf1(G[2])), bf2f(bf1(G[3]))};
#elif defined(DBG_OSEL) && DBG_OSEL == 3
                O = (f32x4){1.f + fr, 2.f, 3.f + fq, 4.f};
#endif
                *(LAS f32x4*)(lds + L_OB + (c % 3) * 4096 + (fr * 64 + i0 + 4 * fq) * 4) = O;
#pragma unroll
                for (int c4 = 0; c4 < 4; ++c4) { const bf16x8 bBK = *(const LAS bf16x8*)(st + S_BKT + (16 * c4 + fr) * PW + 16 * fq); const float gl = ((const LAS float*)(st + S_GL))[16 * c4 + fr];
                    Sacc[c4] = MFMA16(aWV, bBK, Sacc[c4]); Sacc[c4] = Sacc[c4] * gl; }
                { LAS unsigned short* sb = (LAS unsigned short*)(sp + SP_SB);
#pragma unroll
                  for (int c4 = 0; c4 < 4; ++c4)
#pragma unroll
                      for (int rg = 0; rg < 4; ++rg) sb[(4 * fq + rg) * (PT / 2) + 16 * c4 + fr] = bf1(Sacc[c4][rg]);
                  asm volatile("s_waitcnt lgkmcnt(0)" ::: "memory"); }
                CAMP_T1(20);
                __syncthreads();
            }
        }
        __syncthreads();
    }
#ifdef CS_AMP
    { const unsigned long long ts = __builtin_amdgcn_s_memrealtime(); while (__builtin_amdgcn_s_memrealtime() - ts < camp_acc) __builtin_amdgcn_s_sleep(8); }
#endif
}
}
namespace fx {
__device__ __forceinline__ bf16x8 ldg8(const bf16_t* p) { return *(const bf16x8*)p; }
__device__ __forceinline__ bf16x8 ldg4x2(const bf16_t* p) { const bf16x4 a = *(const bf16x4*)p, b = *(const bf16x4*)(p + 8); return (bf16x8){a[0], a[1], a[2], a[3], b[0], b[1], b[2], b[3]}; }
__device__ __forceinline__ bf16x8 packp(const f32x16& p, int s2) { u32x4 w; w.x = cvt_pk_bf16(p[8 * s2 + 0], p[8 * s2 + 1]); w.y = cvt_pk_bf16(p[8 * s2 + 2], p[8 * s2 + 3]); w.z = cvt_pk_bf16(p[8 * s2 + 4], p[8 * s2 + 5]); w.w = cvt_pk_bf16(p[8 * s2 + 6], p[8 * s2 + 7]); return __builtin_bit_cast(bf16x8, w); }
__device__ __forceinline__ int or8(int v) { v |= __builtin_amdgcn_update_dpp(0, v, 0xB1, 0xF, 0xF, true); v |= __builtin_amdgcn_update_dpp(0, v, 0x4E, 0xF, 0xF, true); v |= __builtin_amdgcn_update_dpp(0, v, 0x141, 0xF, 0xF, true); return v; }
#define MFMA32(a, b, c) __builtin_amdgcn_mfma_f32_32x32x16_bf16((a), (b), (c), 0, 0, 0)
constexpr float SCL = 0.125f * LOG2E;

constexpr int KP = 144, VP = 136;
constexpr int CKP = 144, CVP = 264;
constexpr int L_KB = 0, L_VB = 18432, L_CK = 35840, L_CV = 54272, L_IMPW = 71168, L_IMPF = 103936, L_SELM = 112128, L_INVS = 112384, L_UNI = 113408, L_JOBS = 113424;
constexpr float MASKV = -1e30f, MINIT = -5e29f;
__device__ __forceinline__ void attn_sub(const LAS unsigned char* kt, const LAS unsigned char* vtile, int sub, const bf16x8 (&qf)[4], int ql, int hh, float lanebias, bool emask, int key0s, int t, int winlim, float& m, float& lsum, f32x16 (&o)[2]) {
    f32x16 sa;
#pragma unroll
    for (int i = 0; i < 16; ++i) sa[i] = 0.f;
#pragma unroll
    for (int s = 0; s < 4; ++s) sa = MFMA32(*(const LAS bf16x8*)(kt + (sub * 32 + ql) * KP + 32 * s + 16 * hh), qf[s], sa);
    float mt = MASKV;
    if (emask) {
#pragma unroll
        for (int i = 0; i < 16; ++i) { const int key = key0s + (i & 3) + 8 * (i >> 2) + 4 * hh; const bool ok = key <= t && (t - key) < winlim; sa[i] = ok ? __builtin_fmaf(sa[i], SCL, lanebias) : MASKV; mt = fmaxf(mt, sa[i]); }
    } else {
#pragma unroll
        for (int i = 0; i < 16; ++i) { sa[i] = __builtin_fmaf(sa[i], SCL, lanebias); mt = fmaxf(mt, sa[i]); }
    }
    mt = max_xhalf(mt); const float mn = fmaxf(m, mt); const float alpha = __builtin_amdgcn_exp2f(m - mn); float ps = 0.f;
#pragma unroll
    for (int i = 0; i < 16; ++i) { sa[i] = __builtin_amdgcn_exp2f(sa[i] - mn); ps += sa[i]; }
    lsum = lsum * alpha + ps; m = mn;
    if (__ballot(alpha != 1.f) != 0ull) {
#pragma unroll
        for (int dt = 0; dt < 2; ++dt)
#pragma unroll
            for (int i = 0; i < 16; ++i) o[dt][i] *= alpha;
    }
#pragma unroll
    for (int s2 = 0; s2 < 2; ++s2) { const bf16x8 pf = packp(sa, s2);
#pragma unroll
        for (int dt = 0; dt < 2; ++dt) { const LAS unsigned char* vp = vtile + (dt * 32 + ql) * VP + (sub * 32 + 16 * s2 + 4 * hh) * 2;
            const bf16x4 a = *(const LAS bf16x4*)vp, b2 = *(const LAS bf16x4*)(vp + 16);
            o[dt] = MFMA32(((bf16x8){a[0], a[1], a[2], a[3], b2[0], b2[1], b2[2], b2[3]}), pf, o[dt]); } }
}

__device__ __forceinline__ void attn_job64(const LAS unsigned char* kt, const LAS unsigned char* vtile, const bf16x8 (&qf)[4], int ql, int hh, float lanebias, bool emask, int key0, int t, int winlim, float& m, f32x16& lacc, f32x16 (&o)[2]) {
    f32x16 sa[2];
#pragma unroll
    for (int sub = 0; sub < 2; ++sub)
#pragma unroll
        for (int i = 0; i < 16; ++i) sa[sub][i] = 0.f;
#pragma unroll
    for (int s = 0; s < 4; ++s)
#pragma unroll
        for (int sub = 0; sub < 2; ++sub) sa[sub] = MFMA32(*(const LAS bf16x8*)(kt + (sub * 32 + ql) * KP + 32 * s + 16 * hh), qf[s], sa[sub]);
    (void)m; const unsigned keep = lanebias < 0.f ? 0u : 0xffffffffu;
    if (emask) {
#pragma unroll
        for (int sub = 0; sub < 2; ++sub)
#pragma unroll
            for (int i = 0; i < 16; ++i) { const int key = key0 + sub * 32 + (i & 3) + 8 * (i >> 2) + 4 * hh; const bool ok = key <= t && (t - key) < winlim; sa[sub][i] = ok ? __builtin_amdgcn_exp2f(sa[sub][i]) : 0.f; }
    } else {
#pragma unroll
        for (int sub = 0; sub < 2; ++sub)
#pragma unroll
            for (int i = 0; i < 16; ++i) sa[sub][i] = __builtin_amdgcn_exp2f(sa[sub][i]);
    }
    const bf16x8 ones = (ql == 0) ? (bf16x8){0x3f80, 0x3f80, 0x3f80, 0x3f80, 0x3f80, 0x3f80, 0x3f80, 0x3f80} : (bf16x8){0, 0, 0, 0, 0, 0, 0, 0};
#pragma unroll
    for (int sub = 0; sub < 2; ++sub)
#pragma unroll
        for (int s2 = 0; s2 < 2; ++s2) { bf16x8 pf = packp(sa[sub], s2); if (keep == 0u) pf = (bf16x8){0, 0, 0, 0, 0, 0, 0, 0};
            lacc = MFMA32(ones, pf, lacc);
#pragma unroll
            for (int dt = 0; dt < 2; ++dt) { const LAS unsigned char* vp = vtile + (dt * 32 + ql) * VP + (sub * 32 + 16 * s2 + 4 * hh) * 2;
                const bf16x4 a = *(const LAS bf16x4*)vp, b2 = *(const LAS bf16x4*)(vp + 16);
                o[dt] = MFMA32(((bf16x8){a[0], a[1], a[2], a[3], b2[0], b2[1], b2[2], b2[3]}), pf, o[dt]); } }
}

#ifdef ATT_AMP
#define AMP_T0(sec) unsigned long long _t0_##sec = __builtin_amdgcn_s_memrealtime()
#define AMP_T1(sec) do { if (ATT_AMP == sec) amp_acc += __builtin_amdgcn_s_memrealtime() - _t0_##sec; } while (0)
#else
#define AMP_T0(sec) do { } while (0)
#define AMP_T1(sec) do { } while (0)
#endif
__device__ __forceinline__ void attn_phase(const Params& P, LAS unsigned char* lds) {
    unsigned char* ws = P.ws; unsigned long long amp_acc = 0; (void)amp_acc;
    const bf16_t* q = (const bf16_t*)(ws + A_Q); const bf16_t* qr = (const bf16_t*)(ws + A_QR); const bf16_t* kcmp = (const bf16_t*)(ws + A_KCMP); const bf16_t* vcT = (const bf16_t*)(ws + A_VCMPT);
    const bf16_t* ks = (const bf16_t*)(ws + A_KS); const bf16_t* kw = (const bf16_t*)(ws + A_KW); const bf16_t* vts = (const bf16_t*)(ws + A_VTS); const bf16_t* vtw = vts + (size_t)256 * M;
    const float* gates = (const float*)(ws + A_GATES); bf16_t* att = (bf16_t*)(ws + A_ATT);
    LAS float* impw = (LAS float*)(lds + L_IMPW); LAS float* impf = (LAS float*)(lds + L_IMPF); LAS unsigned* selm = (LAS unsigned*)(lds + L_SELM); LAS float* invs = (LAS float*)(lds + L_INVS);
    LAS unsigned* uni = (LAS unsigned*)(lds + L_UNI); LAS unsigned char* jobs = lds + L_JOBS;
    const int tid = threadIdx.x, lane = tid & 63, wid = tid >> 6, r = wid & 3, c2 = wid >> 2, ql = lane & 31, hh = lane >> 5;
    const int srow = tid >> 3, schunk = tid & 7;
    for (int it = blockIdx.x; it < 2048; it += gridDim.x) {
        const int j = it >> 8, w = it & 255, wq = w >> 6; const int qb = 31 - ((j & 1) ? (3 - wq) : wq) - 4 * j; const int bg = w & 63, b = bg >> 2, g = bg & 3;
        const int head = g * 4 + r, t = qb * 64 + c2 * 32 + ql; const size_t qoff = (size_t)(b * T + t) * 1024 + head * 64;
        const float g0 = gates[(size_t)(b * T + t) * 64 + head * 3 + 0], g1 = gates[(size_t)(b * T + t) * 64 + head * 3 + 1], g2 = gates[(size_t)(b * T + t) * 64 + head * 3 + 2];
        AMP_T0(1); AMP_T0(5);
        {
            const u32x4* kc4 = (const u32x4*)(kcmp + (size_t)bg * 128 * 64); const u32x4* vc4 = (const u32x4*)(vcT + (size_t)bg * 64 * 128);
#pragma unroll
            for (int i = 0; i < 2; ++i) { const int e = tid + 512 * i;
                const u32x4 kv = kc4[e]; const u32x4 vv = vc4[e];
                *(LAS u32x4*)(lds + L_CK + (e >> 3) * CKP + (e & 7) * 16) = kv;
                LAS unsigned char* vd = lds + L_CV + (e >> 4) * CVP + (e & 15) * 16; *(LAS u32x2*)vd = (u32x2){vv.x, vv.y}; *(LAS u32x2*)(vd + 8) = (u32x2){vv.z, vv.w}; }
            if (tid == 0) uni[0] = 0u;
        }
        __syncthreads();
        AMP_T1(5); AMP_T0(6);
        unsigned otp[2][8];
        {
            bf16x8 qf[4];
#pragma unroll
            for (int s = 0; s < 4; ++s) qf[s] = ldg8(q + qoff + 16 * s + 8 * hh);
            float ls = 0.f, ecarry = 0.f; f32x16 oc[2];
#pragma unroll
            for (int dt = 0; dt < 2; ++dt)
#pragma unroll
                for (int i = 0; i < 16; ++i) oc[dt][i] = 0.f;
            LAS float* iw = impw + (size_t)(r * 64 + c2 * 32 + ql) * 32;
#pragma unroll 2
            for (int tl = 0; tl < 4; ++tl) { f32x16 a;
#pragma unroll
                for (int i = 0; i < 16; ++i) a[i] = 0.f;
#pragma unroll
                for (int s = 0; s < 4; ++s) a = MFMA32(*(const LAS bf16x8*)(lds + L_CK + (tl * 32 + ql) * CKP + 32 * s + 16 * hh), qf[s], a);
#pragma unroll
                for (int i = 0; i < 16; ++i) { const int n = tl * 32 + (i & 3) + 8 * (i >> 2) + 4 * hh; const float pv = (n * 16 + 31 <= t) ? __builtin_amdgcn_exp2f(a[i]) : 0.f; a[i] = pv; ls += pv; }
                float ep[4];
#pragma unroll
                for (int gg = 0; gg < 4; ++gg) ep[gg] = xhalf(a[4 * gg + 3]);
#pragma unroll
                for (int gg = 0; gg < 4; ++gg) { const float Gs = (a[4 * gg] + a[4 * gg + 1]) + (a[4 * gg + 2] + a[4 * gg + 3]);
                    const float eprev0 = gg > 0 ? ep[gg > 0 ? gg - 1 : 0] : ecarry; const float e = hh ? ep[gg] : eprev0; iw[tl * 8 + 2 * gg + hh] = Gs + e; }
                ecarry = ep[3];
#pragma unroll
                for (int s2 = 0; s2 < 2; ++s2) { const bf16x8 pf = packp(a, s2);
#pragma unroll
                    for (int dt = 0; dt < 2; ++dt) { const LAS unsigned char* vp = lds + L_CV + (dt * 32 + ql) * CVP + (tl * 32 + 16 * s2 + 4 * hh) * 2;
                        const bf16x4 x = *(const LAS bf16x4*)vp, y = *(const LAS bf16x4*)(vp + 16);
                        oc[dt] = MFMA32(((bf16x8){x[0], x[1], x[2], x[3], y[0], y[1], y[2], y[3]}), pf, oc[dt]); } } }
            ls = sum_xhalf(ls); const float inv = ls > 0.f ? 1.f / ls : 0.f;
            if (hh == 0) invs[r * 64 + c2 * 32 + ql] = inv;
            const float sc0 = inv * g0;
#pragma unroll
            for (int dt = 0; dt < 2; ++dt)
#pragma unroll
                for (int i = 0; i < 8; ++i) otp[dt][i] = cvt_pk_bf16(oc[dt][2 * i] * sc0, oc[dt][2 * i + 1] * sc0);
        }
        AMP_T1(6); AMP_T0(7);
        __syncthreads();
        {
            const int qq = tid >> 3, sg = tid & 7;
#pragma unroll
            for (int i = 0; i < 4; ++i) { const int s = sg * 4 + i; const float tot = ((impw[(0 * 64 + qq) * 32 + s] * invs[qq] + impw[(1 * 64 + qq) * 32 + s] * invs[64 + qq]) + impw[(2 * 64 + qq) * 32 + s] * invs[128 + qq]) + impw[(3 * 64 + qq) * 32 + s] * invs[192 + qq];
                const bool forced = (s == 0) || (s == qb) || (s == qb - 1); impf[qq * 32 + s] = forced ? 1e4f : (s <= qb ? tot : -1e30f); }
        }
        __syncthreads();
        {
            const int qq = tid >> 3, sg = tid & 7; const f32x4 x = *(const LAS f32x4*)(impf + qq * 32 + 4 * sg);
            float c0 = x[0], c1 = x[1], c2 = x[2], c3 = x[3]; int bits = 0;
#pragma unroll
            for (int k = 0; k < 8; ++k) {
                const float gm = max8(fmaxf(fmaxf(c0, c1), fmaxf(c2, c3)));
                const int li = c0 == gm ? 0 : (c1 == gm ? 1 : (c2 == gm ? 2 : (c3 == gm ? 3 : 64)));
                const int gi = imin8(4 * sg + li);
                bits |= 1 << gi; const int me = gi - 4 * sg;
                c0 = me == 0 ? -3e38f : c0; c1 = me == 1 ? -3e38f : c1; c2 = me == 2 ? -3e38f : c2; c3 = me == 3 ? -3e38f : c3;
            }
            if (sg == 0) { selm[qq] = (unsigned)bits; __hip_atomic_fetch_or(uni, (unsigned)bits, __ATOMIC_RELAXED, __HIP_MEMORY_SCOPE_WORKGROUP); }
        }
        __syncthreads();
        AMP_T1(7); AMP_T0(8);
        const unsigned um = uni[0] & (qb >= 31 ? 0xffffffffu : ((1u << (qb + 1)) - 1u));
        const int nslc = __popc(um); const int wlo = qb - 8 > 0 ? qb - 8 : 0; const int njobs = nslc + (qb - wlo + 1);
        if (tid == 0) { int n = 0; for (int sb = 0; sb <= qb; ++sb) if ((um >> sb) & 1u) jobs[n++] = (unsigned char)sb; for (int kb = wlo; kb <= qb; ++kb) jobs[n++] = (unsigned char)kb; }
        const unsigned sel = selm[c2 * 32 + ql];
        bf16x8 qf[4];
#pragma unroll
        for (int s = 0; s < 4; ++s) qf[s] = ldg8(qr + qoff + 16 * s + 8 * hh);
        __syncthreads();
        AMP_T1(1); AMP_T1(8);
        AMP_T0(2);
        const bf16_t* ksb = ks + (size_t)bg * T * 64; const bf16_t* kwb = kw + (size_t)bg * T * 64;
        const bf16_t* vsb = vts + (size_t)(g * 64) * M + (size_t)b * T; const bf16_t* vwb = vtw + (size_t)(g * 64) * M + (size_t)b * T;
        u32x4 kregA, vregA, kregB, vregB;
#define ATT_LOAD(ji, KR, VR) do { const int _blk = jobs[(ji)]; const bool _win = (ji) >= nslc; const bf16_t* _kb = _win ? kwb : ksb; const bf16_t* _vb = _win ? vwb : vsb; \
            KR = *(const u32x4*)(_kb + (size_t)(_blk * 64 + srow) * 64 + schunk * 8); VR = *(const u32x4*)(_vb + (size_t)srow * M + _blk * 64 + schunk * 8); } while (0)
#define ATT_STORE(buf, KR, VR) do { *(LAS u32x4*)(lds + L_KB + (buf) * 9216 + srow * KP + schunk * 16) = KR; LAS unsigned char* _vd = lds + L_VB + (buf) * 8704 + srow * VP + schunk * 16; \
            *(LAS u32x2*)_vd = (u32x2){VR.x, VR.y}; *(LAS u32x2*)(_vd + 8) = (u32x2){VR.z, VR.w}; } while (0)
#define ATT_COMPUTE(ji) do { \
            if ((ji) == nslc) { const float ls = sum_xhalf(hh == 0 ? lacc[0] : 0.f); const float sc1 = ls > 0.f ? g1 / ls : 0.f; \
                _Pragma("unroll") for (int dt = 0; dt < 2; ++dt) _Pragma("unroll") for (int i = 0; i < 8; ++i) { otp[dt][i] = cvt_pk_bf16(bflo(otp[dt][i]) + o[dt][2 * i] * sc1, bfhi(otp[dt][i]) + o[dt][2 * i + 1] * sc1); o[dt][2 * i] = 0.f; o[dt][2 * i + 1] = 0.f; } \
                m = MINIT; _Pragma("unroll") for (int i = 0; i < 16; ++i) lacc[i] = 0.f; } \
            const int blk = jobs[(ji)]; const bool win = (ji) >= nslc; const int buf = (ji) & 1; \
            const LAS unsigned char* kt = lds + L_KB + buf * 9216; const LAS unsigned char* vtile = lds + L_VB + buf * 8704; \
            const bool mine = win || ((sel >> blk) & 1u); \
            if (__ballot(mine) != 0ull) { const float lb = mine ? 0.f : MASKV; const bool emask = win ? (blk == qb || blk == qb - 8) : (blk == qb); const int wl = win ? 512 : (1 << 30); \
                attn_job64(kt, vtile, qf, ql, hh, lb, emask, blk * 64, t, wl, m, lacc, o); } } while (0)
        ATT_LOAD(0, kregB, vregB); ATT_STORE(0, kregB, vregB);
        if (njobs > 1) ATT_LOAD(1, kregA, vregA);
        if (njobs > 2) ATT_LOAD(2, kregB, vregB);
        __syncthreads();
        float m = MINIT; f32x16 o[2], lacc;
#pragma unroll
        for (int i = 0; i < 16; ++i) lacc[i] = 0.f;
#pragma unroll
        for (int dt = 0; dt < 2; ++dt)
#pragma unroll
            for (int i = 0; i < 16; ++i) o[dt][i] = 0.f;
#pragma unroll 1
        for (int ji = 0; ji < njobs; ji += 2) {
            {
                { AMP_T0(3); ATT_COMPUTE(ji); AMP_T1(3); }
                { AMP_T0(4); if (ji + 1 < njobs) ATT_STORE(1, kregA, vregA);
                __syncthreads();
                if (ji + 3 < njobs) ATT_LOAD(ji + 3, kregA, vregA); AMP_T1(4); }
            }
            if (ji + 1 < njobs) {
                { AMP_T0(3); ATT_COMPUTE(ji + 1); AMP_T1(3); }
                { AMP_T0(4); if (ji + 2 < njobs) ATT_STORE(0, kregB, vregB);
                __syncthreads();
                if (ji + 4 < njobs) ATT_LOAD(ji + 4, kregB, vregB); AMP_T1(4); }
            }
        }
#undef ATT_COMPUTE
        AMP_T1(2);
#undef ATT_LOAD
#undef ATT_STORE
        {
            const float ls = sum_xhalf(hh == 0 ? lacc[0] : 0.f); const float sc2 = ls > 0.f ? g2 / ls : 0.f;
#pragma unroll
            for (int dt = 0; dt < 2; ++dt)
#pragma unroll
                for (int i = 0; i < 8; ++i) otp[dt][i] = cvt_pk_bf16(bflo(otp[dt][i]) + o[dt][2 * i] * sc2, bfhi(otp[dt][i]) + o[dt][2 * i + 1] * sc2);
        }
#pragma unroll
        for (int dt = 0; dt < 2; ++dt)
#pragma unroll
            for (int g4 = 0; g4 < 4; ++g4) { u32x2 wv; wv.x = otp[dt][2 * g4]; wv.y = otp[dt][2 * g4 + 1];
                *(u32x2*)(att + qoff + dt * 32 + 8 * g4 + 4 * hh) = wv; }
        __syncthreads();
    }
#ifdef ATT_AMP
    { const unsigned long long ts = __builtin_amdgcn_s_memrealtime(); while (__builtin_amdgcn_s_memrealtime() - ts < amp_acc) __builtin_amdgcn_s_sleep(8); }
#endif
}

#define XB_TMO      128
#define XB_XCNT(j)  (256  + 64 * (j))
#define XB_XSUB(j)  (1280 + 64 * (j))
#define XB_XGEN(j)  (2304 + 64 * (j))
#define XB_TOP      3328
#define XB_TOPGEN   3392
#define XCD_BAR_WORDS 3456
#define XB_SPIN_CAP (1u << 18)

__device__ __forceinline__ unsigned xb_ld(unsigned* p)              { return __hip_atomic_load(p, __ATOMIC_RELAXED, __HIP_MEMORY_SCOPE_AGENT); }
__device__ __forceinline__ unsigned xb_add(unsigned* p, unsigned v) { return __hip_atomic_fetch_add(p, v, __ATOMIC_RELAXED, __HIP_MEMORY_SCOPE_AGENT); }
__device__ __forceinline__ unsigned xb_xcc_id() { return (unsigned)__builtin_amdgcn_s_getreg((3 << 11) | 20) & 0xFu; }
#define XB_SPIN(cond, bar) do { unsigned _sp = 0; while (cond) { __builtin_amdgcn_s_sleep(1); \
    if ((++_sp & 255u) == 0u) { if (xb_ld(&(bar)[XB_TMO])) break; if (_sp > XB_SPIN_CAP) { atomicAdd(&(bar)[XB_TMO], 1u); break; } } } } while (0)

struct XcdBarrier {
    unsigned* bar; unsigned x;
    volatile LAS unsigned* st;
};

__device__ __forceinline__ XcdBarrier xcd_barrier_post(unsigned* bar, volatile LAS unsigned* st) {
    XcdBarrier b; b.bar = bar; b.x = xb_xcc_id(); b.st = st;
    if (threadIdx.x == 0) (void)xb_add(&bar[XB_XCNT(b.x)], 1u);
    return b;
}
__device__ __forceinline__ void xcd_barrier_complete(unsigned* bar, unsigned x, unsigned& nloc, unsigned& nx) {
    const unsigned G = gridDim.x * gridDim.y * gridDim.z;
    unsigned sum, cnt, mine, sp = 0u;
    for (;;) {
        sum = 0u; cnt = 0u; mine = 0u;
#pragma unroll
        for (unsigned j = 0; j < 16; ++j) { const unsigned c = xb_ld(&bar[XB_XCNT(j)]); sum += c; cnt += (c > 0u) ? 1u : 0u; mine = (j == x) ? c : mine; }
        if (sum == G) break;
        __builtin_amdgcn_s_sleep(1);
        if ((++sp & 255u) == 0u) { if (xb_ld(&bar[XB_TMO])) break; if (sp > XB_SPIN_CAP) { atomicAdd(&bar[XB_TMO], 1u); break; } }
    }
    nloc = mine > 0u ? mine : 1u; nx = cnt > 0u ? cnt : 1u;
}

__device__ __forceinline__ void xcd_barrier(const XcdBarrier& b) {
    asm volatile("s_waitcnt vmcnt(0)" ::: "memory");
    __syncthreads();
    if (threadIdx.x == 0) {
        unsigned* bar = b.bar;
        __builtin_amdgcn_s_waitcnt(0);
        unsigned nloc = b.st[0], nx = b.st[1];
        if (nloc == 0u) { xcd_barrier_complete(bar, b.x, nloc, nx); b.st[0] = nloc; b.st[1] = nx; }
        const unsigned old = xb_add(&bar[XB_XSUB(b.x)], 1u);
        const unsigned gen = old / nloc;
        if (old + 1u == (gen + 1u) * nloc) {
            __builtin_amdgcn_fence(__ATOMIC_RELEASE, "agent");
            asm volatile("s_waitcnt vmcnt(0)" ::: "memory");
            const unsigned og = xb_add(&bar[XB_TOP], 1u);
            const unsigned tg = og / nx;
            if (og + 1u == (tg + 1u) * nx) xb_add(&bar[XB_TOPGEN], 1u);
            else XB_SPIN(xb_ld(&bar[XB_TOPGEN]) == tg, bar);
            __builtin_amdgcn_fence(__ATOMIC_ACQUIRE, "agent");
            xb_add(&bar[XB_XGEN(b.x)], 1u);
            asm volatile("s_waitcnt vmcnt(0)" ::: "memory");
        } else {
            XB_SPIN(xb_ld(&bar[XB_XGEN(b.x)]) == gen, bar);
            __builtin_amdgcn_fence(__ATOMIC_ACQUIRE, "agent");
            asm volatile("s_waitcnt vmcnt(0)" ::: "memory");
        }
    }
    __syncthreads();
}


__device__ __forceinline__ JobD job(const void* A, const void* B, long tileA, long tileB, int nM, int nN, int nt) { JobD j; j.A = (const char*)A; j.B = (const char*)B; j.tileA = tileA; j.tileB = tileB; j.nM = nM; j.nN = nN; j.nt = nt; j.ksplit = 1 << 30; j.wrapA = 0; j.wrapB = 0; j.batchA = 0; j.batchB = 0; j.tileBm = 0; j.shA = 0; j.shB = 0; return j; }
constexpr int NPHASE = 23;
constexpr int LDS_BYTES = 147456;
__global__ void __launch_bounds__(512, 2) mega(Params P) {
    extern __shared__ __attribute__((aligned(16))) unsigned char lds_raw[];
    LAS unsigned char* lds = (LAS unsigned char*)lds_raw;
    cooperative_groups::grid_group grid = cooperative_groups::this_grid();
    const In& I = P.in; unsigned char* ws = P.ws; const int G = gridDim.x, c = blockIdx.x;
    const int lo = P.ph_lo, hi = P.ph_hi;
    volatile LAS unsigned* bst = (volatile LAS unsigned*)(lds + LDS_BYTES - 16);
    if (threadIdx.x == 0) { bst[0] = 0u; bst[1] = 0u; }
    __syncthreads();
    if (P.ph_lo < 0) grid.sync();
    XcdBarrier bar = xcd_barrier_post((unsigned*)(ws + X_BAR) + P.li * XCD_BAR_WORDS, bst);
#ifndef PHMASK
#define PHMASK 0xffffffffu
#endif
#define IN(k) ((((PHMASK) >> (k)) & 1u) && lo <= (k) && (k) < hi)
#ifdef TIMING
#define STAMP(k) do { if (blockIdx.x == 0 && threadIdx.x == 0) ((unsigned long long*)(ws + X_CTL + 1024))[(k)] = __builtin_amdgcn_s_memrealtime(); } while (0)
#define SEAM(k) do { if (IN(k) && IN((k) + 1)) { xcd_barrier(bar); } STAMP((k) + 1); } while (0)
#else
#define STAMP(k) do { } while (0)
#define SEAM(k) do { if (IN(k) && IN((k) + 1)) { xcd_barrier(bar); } } while (0)
#endif
#ifndef DUP_MASK
#define DUP_MASK 0u
#endif
#define PH(k, ...) if (IN(k)) { { __VA_ARGS__ } if (((DUP_MASK) >> (k)) & 1u) { xcd_barrier(bar); { __VA_ARGS__ } } } SEAM(k);
    const long T1K = 256L * 1024 * 2;
    STAMP(0);
#ifdef EXTRA_SYNCS
    for (int i = 0; i < EXTRA_SYNCS; ++i) xcd_barrier(bar);
#endif
    PH(0,  prep_phase(P, lds); )
    PH(1,  StaticSched S; S.G = G; S.c = c; S.lda = 2048; S.ldb = 2048; S.nj = 2;
        S.j0 = job(ws + A_MIX, ws + W_RKV, T1K, T1K, 384, 4, 16); S.j0.shB = 7; S.j0.batchB = 2 * MiB;
        S.j1 = job((unsigned char*)P.out + O_XB + 2048, ws + W_L1, T1K, T1K, 128, 1, 32); S.j1.ksplit = 16; S.j1.wrapA = -(16L * 128 + 2048); S.j1.wrapB = 256L * 1024 * 2 - 16L * 128; S.j1.shA = 3; S.j1.batchA = 2048;
        EpiP1 E{(bf16_t*)(ws + A_RKV), (bf16_t*)((unsigned char*)P.out + O_HL)};
        struct SchedP1 { StaticSched s; __device__ __forceinline__ bool next(int i, Unit& u) const {
                if (s.G != 256) return s.next(i, u);
                const int c = s.c; long L;
                if (i == 0) L = c < 128 ? 1536 + c : c - 128; else if (i <= 5) L = 128 + (long)(i - 1) * 256 + c; else if (i == 6 && c >= 128) L = 1408 + (c - 128); else return false;
                StaticSched t = s; t.G = 1; t.c = 0; return t.next((int)L, u); }
            int lda, ldb; } SP; SP.s = S; SP.lda = S.lda; SP.ldb = S.ldb;
        gemm_phase(lds, SP, E); )
    PH(2,  StaticSched S; S.G = G; S.c = c; S.lda = 512; S.ldb = 512; S.nj = 1; S.j0 = job((unsigned char*)P.out + O_HL, ws + W_L2, 256L * 256 * 2, 256L * 256 * 2, 128, 12, 4); S.j1 = S.j0;
        EpiP2 E{(bf16_t*)(ws + A_WAG), I.a_w0, I.a_a0}; gemm_phase(lds, S, E); )
#ifdef DUP_SCAN
    if (IN(3)) { scan_phase(P, lds, (bf16_t*)P.out); xcd_barrier(bar); }
#endif
#if defined(DBG_SCAN)
    if (IN(3)) {
        scan_chunked(P, lds, (bf16_t*)P.out); xcd_barrier(bar);
        scan_phase(P, lds, (bf16_t*)(ws + A_RKV)); xcd_barrier(bar);
        { const bf16_t* a = (const bf16_t*)P.out; const bf16_t* r2 = (const bf16_t*)(ws + A_RKV); float s0 = 0.f, s1 = 0.f;
          for (size_t i = (size_t)blockIdx.x * 512 + threadIdx.x; i < (size_t)M * D; i += (size_t)gridDim.x * 512) { const int tt = (int)((i >> 10) & 2047); if (tt < DBG_TMIN || tt >= DBG_TMAX) continue; float x = bf2f(a[i]), y = bf2f(r2[i]);
#if DBG_MODE == 1
            if (!(fabsf(x) < 1e30f)) { s0 += 1.f; } s1 += 1.f; }
#else
            if (!(fabsf(x) < 1e30f)) continue; s0 += (x - y) * (x - y); s1 += y * y; }
#endif
          s0 = wave_sum(s0); s1 = wave_sum(s1); if ((threadIdx.x & 63) == 0) { atomicAdd((float*)(ws + X_CTL) + 300, s0); atomicAdd((float*)(ws + X_CTL) + 301, s1); } }
    } SEAM(3);
#elif defined(SCAN_OLD)
    PH(3,  scan_phase(P, lds, (bf16_t*)(ws + A_RKV)); )
#else
    PH(3,  scan_chunked(P, lds, (bf16_t*)(ws + A_RKV)); )
#endif
    PH(4,  StaticSched S; S.G = G; S.c = c; S.lda = 2048; S.ldb = 2048; S.nj = 1; S.j0 = job(ws + A_RKV, ws + W_AO, T1K, T1K, 128, 4, 16); S.j1 = S.j0; EpiResid E{I.x, nullptr, (_Float16*)P.out, nullptr, nullptr, nullptr}; gemm_phase(lds, S, E); )
    PH(5,  ln_phase(P, lds, 0, (bf16_t*)(ws + A_X1B), nullptr, false, I.p, (bf16_t*)(ws + A_PB0), (_Float16*)P.out, (_Float16*)P.out); )
    PH(6,  StaticSched S; S.G = G; S.c = c; S.lda = 2048; S.ldb = 2048; S.nj = 1; S.j0 = job(ws + A_X1B, ws + W_FGU, T1K, T1K, 128, 22, 16); S.j1 = S.j0; EpiGlu E{(bf16_t*)(ws + A_H), DFF}; gemm_phase(lds, S, E); )
    PH(7,  StaticSched S; S.G = G; S.c = c; S.lda = DFF * 2; S.ldb = DFF * 2; S.nj = 1; S.j0 = job(ws + A_H, ws + W_FDN, 256L * DFF * 2, 256L * DFF * 2, 128, 4, 44); S.j1 = S.j0; EpiResid E{nullptr, (_Float16*)P.out, (_Float16*)P.out, (const f32x2*)(ws + X_STAT), I.ln_g, I.ln_b}; gemm_phase(lds, S, E); )
    PH(8,  { StaticSched S; S.G = G; S.c = c; S.lda = 512; S.ldb = 512; S.nj = 1; S.j0 = job(ws + A_PB0, ws + W_PLE, 256L * 256 * 2, 256L * 256 * 2, 128, 4, 4); S.j1 = S.j0; EpiBf16 E{(bf16_t*)(ws + A_PP0), nullptr, 1024, nullptr, nullptr, 0}; gemm_phase(lds, S, E); }
        ln_phase(P, lds, 1, (bf16_t*)(ws + A_X2B), nullptr, false, nullptr, nullptr, (_Float16*)P.out, (_Float16*)P.out); )
    PH(10,  StaticSched S; S.G = G; S.c = c; S.lda = 2048; S.ldb = 2048; S.nj = 1; S.j0 = job(ws + A_X2B, ws + W_GATE, T1K, T1K, 128, 4, 16); S.j1 = S.j0; EpiGate E{(_Float16*)P.out, (_Float16*)P.out, nullptr, (const bf16_t*)(ws + A_PP0), I.ple_gate_b, (bf16_t*)(ws + A_X3B), (const f32x2*)(ws + X_STAT) + (size_t)M, I.ln_g + D, I.ln_b + D}; gemm_phase(lds, S, E); )
    PH(11,  StaticSched S; S.G = G; S.c = c; S.lda = 2048; S.ldb = 2048; S.nj = 2; S.j0 = job(ws + A_X3B, ws + W_NSA, T1K, T1K, 128, 9, 16); S.j1 = job(ws + W_VT, ws + A_X3B, T1K, T1K, 2, 128, 16);
        EpiNsa E{ws}; gemm_phase(lds, S, E); )
    PH(12,  StaticSched S; S.G = G; S.c = c; S.lda = 2048; S.ldb = 4096; S.nj = 2;
        S.j0 = job(ws + A_KC, ws + W_PHI, 1024, 0, 128, 1, 8); S.j0.shA = 2; S.j0.batchA = T1K - 4096; S.j0.tileBm = 1024; S.j0.shB = 2; S.j0.batchB = -4096;
        S.j1 = job(ws + A_VC, ws + W_PHI + MiB, 1024, 0, 128, 1, 8); S.j1.shA = 2; S.j1.batchA = T1K - 4096; S.j1.tileBm = 1024; S.j1.shB = 2; S.j1.batchB = -4096;
        EpiPart E{(float*)(ws + A_HCP)}; gemm_phase(lds, S, E); )
    PH(13,  cmp2_phase(P, lds); )
    PH(14,  attn_phase(P, lds); )
    PH(15,  StaticSched S; S.G = G; S.c = c; S.lda = 2048; S.ldb = 2048; S.nj = 1; S.j0 = job(ws + A_ATT, ws + W_BO, T1K, T1K, 128, 4, 16); S.j1 = S.j0; EpiResid E{nullptr, (_Float16*)P.out, (_Float16*)P.out, nullptr, nullptr, nullptr}; gemm_phase(lds, S, E); )
    PH(16,  ln_phase(P, lds, 2, (bf16_t*)(ws + A_X4B), nullptr, true, I.p + (size_t)M * PLE, (bf16_t*)(ws + A_PB1), (_Float16*)P.out, (_Float16*)P.out); )
    PH(17,  moe_gather_phase(P); )
    PH(18,  MoeSched S; S.A = (const char*)(ws + A_XS); S.B = (const char*)(ws + W_MGU); S.tileA = T1K; S.tileB = T1K; S.strideE = 2816L * 1024 * 2; S.nN = 11; S.nt = 16; S.G = G; S.c = c; S.lda = 2048; S.ldb = 2048; S.init((const unsigned*)(ws + X_CTL) + CW_CNT);
        EpiGlu E{(bf16_t*)(ws + A_HM), DFE}; gemm_phase(lds, S, E); )
    PH(19,  MoeSched S; S.A = (const char*)(ws + A_HM); S.B = (const char*)(ws + W_MDN); S.tileA = 256L * DFE * 2; S.tileB = 256L * DFE * 2; S.strideE = 1024L * DFE * 2; S.nN = 4; S.nt = 22; S.G = G; S.c = c; S.lda = DFE * 2; S.ldb = DFE * 2; S.init((const unsigned*)(ws + X_CTL) + CW_CNT);
        EpiMoeDown E{(bf16_t*)(ws + A_YS2), (const int*)(ws + X_RDST), (const float*)(ws + X_RW)}; gemm_phase(lds, S, E); )
    PH(20,  { StaticSched S; S.G = G; S.c = c; S.lda = 512; S.ldb = 512; S.nj = 1; S.j0 = job(ws + A_PB1, ws + W_PLE + MiB / 2, 256L * 256 * 2, 256L * 256 * 2, 128, 4, 4); S.j1 = S.j0; EpiBf16 E{(bf16_t*)(ws + A_PP1), nullptr, 1024, nullptr, nullptr, 0}; gemm_phase(lds, S, E); }
        ln_phase(P, lds, 3, (bf16_t*)(ws + A_X5B), (const bf16_t*)(ws + A_YS2), false, nullptr, nullptr, (_Float16*)P.out, (_Float16*)(ws + A_STREAM2)); )
    PH(22,  StaticSched S; S.G = G; S.c = c; S.lda = 2048; S.ldb = 2048; S.nj = 1; S.j0 = job(ws + A_X5B, ws + W_GATE + 2 * MiB, T1K, T1K, 128, 4, 16); S.j1 = S.j0; EpiGate E{(const _Float16*)(ws + A_STREAM2), nullptr, P.out, (const bf16_t*)(ws + A_PP1), I.ple_gate_b + D, nullptr, (const f32x2*)(ws + X_STAT) + (size_t)3 * M, I.ln_g + 3 * D, I.ln_b + 3 * D}; gemm_phase(lds, S, E); )
#if defined(DBG_SCAN)
    xcd_barrier(bar);
    { const float e0 = ((const float*)(ws + X_CTL))[300], e1 = ((const float*)(ws + X_CTL))[301]; float e = sqrtf(e0 / fmaxf(e1, 1e-30f)); if (!(e < 1e3f)) e = 1e3f; const float sc = 1.f + 10.f * e;
      for (size_t i = (size_t)blockIdx.x * 512 + threadIdx.x; i < (size_t)M * D; i += (size_t)gridDim.x * 512) P.out[i] *= sc; }
#endif
#undef IN
#undef SEAM
}

static int g_grid = 0;
static bool fast_setup(size_t ws_size) {
    if (g_grid) return g_grid > 0;
    int dev = 0, cus = 0, per_cu = 0;
    if (ws_size < WS_NEED) { fprintf(stderr, "kernel_launch: workspace too small: %zu < %zu\n", ws_size, (size_t)WS_NEED); g_grid = -1; return false; }
    (void)hipGetDevice(&dev); (void)hipDeviceGetAttribute(&cus, hipDeviceAttributeMultiprocessorCount, dev);
    if (hipFuncSetAttribute((const void*)mega, hipFuncAttributeMaxDynamicSharedMemorySize, LDS_BYTES) != hipSuccess) { fprintf(stderr, "hipFuncSetAttribute failed\n"); g_grid = -1; return false; }
    if (hipOccupancyMaxActiveBlocksPerMultiprocessor(&per_cu, (const void*)mega, 512, LDS_BYTES) != hipSuccess || per_cu < 1) { fprintf(stderr, "occupancy query failed (%d)\n", per_cu); g_grid = -1; return false; }
    g_grid = cus * 1;
    fprintf(stderr, "fast_setup: cus %d per_cu %d grid %d ws %zu need %zu\n", cus, per_cu, g_grid, ws_size, (size_t)WS_NEED);
    return true;
}
static void fast_launch(void* const* d_in, void* d_out, void* d_ws, hipStream_t stream, int lo, int hi, int li = 0) {
    Params p{}; const float** f = (const float**)&p.in; for (int i = 0; i < 36; ++i) f[i] = (const float*)d_in[i];
    p.out = (float*)d_out; p.ws = (unsigned char*)d_ws; p.ph_lo = lo; p.ph_hi = hi; p.li = li; p.pad = 0;
    void* args[] = {&p};
    hipError_t e = hipLaunchCooperativeKernel((const void*)mega, dim3(g_grid), dim3(512), args, LDS_BYTES, stream);
    if (e != hipSuccess) fprintf(stderr, "cooperative launch failed: %s (grid %d)\n", hipGetErrorString(e), g_grid);
}
}
extern "C" void kernel_launch(void* const* d_in, const int* in_sizes, int n_in, void* d_out, int out_size, void* d_ws, size_t ws_size, hipStream_t stream) {
    if (!fx::fast_setup(ws_size)) return;
    (void)hipMemsetAsync((char*)d_ws + fx::X_CTL, 0, 65536, stream);
#if defined(PER_PHASE)
    for (int ph = 0; ph < fx::NPHASE; ++ph) fx::fast_launch(d_in, d_out, d_ws, stream, ph, ph + 1);
#else
    fx::fast_launch(d_in, d_out, d_ws, stream, 0, fx::NPHASE);
#endif
}
```

```cpp
#include <hip/hip_runtime.h>
#include <hip/hip_cooperative_groups.h>
#include <cstdio>
#include <cstdint>
namespace fx {
#define LAS __attribute__((address_space(3)))
typedef unsigned short bf16_t;
typedef short bf16x8 __attribute__((ext_vector_type(8)));
typedef short bf16x4 __attribute__((ext_vector_type(4)));
typedef float f32x4 __attribute__((ext_vector_type(4)));
typedef float f32x2 __attribute__((ext_vector_type(2)));
typedef float f32x16 __attribute__((ext_vector_type(16)));
typedef unsigned u32x4 __attribute__((ext_vector_type(4)));
typedef unsigned u32x2 __attribute__((ext_vector_type(2)));
typedef _Float16 h16x4 __attribute__((ext_vector_type(4)));
__device__ __forceinline__ f32x4 ldh4(const _Float16* p) { const h16x4 h = *(const h16x4*)p; return __builtin_convertvector(h, f32x4); }
__device__ __forceinline__ void sth4(_Float16* p, const f32x4 v) { *(h16x4*)p = __builtin_convertvector(v, h16x4); }
#ifdef WT_STORES
__device__ __forceinline__ void gst16(void* p, const u32x4 v) { asm volatile("global_store_dwordx4 %0, %1, off sc1\n\ts_nop 1" :: "v"(p), "v"(v) : "memory"); }
#ifdef WT8
__device__ __forceinline__ void gst8(void* p, const u32x2 v) { asm volatile("global_store_dwordx2 %0, %1, off sc1\n\ts_nop 1" :: "v"(p), "v"(v) : "memory"); }
#else
__device__ __forceinline__ void gst8(void* p, const u32x2 v) { *(u32x2*)p = v; }
#endif
#else
#ifdef NT_STORES
__device__ __forceinline__ void gst16(void* p, const u32x4 v) { __builtin_nontemporal_store(v, (u32x4*)p); }
__device__ __forceinline__ void gst8(void* p, const u32x2 v) { __builtin_nontemporal_store(v, (u32x2*)p); }
#else
__device__ __forceinline__ void gst16(void* p, const u32x4 v) { *(u32x4*)p = v; }
__device__ __forceinline__ void gst8(void* p, const u32x2 v) { *(u32x2*)p = v; }
#endif
#endif
__device__ __forceinline__ void gst16f(void* p, const f32x4 v) { u32x4 u; u.x = __float_as_uint(v[0]); u.y = __float_as_uint(v[1]); u.z = __float_as_uint(v[2]); u.w = __float_as_uint(v[3]); gst16(p, u); }
__device__ __forceinline__ void gsth4(_Float16* p, const f32x4 v) { const h16x4 h = __builtin_convertvector(v, h16x4); u32x2 u; __builtin_memcpy(&u, &h, 8); gst8(p, u); }

constexpr int D = 1024, NB = 16, T = 2048, M = NB * T, PLE = 256;
constexpr int DFF = 2816, DFE = 1408, NE = 8;
constexpr int XBT = T + 1;
constexpr int MOE_ROWS_MAX = 264 * 256;
constexpr float ALPHA = 1.4142135623730951f, LN_EPS = 1e-5f, GN_EPS = 64e-5f;
constexpr float LOG2E = 1.4426950408889634f;

constexpr size_t MiB = 1u << 20;
constexpr size_t W_RKV = 0;
constexpr size_t W_L1 = W_RKV + 3 * 2 * MiB;
constexpr size_t W_L2 = W_L1 + 1 * MiB;
constexpr size_t W_AO = W_L2 + 3 * MiB / 2;
constexpr size_t W_FGU = W_AO + 2 * MiB;
constexpr size_t W_FDN = W_FGU + 11 * MiB;
constexpr size_t W_PLE = W_FDN + 11 * MiB / 2;
constexpr size_t W_GATE = W_PLE + 1 * MiB;
constexpr size_t W_NSA = W_GATE + 4 * MiB;
constexpr size_t W_VT = W_NSA + 9 * MiB / 2;
constexpr size_t W_PHI = W_VT + 1 * MiB;
constexpr size_t W_BO = W_PHI + 2 * MiB;
constexpr size_t W_MGU = W_BO + 2 * MiB;
constexpr size_t W_MDN = W_MGU + 44 * MiB;
constexpr size_t W_END = 108 * MiB;
static_assert(W_MDN + 22 * MiB <= W_END, "weights");
constexpr size_t X_CTL = W_END;
constexpr size_t X_BAR = X_CTL + 16 * 1024;
constexpr size_t X_CS = X_CTL + 64 * 1024;
constexpr size_t X_CB = X_CS + 512 * 1024;
constexpr size_t X_TOKE = X_CB + 4096;
constexpr size_t X_TOKW = X_TOKE + (size_t)M * 4;
constexpr size_t X_RSRC = X_TOKW + (size_t)M * 8;
constexpr size_t X_RDST = X_RSRC + (size_t)MOE_ROWS_MAX * 4;
constexpr size_t X_RW = X_RDST + (size_t)MOE_ROWS_MAX * 4;
constexpr size_t X_STAT = X_RW + (size_t)MOE_ROWS_MAX * 4;
constexpr size_t X_END = X_STAT + (size_t)4 * M * 8;
static_assert(X_END <= W_END + 12 * MiB, "misc");
constexpr size_t ACT = W_END + 12 * MiB;
constexpr size_t A_MIX = ACT + 0 * MiB;
constexpr size_t O_XB = 0, O_HL = 66 * MiB;
constexpr size_t A_RKV = ACT + 192 * MiB;
constexpr size_t A_WAG = ACT + 0 * MiB;
constexpr size_t A_X1B = ACT + 0 * MiB, A_H = ACT + 64 * MiB, A_X2B = ACT + 0 * MiB, A_PB0 = ACT + 240 * MiB, A_PP0 = ACT + 64 * MiB, A_X3B = ACT + 128 * MiB;
constexpr size_t A_KC = ACT + 0 * MiB, A_VC = ACT + 17 * MiB, A_KS = ACT + 34 * MiB, A_KW = ACT + 50 * MiB, A_VTS = ACT + 66 * MiB  , A_GATES = ACT + 98 * MiB;
constexpr size_t A_HCP = ACT + 320 * MiB;
constexpr size_t A_HCK = ACT + 106 * MiB, A_HCV = ACT + 110 * MiB, A_KCMP = ACT + 114 * MiB, A_VCMPT = ACT + 115 * MiB;
constexpr size_t A_Q = ACT + 192 * MiB, A_QR = ACT + 256 * MiB, A_ATT = ACT + 320 * MiB;
constexpr size_t A_X4B = ACT + 320 * MiB, A_XS = ACT + 0 * MiB, A_HM = ACT + 132 * MiB, A_YS2 = ACT + 0 * MiB, A_X5B = ACT + 132 * MiB  , A_PB1 = W_RKV  , A_PP1 = ACT + 320 * MiB;
constexpr size_t A_STREAM2 = ACT + 256 * MiB;
constexpr size_t WS_NEED = ACT + 385 * MiB;
constexpr int CW_CNT = 0;
constexpr int CW_CUR = 16;
constexpr int CW_DBG = 64;

__device__ __forceinline__ unsigned cvt_pk_bf16(float lo, float hi) { unsigned r; asm volatile("v_cvt_pk_bf16_f32 %0, %1, %2" : "=v"(r) : "v"(lo), "v"(hi)); return r; }
__device__ __forceinline__ float bf2f(unsigned short b) { return __uint_as_float(((unsigned)b) << 16); }
__device__ __forceinline__ float bflo(unsigned w) { return __uint_as_float(w << 16); }
__device__ __forceinline__ float bfhi(unsigned w) { return __uint_as_float(w & 0xffff0000u); }
__device__ __forceinline__ float sigmoid_f(float x) { return 1.f / (1.f + __expf(-x)); }

__device__ __forceinline__ float dpp_xor1(float v) { return __builtin_bit_cast(float, __builtin_amdgcn_update_dpp(0, __builtin_bit_cast(int, v), 0xB1, 0xF, 0xF, true)); }
__device__ __forceinline__ float dpp_xor2(float v) { return __builtin_bit_cast(float, __builtin_amdgcn_update_dpp(0, __builtin_bit_cast(int, v), 0x4E, 0xF, 0xF, true)); }
__device__ __forceinline__ float dpp_hmir(float v) { return __builtin_bit_cast(float, __builtin_amdgcn_update_dpp(0, __builtin_bit_cast(int, v), 0x141, 0xF, 0xF, true)); }
__device__ __forceinline__ float max8(float v) { v = fmaxf(v, dpp_xor1(v)); v = fmaxf(v, dpp_xor2(v)); v = fmaxf(v, dpp_hmir(v)); return v; }
__device__ __forceinline__ int imin8(int v) { int t = __builtin_amdgcn_update_dpp(0, v, 0xB1, 0xF, 0xF, true); v = t < v ? t : v; t = __builtin_amdgcn_update_dpp(0, v, 0x4E, 0xF, 0xF, true); v = t < v ? t : v; t = __builtin_amdgcn_update_dpp(0, v, 0x141, 0xF, 0xF, true); v = t < v ? t : v; return v; }
__device__ __forceinline__ float dpp_ror8(float v) { return __builtin_bit_cast(float, __builtin_amdgcn_update_dpp(0, __builtin_bit_cast(int, v), 0x128, 0xF, 0xF, true)); }
__device__ __forceinline__ float sum16(float v) { v += dpp_xor1(v); v += dpp_xor2(v); v += dpp_hmir(v); v += dpp_ror8(v); return v; }
__device__ __forceinline__ float wave_sum(float v) { v = sum16(v); const int b = __builtin_bit_cast(int, v);
    return (__builtin_bit_cast(float, __builtin_amdgcn_readlane(b, 0)) + __builtin_bit_cast(float, __builtin_amdgcn_readlane(b, 16))) + (__builtin_bit_cast(float, __builtin_amdgcn_readlane(b, 32)) + __builtin_bit_cast(float, __builtin_amdgcn_readlane(b, 48))); }
__device__ __forceinline__ float xhalf(float v) { return __shfl_xor(v, 32); }
__device__ __forceinline__ float max_xhalf(float v) { return fmaxf(v, __shfl_xor(v, 32)); }
__device__ __forceinline__ float sum_xhalf(float v) { return v + __shfl_xor(v, 32); }
__device__ __forceinline__ float sum8(float v) { v += dpp_xor1(v); v += dpp_xor2(v); v += dpp_hmir(v); return v; }

constexpr int BM = 256, BK = 64, HALF = 128, HTB = HALF * BK * 2, STAGE_BYTES = 8 * HTB, NXCD = 8, WGM = 4;
__host__ __device__ __forceinline__ int lds_byte(int r, int c) { const int st = (r >> 4) * 2 + (c >> 5), rr = r & 15, cc = c & 31, ob = rr * 64 + cc * 2; return st * 1024 + (ob ^ (((ob >> 9) & 1) << 5)); }
__host__ __device__ __forceinline__ void stage_rc(int b, int& R, int& C) { const int st = b / 1024, sb = b % 1024, swz = sb ^ (((sb >> 9) & 1) << 5); R = (st >> 1) * 16 + swz / 64; C = (st & 1) * 32 + (swz % 64) / 2; }
__host__ __device__ __forceinline__ int perm32(int rho) { const int n = rho >> 4, i = rho & 15; return 8 * (i >> 2) + 4 * n + (i & 3); }

struct Unit {
    const char* A;
    const char* B;
    int nt;
    int ksplit;
    long wrapA, wrapB;
    int pm, pn, job;
};
__device__ __forceinline__ const char* ktA(const Unit& u, int t) { return u.A + (long)t * (BK * 2) + (t >= u.ksplit ? u.wrapA : 0L); }
__device__ __forceinline__ const char* ktB(const Unit& u, int t) { return u.B + (long)t * (BK * 2) + (t >= u.ksplit ? u.wrapB : 0L); }

struct JobD { const char* A; const char* B; long tileA, tileB; int nM, nN, nt, ksplit; long wrapA, wrapB, batchA, batchB, tileBm; int shA, shB; };
struct StaticSched {
    JobD j0, j1; int nj; int G, c; int lda, ldb;
    __device__ __forceinline__ bool next(int i, Unit& u) const {
        long L = (long)i * G + c; const long n0 = (long)j0.nM * j0.nN; const bool second = (nj > 1) && (L >= n0);
        if (second) L -= n0;
        const int nM = second ? j1.nM : j0.nM, nN = second ? j1.nN : j0.nN;
        const int nwg = nM * nN; if (L >= nwg) return false;
        int wgid = (int)L; { const int qq = nwg / NXCD, r = nwg % NXCD, xcd = wgid % NXCD, off = wgid / NXCD; wgid = (xcd < r ? xcd * (qq + 1) : r * (qq + 1) + (xcd - r) * qq) + off; }
        const int nig = WGM * nN, gid = wgid / nig, fm = gid * WGM, gsz = (nM - fm) < WGM ? (nM - fm) : WGM;
        u.pm = fm + ((wgid % nig) % gsz); u.pn = (wgid % nig) / gsz; u.job = second ? 1 : 0;
        if (second) { u.A = j1.A + (long)u.pm * j1.tileA + (long)(u.pm >> j1.shA) * j1.batchA; u.B = j1.B + (long)u.pn * j1.tileB + (long)(u.pm >> j1.shB) * j1.batchB + (long)u.pm * j1.tileBm; u.nt = j1.nt; u.ksplit = j1.ksplit; u.wrapA = j1.wrapA; u.wrapB = j1.wrapB; }
        else { u.A = j0.A + (long)u.pm * j0.tileA + (long)(u.pm >> j0.shA) * j0.batchA; u.B = j0.B + (long)u.pn * j0.tileB + (long)(u.pm >> j0.shB) * j0.batchB + (long)u.pm * j0.tileBm; u.nt = j0.nt; u.ksplit = j0.ksplit; u.wrapA = j0.wrapA; u.wrapB = j0.wrapB; }
        return true;
    }
};

template <class S> struct sched_gather { static constexpr bool v = false; };
#ifdef GEMM_PROBE_PH
#ifndef GEMM_PROBE_MUL
#define GEMM_PROBE_MUL 2
#endif
#define GP_T0(mode, cond) do { if (GEMM_PROBE_MODE == (mode) && (cond)) gp_t0 = __builtin_amdgcn_s_memrealtime(); } while (0)
#define GP_T1(mode, cond) do { if (GEMM_PROBE_MODE == (mode) && (cond)) gp_acc += __builtin_amdgcn_s_memrealtime() - gp_t0; } while (0)
#else
#define GP_T0(mode, cond) do { } while (0)
#define GP_T1(mode, cond) do { } while (0)
#endif
template <class Epi, class Sched>
__device__ __forceinline__ void gemm_phase_impl(LAS unsigned char* lds, const Sched& S, const Epi& E, const int phk) {
    unsigned long long gp_acc = 0, gp_t0 = 0; (void)gp_acc; (void)gp_t0; (void)phk;
    const int tid = threadIdx.x, wid = __builtin_amdgcn_readfirstlane(tid >> 6), lane = tid & 63, wr = wid >> 2, wc = wid & 3, fr = lane & 15, fq = lane >> 4;
    unsigned voffA[2], voffB[2]; int gR[2]; unsigned gC2[2]; (void)gR; (void)gC2;
    constexpr bool GATHER = sched_gather<Sched>::v; constexpr int GIDX = 131072;
    unsigned gA[2][2], gN[2][2], gX[2][2];
#pragma unroll
    for (int i = 0; i < 2; ++i) { int R, C; stage_rc(tid * 16 + i * 8192, R, C); const int Rb = Epi::PERM ? ((R & ~31) + perm32(R & 31)) : R;
        voffA[i] = (unsigned)(R * S.lda + C * 2); voffB[i] = (unsigned)(Rb * S.ldb + C * 2); gR[i] = R; gC2[i] = (unsigned)(C * 2); }
    const size_t hstepA = (size_t)HALF * S.lda, hstepB = (size_t)HALF * S.ldb;
    const unsigned ldsw = (unsigned)wid * 1024u;
    const int aoff = lds_byte(wr * 64 + fr, fq * 8), boff = lds_byte(wc * 32 + fr, fq * 8);
#define PG8_SA(b, h) (((b) * 2 + (h)) * HTB)
#define PG8_SB(b, h) ((4 + (b) * 2 + (h)) * HTB)
#define PG8_STAGE(bufoff, gbase, voff) do { _Pragma("unroll") for (int _i = 0; _i < 2; ++_i) \
        __builtin_amdgcn_global_load_lds((const unsigned*)((const char*)(gbase) + (voff)[_i]), (LAS unsigned*)(lds + (bufoff) + ldsw + _i * 8192), 16, 0, 0); } while (0)
#define PG8_STAGE_A(bufoff, ptr, h, GG) do { if constexpr (GATHER) { PG8_STAGE(bufoff, ptr, GG[h]); } else { PG8_STAGE(bufoff, (ptr) + (h) * hstepA, voffA); } } while (0)
#define PG8_LDA(dst, b, h) do { _Pragma("unroll") for (int m = 0; m < 4; ++m) _Pragma("unroll") for (int k = 0; k < 2; ++k) dst[m][k] = *(const LAS bf16x8*)(lds + PG8_SA(b, h) + aoff + m * 2048 + k * 1024); } while (0)
#define PG8_LDB(dst, b, h) do { _Pragma("unroll") for (int n = 0; n < 2; ++n) _Pragma("unroll") for (int k = 0; k < 2; ++k) dst[n][k] = *(const LAS bf16x8*)(lds + PG8_SB(b, h) + boff + n * 2048 + k * 1024); } while (0)
#define PG8_MMA(ai, bj, At, Bt) do { __builtin_amdgcn_s_setprio(1); _Pragma("unroll") for (int m = 0; m < 4; ++m) _Pragma("unroll") for (int n = 0; n < 2; ++n) _Pragma("unroll") for (int k = 0; k < 2; ++k) \
        acc[ai][bj][m][n] = __builtin_amdgcn_mfma_f32_16x16x32_bf16(Bt[n][k], At[m][k], acc[ai][bj][m][n], 0, 0, 0); __builtin_amdgcn_s_setprio(0); } while (0)
#define PG8_WAIT_V(n) asm volatile("s_waitcnt vmcnt(" #n ")" ::: "memory")
#define PG8_WAIT_V8R(relax) do { if constexpr (Epi::NST == 8) { if (relax) asm volatile("s_waitcnt vmcnt(16)" ::: "memory"); else asm volatile("s_waitcnt vmcnt(8)" ::: "memory"); } else { asm volatile("s_waitcnt vmcnt(8)" ::: "memory"); } } while (0)
#define PG8_WAIT_L(n) asm volatile("s_waitcnt lgkmcnt(" #n ")" ::: "memory")
#define PG8_BAR __builtin_amdgcn_s_barrier()
#define PG8_SCHED __builtin_amdgcn_sched_barrier(0)
    Unit cur, nxt; int ui = 0;
    if (!S.next(0, cur)) return;
    f32x4 acc[2][2][4][2];
#pragma unroll
    for (int a = 0; a < 2; ++a)
#pragma unroll
        for (int b = 0; b < 2; ++b)
#pragma unroll
            for (int m = 0; m < 4; ++m)
#pragma unroll
                for (int n = 0; n < 2; ++n) acc[a][b][m][n] = (f32x4){0.f, 0.f, 0.f, 0.f};
    bf16x8 At[4][2], B0[2][2], B1[2][2];
#pragma unroll
    for (int h = 0; h < 2; ++h)
#pragma unroll
        for (int i = 0; i < 2; ++i) { gA[h][i] = 0u; gN[h][i] = 0u; gX[h][i] = 0u; }
    if constexpr (GATHER) {
#pragma unroll
        for (int h = 0; h < 2; ++h)
#pragma unroll
            for (int i = 0; i < 2; ++i) gA[h][i] = (unsigned)S.rs[cur.pm * 256 + h * 128 + gR[i]] * (unsigned)S.lda + gC2[i];
    }
    {
        const char* cA = ktA(cur, 0); const char* cB = ktB(cur, 0); const char* cA1 = ktA(cur, 1); const char* cB1 = ktB(cur, 1);
        PG8_STAGE(PG8_SB(0, 0), cB, voffB); PG8_STAGE(PG8_SB(0, 1), cB + hstepB, voffB); PG8_STAGE_A(PG8_SA(0, 0), cA, 0, gA); PG8_STAGE_A(PG8_SA(0, 1), cA, 1, gA);
        if (wr == 1) PG8_BAR;
        PG8_WAIT_V(2); PG8_BAR;
        PG8_STAGE(PG8_SB(1, 0), cB1, voffB); PG8_STAGE_A(PG8_SA(1, 0), cA1, 0, gA); PG8_STAGE(PG8_SB(1, 1), cB1 + hstepB, voffB);
        PG8_WAIT_V(6); PG8_BAR;
    }
    for (;;) {
        const bool has_next = S.next(ui + 1, nxt);
        if (!has_next) nxt = cur;
        if constexpr (GATHER) { if (has_next && wid == 0) __builtin_amdgcn_global_load_lds((const unsigned*)(S.rs + nxt.pm * 256 + lane * 4), (LAS unsigned*)(lds + GIDX + ((ui + 1) & 1) * 1024), 16, 0, 0); }
        const int nt = cur.nt;
        for (int t = 0; t < nt; t += 2) {
            GP_T0(2, t == 0); GP_T0(3, t == 4);
            const bool last = (t == nt - 2);
            const char* a1 = ktA(cur, t + 1);
            const char* a2 = last ? ktA(nxt, 0) : ktA(cur, t + 2); const char* b2 = last ? ktB(nxt, 0) : ktB(cur, t + 2);
            const char* a3 = last ? ktA(nxt, 1) : ktA(cur, t + 3); const char* b3 = last ? ktB(nxt, 1) : ktB(cur, t + 3);
            if constexpr (GATHER) {
                if (last) {
#pragma unroll
                    for (int h = 0; h < 2; ++h)
#pragma unroll
                        for (int i = 0; i < 2; ++i) gN[h][i] = has_next ? (unsigned)(*(const LAS int*)(lds + GIDX + ((ui + 1) & 1) * 1024 + (h * 128 + gR[i]) * 4)) * (unsigned)S.lda + gC2[i] : gA[h][i];
                }
#pragma unroll
                for (int h = 0; h < 2; ++h)
#pragma unroll
                    for (int i = 0; i < 2; ++i) gX[h][i] = last ? gN[h][i] : gA[h][i];
            }
            PG8_LDB(B0, 0, 0); PG8_LDB(B1, 0, 1); PG8_SCHED; PG8_LDA(At, 0, 0); PG8_STAGE_A(PG8_SA(1, 1), a1, 1, gA);
            PG8_WAIT_V(8); PG8_WAIT_L(0); PG8_BAR; PG8_MMA(0, 0, At, B0); PG8_MMA(0, 1, At, B1); PG8_BAR; PG8_SCHED;
            PG8_LDA(At, 0, 1); PG8_STAGE(PG8_SB(0, 0), b2, voffB); PG8_STAGE(PG8_SB(0, 1), b2 + hstepB, voffB); PG8_STAGE_A(PG8_SA(0, 0), a2, 0, gX);
            PG8_WAIT_V(8); PG8_WAIT_L(0); PG8_BAR; PG8_MMA(1, 0, At, B0); PG8_MMA(1, 1, At, B1); PG8_BAR; PG8_SCHED;
            PG8_LDB(B0, 1, 0); PG8_LDB(B1, 1, 1); PG8_SCHED; PG8_LDA(At, 1, 0); PG8_STAGE_A(PG8_SA(0, 1), a2, 1, gX);
            PG8_WAIT_V(8); PG8_WAIT_L(0); PG8_BAR; PG8_MMA(0, 0, At, B0); PG8_MMA(0, 1, At, B1); PG8_BAR; PG8_SCHED;
            PG8_LDA(At, 1, 1); PG8_STAGE(PG8_SB(1, 0), b3, voffB); PG8_STAGE(PG8_SB(1, 1), b3 + hstepB, voffB); PG8_STAGE_A(PG8_SA(1, 0), a3, 0, gX);
            PG8_WAIT_V(8); PG8_WAIT_L(0); PG8_BAR; PG8_MMA(1, 0, At, B0); PG8_MMA(1, 1, At, B1); PG8_BAR; PG8_SCHED;
            GP_T1(2, t == 0); GP_T1(3, t == 4);
        }
        GP_T0(1, true);
        if (wr == 0) PG8_BAR;
        E(acc, cur, wr, wc, fr, fq);
        if (!has_next) { GP_T1(1, true); break; }
#pragma unroll
        for (int a = 0; a < 2; ++a)
#pragma unroll
            for (int b = 0; b < 2; ++b)
#pragma unroll
                for (int m = 0; m < 4; ++m)
#pragma unroll
                    for (int n = 0; n < 2; ++n) acc[a][b][m][n] = (f32x4){0.f, 0.f, 0.f, 0.f};
        cur = nxt; ++ui;
        if constexpr (GATHER) {
#pragma unroll
            for (int h = 0; h < 2; ++h)
#pragma unroll
                for (int i = 0; i < 2; ++i) gA[h][i] = gN[h][i]; }
        if (wr == 1) PG8_BAR;
        GP_T1(1, true);
    }
    PG8_WAIT_V(0);
    PG8_BAR;
#ifdef GEMM_PROBE_PH
    if (phk == GEMM_PROBE_PH) { const unsigned long long ts = __builtin_amdgcn_s_memrealtime(); while (__builtin_amdgcn_s_memrealtime() - ts < gp_acc * GEMM_PROBE_MUL) __builtin_amdgcn_s_sleep(8); }
#endif
#undef PG8_SA
#undef PG8_SB
#undef PG8_STAGE
#undef PG8_LDA
#undef PG8_STAGE_A
#undef PG8_LDB
#undef PG8_MMA
#undef PG8_WAIT_V
#undef PG8_WAIT_V8R
#undef PG8_WAIT_L
#undef PG8_BAR
#undef PG8_SCHED
}
#define gemm_phase(l, s, e) gemm_phase_impl(l, s, e, PHK)
}
namespace fx {
typedef const f32x4 (&AccRef)[2][2][4][2];

__device__ __forceinline__ u32x4 pack8(const f32x4 v0, const f32x4 v1) { u32x4 w; w.x = cvt_pk_bf16(v0[0], v0[1]); w.y = cvt_pk_bf16(v0[2], v0[3]); w.z = cvt_pk_bf16(v1[0], v1[1]); w.w = cvt_pk_bf16(v1[2], v1[3]); return w; }
__device__ __forceinline__ f32x4 tanh4(f32x4 v) { f32x4 o;
#pragma unroll
    for (int i = 0; i < 4; ++i) { const float e = __expf(2.f * v[i]); o[i] = 1.f - 2.f * __builtin_amdgcn_rcpf(e + 1.f); } return o; }
__device__ __forceinline__ f32x4 sigm4(f32x4 v) { f32x4 o;
#pragma unroll
    for (int i = 0; i < 4; ++i) o[i] = __builtin_amdgcn_rcpf(1.f + __expf(-v[i])); return o; }
__device__ __forceinline__ f32x4 gelu4(f32x4 v) { f32x4 o;
#pragma unroll
    for (int i = 0; i < 4; ++i) { const float x = v[i]; const float u = 0.7978845608028654f * (x + 0.044715f * x * x * x); const float e = __expf(2.f * u); const float th = 1.f - 2.f * __builtin_amdgcn_rcpf(e + 1.f); o[i] = 0.5f * x * (1.f + th); } return o; }

struct EpiP1 {
    static constexpr bool PERM = true; static constexpr int NST = 0;
    bf16_t* rkv; bf16_t* hl;
    __device__ __forceinline__ void operator()(AccRef acc, const Unit& u, int wr, int wc, int fr, int fq) const {
        const int row0 = u.pm * BM + wr * 64 + fr;
        bf16_t* base = u.job == 0 ? rkv : hl;
        const int ldc = u.job == 1 ? 256 : 1024;
        const int col0 = u.pn * BM + wc * 32 + 8 * fq;
#pragma unroll
        for (int ai = 0; ai < 2; ++ai)
#pragma unroll
            for (int m = 0; m < 4; ++m) { bf16_t* rowp = base + (size_t)(row0 + ai * HALF + m * 16) * ldc + col0;
#pragma unroll
                for (int bj = 0; bj < 2; ++bj) { f32x4 v0 = acc[ai][bj][m][0], v1 = acc[ai][bj][m][1];
                    if (u.job == 1) { if (bj == 1) { v0 = sigm4(v0); v1 = sigm4(v1); } else if (wc < 2) { v0 = tanh4(v0); v1 = tanh4(v1); } }
                    gst16(rowp + bj * HALF, pack8(v0, v1)); } }
    }
};
struct EpiP2 {
    static constexpr bool PERM = true; static constexpr int NST = 0;
    bf16_t* wag; const float* w0; const float* a0;
    __device__ __forceinline__ void operator()(AccRef acc, const Unit& u, int wr, int wc, int fr, int fq) const {
        const int row0 = u.pm * BM + wr * 64 + fr; const int kind = u.pn >> 2; const int colt = (u.pn & 3) * BM;
        bf16_t* base = wag + (size_t)kind * M * 1024; const float* bias = kind == 0 ? w0 : a0;
        const int col0 = colt + wc * 32 + 8 * fq;
        f32x4 bv[2][2];
#pragma unroll
        for (int bj = 0; bj < 2; ++bj)
#pragma unroll
            for (int n = 0; n < 2; ++n) bv[bj][n] = kind < 2 ? *(const f32x4*)(bias + col0 + bj * HALF + 4 * n) : (f32x4){0.f, 0.f, 0.f, 0.f};
#pragma unroll
        for (int ai = 0; ai < 2; ++ai)
#pragma unroll
            for (int m = 0; m < 4; ++m) { bf16_t* rowp = base + (size_t)(row0 + ai * HALF + m * 16) * 1024 + col0;
#pragma unroll
                for (int bj = 0; bj < 2; ++bj) { f32x4 v0 = acc[ai][bj][m][0] + bv[bj][0], v1 = acc[ai][bj][m][1] + bv[bj][1];
                    if (kind == 0) { v0 = sigm4(v0) * (-0.6065306597126334f); v1 = sigm4(v1) * (-0.6065306597126334f); } else if (kind == 1) { v0 = sigm4(v0); v1 = sigm4(v1); }
                    gst16(rowp + bj * HALF, pack8(v0, v1)); } }
    }
};
typedef _Float16 h16x8 __attribute__((ext_vector_type(8)));
struct EpiResid {
    static constexpr bool PERM = true; static constexpr int NST = 0; static constexpr int ID = 3;
    const float* resf; const _Float16* resh; _Float16* out; const f32x2* st; const float* lg; const float* lb; const bf16_t* resb;
    __device__ __forceinline__ void operator()(AccRef acc, const Unit& u, int wr, int wc, int fr, int fq) const {
        const int row0 = u.pm * BM + wr * 64 + fr, col0 = u.pn * BM + wc * 32 + 8 * fq;
        f32x4 gvv[2][2], bvv[2][2];
#pragma unroll
        for (int bj = 0; bj < 2; ++bj)
#pragma unroll
            for (int n = 0; n < 2; ++n) { if (st) { gvv[bj][n] = *(const f32x4*)(lg + col0 + bj * HALF + 4 * n); bvv[bj][n] = *(const f32x4*)(lb + col0 + bj * HALF + 4 * n); } else { gvv[bj][n] = bvv[bj][n] = (f32x4){0.f, 0.f, 0.f, 0.f}; } }
#pragma unroll
        for (int ai = 0; ai < 2; ++ai)
#pragma unroll
            for (int m = 0; m < 4; ++m) { const int row = row0 + ai * HALF + m * 16; const size_t off = (size_t)row * 1024 + col0;
                f32x2 sv = (f32x2){0.f, 1.f}; if (st) sv = st[row];
                f32x4 ra[2][2];
#pragma unroll
                for (int bj = 0; bj < 2; ++bj) { const size_t o2 = off + bj * HALF;
                    if (resf) { ra[bj][0] = *(const f32x4*)(resf + o2); ra[bj][1] = *(const f32x4*)(resf + o2 + 4); }
                    else if (resb) { const u32x4 w = *(const u32x4*)(resb + o2); ra[bj][0] = (f32x4){bflo(w.x), bfhi(w.x), bflo(w.y), bfhi(w.y)}; ra[bj][1] = (f32x4){bflo(w.z), bfhi(w.z), bflo(w.w), bfhi(w.w)}; }
                    else { const h16x8 hv = *(const h16x8*)(resh + o2); ra[bj][0] = (f32x4){(float)hv[0], (float)hv[1], (float)hv[2], (float)hv[3]}; ra[bj][1] = (f32x4){(float)hv[4], (float)hv[5], (float)hv[6], (float)hv[7]}; } }
                asm volatile("" ::: "memory");
#pragma unroll
                for (int bj = 0; bj < 2; ++bj) { const size_t o2 = off + bj * HALF; f32x4 r0 = ra[bj][0], r1 = ra[bj][1];
                    if (st) { r0 = (r0 - sv.x) * sv.y * gvv[bj][0] + bvv[bj][0]; r1 = (r1 - sv.x) * sv.y * gvv[bj][1] + bvv[bj][1]; }
                    const f32x4 y0 = r0 * ALPHA + acc[ai][bj][m][0], y1 = r1 * ALPHA + acc[ai][bj][m][1];
                    const h16x8 ho = (h16x8){(_Float16)y0[0], (_Float16)y0[1], (_Float16)y0[2], (_Float16)y0[3], (_Float16)y1[0], (_Float16)y1[1], (_Float16)y1[2], (_Float16)y1[3]};
                    *(h16x8*)(out + o2) = ho; } }
    }
};
struct EpiGlu {
    static constexpr bool PERM = true; static constexpr int NST = 8;
    bf16_t* h; int ldh;
    __device__ __forceinline__ void operator()(AccRef acc, const Unit& u, int wr, int wc, int fr, int fq) const {
        const int row0 = u.pm * BM + wr * 64 + fr, col0 = u.pn * HALF + wc * 32 + 8 * fq;
#pragma unroll
        for (int ai = 0; ai < 2; ++ai)
#pragma unroll
            for (int m = 0; m < 4; ++m) { f32x4 o[2];
#pragma unroll
                for (int n = 0; n < 2; ++n) { const f32x4 g = acc[ai][0][m][n], up = acc[ai][1][m][n];
#pragma unroll
                    for (int i = 0; i < 4; ++i) o[n][i] = g[i] * __builtin_amdgcn_rcpf(1.f + __expf(-g[i])) * up[i]; }
                gst16(h + (size_t)(row0 + ai * HALF + m * 16) * ldh + col0, pack8(o[0], o[1])); }
    }
};
struct EpiBf16 {
    static constexpr bool PERM = true; static constexpr int NST = 0;
    bf16_t* O0; bf16_t* O1; int ldc; const float* bias0; const float* bias1; int act;
    __device__ __forceinline__ void operator()(AccRef acc, const Unit& u, int wr, int wc, int fr, int fq) const {
        const int row0 = u.pm * BM + wr * 64 + fr, col0 = u.pn * BM + wc * 32 + 8 * fq;
        bf16_t* base = u.job == 0 ? O0 : O1; const float* bias = u.job == 0 ? bias0 : bias1;
        f32x4 bv[2][2];
#pragma unroll
        for (int bj = 0; bj < 2; ++bj)
#pragma unroll
            for (int n = 0; n < 2; ++n) bv[bj][n] = act ? *(const f32x4*)(bias + col0 + bj * HALF + 4 * n) : (f32x4){0.f, 0.f, 0.f, 0.f};
#pragma unroll
        for (int ai = 0; ai < 2; ++ai)
#pragma unroll
            for (int m = 0; m < 4; ++m) { bf16_t* rowp = base + (size_t)(row0 + ai * HALF + m * 16) * ldc + col0;
#pragma unroll
                for (int bj = 0; bj < 2; ++bj) { f32x4 v0 = acc[ai][bj][m][0] + bv[bj][0], v1 = acc[ai][bj][m][1] + bv[bj][1];
                    if (act) { v0 = gelu4(v0); v1 = gelu4(v1); }
                    gst16(rowp + bj * HALF, pack8(v0, v1)); } }
    }
};
struct EpiPart {
    static constexpr bool PERM = false; static constexpr int NST = 0;
    float* part;
    __device__ __forceinline__ void operator()(AccRef acc, const Unit& u, int wr, int wc, int fr, int fq) const {
        const int rt = u.pm >> 2, ks = u.pm & 3; const int row0 = rt * BM + wr * 64 + fr, col0 = wc * 32 + 4 * fq;
        float* base = part + ((size_t)(u.job * 4 + ks) * 8192) * 256;
#pragma unroll
        for (int ai = 0; ai < 2; ++ai)
#pragma unroll
            for (int m = 0; m < 4; ++m) { float* rowp = base + (size_t)(row0 + ai * HALF + m * 16) * 256 + col0;
#pragma unroll
                for (int bj = 0; bj < 2; ++bj)
#pragma unroll
                    for (int n = 0; n < 2; ++n) gst16f(rowp + bj * HALF + n * 16, acc[ai][bj][m][n]); }
    }
};
struct EpiGate {
    static constexpr bool PERM = true; static constexpr int NST = 0;
    const _Float16* xs; _Float16* xo; float* outf; const bf16_t* pp; const float* gb; bf16_t* xb; const f32x2* st; const float* lg; const float* lb;
    __device__ __forceinline__ void operator()(AccRef acc, const Unit& u, int wr, int wc, int fr, int fq) const {
        const int row0 = u.pm * BM + wr * 64 + fr, col0 = u.pn * BM + wc * 32 + 8 * fq;
        f32x4 bv[2][2], gvv[2][2], bvv[2][2];
#pragma unroll
        for (int bj = 0; bj < 2; ++bj)
#pragma unroll
            for (int n = 0; n < 2; ++n) { const int cc = col0 + bj * HALF + 4 * n; bv[bj][n] = *(const f32x4*)(gb + cc); gvv[bj][n] = *(const f32x4*)(lg + cc); bvv[bj][n] = *(const f32x4*)(lb + cc); }
#pragma unroll
        for (int ai = 0; ai < 2; ++ai)
#pragma unroll
            for (int m = 0; m < 4; ++m) { const int row = row0 + ai * HALF + m * 16; const size_t off = (size_t)row * 1024 + col0; const f32x2 sv = st[row];
                h16x8 xr[2]; u32x4 pr[2];
#pragma unroll
                for (int bj = 0; bj < 2; ++bj) { xr[bj] = *(const h16x8*)(xs + off + bj * HALF); pr[bj] = *(const u32x4*)(pp + off + bj * HALF); }
                asm volatile("" ::: "memory");
#pragma unroll
                for (int bj = 0; bj < 2; ++bj) { const size_t o2 = off + bj * HALF; const h16x8 hv = xr[bj]; const u32x4 pw = pr[bj];
                    const f32x4 x0 = ((f32x4){(float)hv[0], (float)hv[1], (float)hv[2], (float)hv[3]} - sv.x) * sv.y * gvv[bj][0] + bvv[bj][0];
                    const f32x4 x1 = ((f32x4){(float)hv[4], (float)hv[5], (float)hv[6], (float)hv[7]} - sv.x) * sv.y * gvv[bj][1] + bvv[bj][1];
                    const f32x4 p0 = (f32x4){bflo(pw.x), bfhi(pw.x), bflo(pw.y), bfhi(pw.y)}, p1 = (f32x4){bflo(pw.z), bfhi(pw.z), bflo(pw.w), bfhi(pw.w)};
                    const f32x4 r0 = x0 + p0 * sigm4(acc[ai][bj][m][0] + bv[bj][0]), r1 = x1 + p1 * sigm4(acc[ai][bj][m][1] + bv[bj][1]);
                    if (outf) { *(f32x4*)(outf + o2) = r0; *(f32x4*)(outf + o2 + 4) = r1; }
                    else if (xo) { *(h16x8*)(xo + o2) = (h16x8){(_Float16)r0[0], (_Float16)r0[1], (_Float16)r0[2], (_Float16)r0[3], (_Float16)r1[0], (_Float16)r1[1], (_Float16)r1[2], (_Float16)r1[3]}; }
                    if (xb) *(u32x4*)(xb + o2) = pack8(r0, r1); } }
    }
};
struct EpiGateOut {
    static constexpr bool PERM = true; static constexpr int NST = 0;
    const bf16_t* xn; float* outf; const bf16_t* pp; const float* gb;
    __device__ __forceinline__ void operator()(AccRef acc, const Unit& u, int wr, int wc, int fr, int fq) const {
        const int row0 = u.pm * BM + wr * 64 + fr, col0 = u.pn * BM + wc * 32 + 8 * fq;
        f32x4 bv[2][2];
#pragma unroll
        for (int bj = 0; bj < 2; ++bj)
#pragma unroll
            for (int n = 0; n < 2; ++n) bv[bj][n] = *(const f32x4*)(gb + col0 + bj * HALF + 4 * n);
#pragma unroll
        for (int ai = 0; ai < 2; ++ai)
#pragma unroll
            for (int m = 0; m < 4; ++m) { const size_t off = (size_t)(row0 + ai * HALF + m * 16) * 1024 + col0;
                u32x4 xr[2], pr[2];
#pragma unroll
                for (int bj = 0; bj < 2; ++bj) { xr[bj] = *(const u32x4*)(xn + off + bj * HALF); pr[bj] = *(const u32x4*)(pp + off + bj * HALF); }
                asm volatile("" ::: "memory");
#pragma unroll
                for (int bj = 0; bj < 2; ++bj) { const u32x4 xw = xr[bj], pw = pr[bj];
                    const f32x4 x0 = (f32x4){bflo(xw.x), bfhi(xw.x), bflo(xw.y), bfhi(xw.y)}, x1 = (f32x4){bflo(xw.z), bfhi(xw.z), bflo(xw.w), bfhi(xw.w)};
                    const f32x4 p0 = (f32x4){bflo(pw.x), bfhi(pw.x), bflo(pw.y), bfhi(pw.y)}, p1 = (f32x4){bflo(pw.z), bfhi(pw.z), bflo(pw.w), bfhi(pw.w)};
                    *(f32x4*)(outf + off + bj * HALF) = x0 + p0 * sigm4(acc[ai][bj][m][0] + bv[bj][0]);
                    *(f32x4*)(outf + off + bj * HALF + 4) = x1 + p1 * sigm4(acc[ai][bj][m][1] + bv[bj][1]); } }
    }
};
constexpr float QSCL = 0.125f * 1.4426950408889634f;
struct EpiNsa {
    static constexpr bool PERM = true; static constexpr int NST = 0;
    unsigned char* ws;
    __device__ __forceinline__ void operator()(AccRef acc, const Unit& u, int wr, int wc, int fr, int fq) const {
        const int row0 = u.pm * BM + wr * 64 + fr; const float* cs = (const float*)(ws + X_CS);
        bf16_t* vt = (bf16_t*)(ws + A_VTS); bf16_t* q = (bf16_t*)(ws + A_Q); bf16_t* qr = (bf16_t*)(ws + A_QR); float* gates = (float*)(ws + A_GATES);
        if (u.job == 1) {
            const int col0 = u.pn * BM + wc * 32 + 8 * fq;
#pragma unroll
            for (int ai = 0; ai < 2; ++ai)
#pragma unroll
                for (int m = 0; m < 4; ++m) { bf16_t* rowp = vt + (size_t)(row0 + ai * HALF + m * 16) * M + col0;
#pragma unroll
                    for (int bj = 0; bj < 2; ++bj) gst16(rowp + bj * HALF, pack8(acc[ai][bj][m][0], acc[ai][bj][m][1])); }
            return;
        }
        const int pn = u.pn;
        if (pn < 2) {
            bf16_t* base = (bf16_t*)(ws + (pn == 0 ? A_KC : A_VC));
#pragma unroll
            for (int ai = 0; ai < 2; ++ai)
#pragma unroll
                for (int m = 0; m < 4; ++m) { const int row = row0 + ai * HALF + m * 16; const int b = row >> 11, t = row & 2047;
#pragma unroll
                    for (int bj = 0; bj < 2; ++bj) { const int c = 128 * bj + 32 * wc + 8 * fq; const int g = c >> 6, d = c & 63;
                        gst16(base + ((size_t)(b * 4 + g) * T + t) * 64 + d, pack8(acc[ai][bj][m][0], acc[ai][bj][m][1])); } }
        } else if (pn < 8) {
#pragma unroll
            for (int ai = 0; ai < 2; ++ai)
#pragma unroll
                for (int m = 0; m < 4; ++m) { const int row = row0 + ai * HALF + m * 16; const int b = row >> 11, t = row & 2047; const int d0 = 4 * (4 * (wc & 1) + fq);
                    const f32x4 c0 = *(const f32x4*)(cs + ((size_t)t * 32 + d0) * 2), c1 = *(const f32x4*)(cs + ((size_t)t * 32 + d0) * 2 + 4);
                    const f32x4 co = (f32x4){c0[0], c0[2], c1[0], c1[2]}, si = (f32x4){c0[1], c0[3], c1[1], c1[3]};
#pragma unroll
                    for (int bj = 0; bj < 2; ++bj) { const int hh = 2 * bj + (wc >> 1);
                        f32x4 x1 = acc[ai][bj][m][0], x2 = acc[ai][bj][m][1]; if (pn >= 4) { x1 = x1 * QSCL; x2 = x2 * QSCL; }
                        const f32x4 r1 = x1 * co - x2 * si, r2 = x2 * co + x1 * si;
                        u32x2 w1, w2; w1.x = cvt_pk_bf16(r1[0], r1[1]); w1.y = cvt_pk_bf16(r1[2], r1[3]); w2.x = cvt_pk_bf16(r2[0], r2[1]); w2.y = cvt_pk_bf16(r2[2], r2[3]);
                        if (pn < 4) { bf16_t* kb = (bf16_t*)(ws + (pn == 2 ? A_KS : A_KW)) + ((size_t)(b * 4 + hh) * T + t) * 64; gst8(kb + d0, w1); gst8(kb + d0 + 32, w2); }
                        else { const size_t o = (size_t)row * 1024 + (size_t)((pn - 4) * 4 + hh) * 64;
                            gst8(qr + o + d0, w1); gst8(qr + o + d0 + 32, w2);
                            u32x2 u1, u2; u1.x = cvt_pk_bf16(x1[0], x1[1]); u1.y = cvt_pk_bf16(x1[2], x1[3]); u2.x = cvt_pk_bf16(x2[0], x2[1]); u2.y = cvt_pk_bf16(x2[2], x2[3]);
                            gst8(q + o + d0, u1); gst8(q + o + d0 + 32, u2); } } }
        } else {
            if (wc < 2) {
#pragma unroll
                for (int ai = 0; ai < 2; ++ai)
#pragma unroll
                    for (int m = 0; m < 4; ++m) { const int row = row0 + ai * HALF + m * 16; float* gp = gates + (size_t)row * 64 + 32 * wc + 8 * fq;
                        gst16f(gp, sigm4(acc[ai][0][m][0])); gst16f(gp + 4, sigm4(acc[ai][0][m][1])); }
            }
        }
    }
};
struct EpiMoeDown {
    static constexpr bool PERM = true; static constexpr int NST = 0;
    bf16_t* ys2; const int* row_dst; const float* row_w;
    __device__ __forceinline__ void operator()(AccRef acc, const Unit& u, int wr, int wc, int fr, int fq) const {
        const int row0 = u.pm * BM + wr * 64 + fr, col0 = u.pn * BM + wc * 32 + 8 * fq;
        int dst8[8]; float w8[8];
#pragma unroll
        for (int ai = 0; ai < 2; ++ai)
#pragma unroll
            for (int m = 0; m < 4; ++m) { const int row = row0 + ai * HALF + m * 16; dst8[ai * 4 + m] = row_dst[row]; w8[ai * 4 + m] = row_w[row]; }
#pragma unroll
        for (int ai = 0; ai < 2; ++ai)
#pragma unroll
            for (int m = 0; m < 4; ++m) { const int dst = dst8[ai * 4 + m]; const float w = w8[ai * 4 + m];
                if (dst >= 0) { bf16_t* rowp = ys2 + (size_t)dst * 1024 + col0;
#pragma unroll
                    for (int bj = 0; bj < 2; ++bj) gst16(rowp + bj * HALF, pack8(acc[ai][bj][m][0] * w, acc[ai][bj][m][1] * w)); } }
    }
};
}
namespace fx {
struct In {
    const float *x, *p, *a_mu, *a_w_rkv, *a_w0, *a_w1, *a_w2, *a_a0, *a_a1, *a_a2, *a_g1, *a_g2, *a_k_k, *a_k_a, *a_r_k, *a_gn_g, *a_gn_b, *a_w_o,
        *b_w_kv, *b_cmp_pos, *b_phi_w1, *b_phi_b1, *b_phi_w2, *b_w_in, *b_w_o, *f_w_gu, *f_w_down, *m_w_router, *m_b_router, *m_w_gu, *m_w_down,
        *ln_g, *ln_b, *ple_w, *ple_gate_w, *ple_gate_b;
};
struct Params { In in; float* out; unsigned char* ws; int ph_lo, ph_hi, li, pad; };

__device__ __forceinline__ int ropeperm(int rr) { const int hh = rr >> 6, u = rr & 63; return hh * 64 + 4 * (u >> 3) + (u & 3) + 32 * ((u >> 2) & 1); }

struct WSrc { const float* base; const float* mu; int ldw, klo, khi, muhi; };
__device__ __forceinline__ WSrc wsrc(const In& I, int ty, int sub, int n0, int K) {
    WSrc w; w.mu = nullptr; w.klo = 0; w.khi = K; w.muhi = 0; w.ldw = D; w.base = nullptr;
    switch (ty) {
    case 0: w.base = I.a_w_rkv + (size_t)sub * D * D; break;
    case 1: { const int c = n0 & 255; w.muhi = n0 >> 8; if (c < 64) { w.base = I.a_w1; w.ldw = 64; w.mu = I.a_mu + 3 * D; } else if (c < 128) { w.base = I.a_a1; w.ldw = 64; w.mu = I.a_mu + 4 * D; } else { w.base = I.a_g1; w.ldw = 128; w.mu = I.a_mu + 5 * D; } break; }
    case 2: { const int kind = n0 >> 10; if (kind == 0) { w.base = I.a_w2; w.klo = 0; w.khi = 64; } else if (kind == 1) { w.base = I.a_a2; w.klo = 64; w.khi = 128; } else { w.base = I.a_g2; w.klo = 128; w.khi = 256; } break; }
    case 3: w.base = I.a_w_o; break;
    case 4: w.base = I.f_w_gu; w.ldw = 2 * DFF; break;
    case 5: w.base = I.f_w_down; break;
    case 6: w.base = I.ple_w + (size_t)sub * PLE * D; break;
    case 7: w.base = I.ple_gate_w + (size_t)sub * D * D; break;
    case 8: w.base = I.b_w_kv; w.ldw = 1536; break;
    case 9: w.base = I.b_w_in; w.ldw = 1072; break;
    case 10: w.base = I.b_w_kv; w.ldw = 1536; break;
    case 11: w.base = I.b_phi_w1 + (size_t)sub * 2048 * 256; w.ldw = 256; break;
    case 12: w.base = I.b_w_o; break;
    case 13: w.base = I.m_w_gu + (size_t)sub * D * (2 * DFE); w.ldw = 2 * DFE; break;
    default: w.base = I.m_w_down + (size_t)sub * DFE * D; break;
    }
    return w;
}
__device__ __forceinline__ int wcol(int ty, int n) {
    switch (ty) {
    case 1: { const int c = n & 255; return c < 64 ? c : (c < 128 ? c - 64 : c - 128); }
    case 2: return n & 1023;
    case 4: { const int tile = n >> 8, rr = n & 255; return (rr >> 7) * DFF + tile * 128 + (rr & 127); }
    case 8: { const int tile = n >> 8, rr = n & 255; return tile == 0 ? rr : (tile == 1 ? 256 + rr : (tile == 2 ? 512 + ropeperm(rr) : 1024 + ropeperm(rr))); }
    case 9: { if (n < 1024) return (n & ~255) + ropeperm(n & 255); const int rr = n - 1024; return rr < 48 ? 1024 + rr : -1; }
    case 10: { const int ten = n >> 8, rr = n & 255; return (ten ? 5 : 3) * 256 + rr; }
    case 13: { const int tile = n >> 8, rr = n & 255; return (rr >> 7) * DFE + tile * 128 + (rr & 127); }
    default: return n;
    }
}
__device__ __forceinline__ void wprep_ld(const In& I, int ty, int sub, int K, int N, int item, int lane, float (&v)[16][4]) {
    const int nblk = N / 64, kb = item / nblk, nb = item % nblk, k0 = 64 * kb, n0 = 64 * nb;
    const WSrc w = wsrc(I, ty, sub, n0, K);
    int col[4];
#pragma unroll
    for (int e = 0; e < 4; ++e) col[e] = wcol(ty, n0 + 4 * (lane & 15) + e);
    const bool contig = (ty != 8 && ty != 9);
    if (contig) {
#pragma unroll
        for (int i = 0; i < 16; ++i) { const int k = k0 + 4 * i + (lane >> 4); const bool kin = k >= w.klo && k < w.khi; const float* rowp = w.base + (size_t)(k - w.klo) * w.ldw;
            const f32x4 x = kin ? *(const f32x4*)(rowp + col[0]) : (f32x4){0.f, 0.f, 0.f, 0.f}; v[i][0] = x[0]; v[i][1] = x[1]; v[i][2] = x[2]; v[i][3] = x[3]; }
    } else {
#pragma unroll
        for (int i = 0; i < 16; ++i) { const int k = k0 + 4 * i + (lane >> 4); const bool kin = k >= w.klo && k < w.khi; const float* rowp = w.base + (size_t)(k - w.klo) * w.ldw;
#pragma unroll
            for (int e = 0; e < 4; ++e) v[i][e] = (kin && col[e] >= 0) ? rowp[col[e]] : 0.f; }
    }
    if (w.mu) {
#pragma unroll
        for (int i = 0; i < 16; ++i) { const float m = w.mu[k0 + 4 * i + (lane >> 4)]; const float sc = w.muhi ? m : 1.f - m;
#pragma unroll
            for (int e = 0; e < 4; ++e) v[i][e] *= sc; }
    }
}
__device__ __forceinline__ void wprep_st(int K, int N, bf16_t* WT, LAS float* scr, int item, int lane, const float (&v)[16][4]) {
    const int nblk = N / 64, kb = item / nblk, nb = item % nblk, k0 = 64 * kb, n0 = 64 * nb;
#pragma unroll
    for (int i = 0; i < 16; ++i) { const int kk = 4 * i + (lane >> 4);
#pragma unroll
        for (int e = 0; e < 4; ++e) scr[kk * 65 + 4 * (lane & 15) + e] = v[i][e]; }
    asm volatile("s_waitcnt lgkmcnt(0)" ::: "memory");
    const int c = lane & 7;
#pragma unroll
    for (int j = 0; j < 8; ++j) { const int n = (lane >> 3) + 8 * j; const LAS float* s = scr + (8 * c) * 65 + n;
        u32x4 o; o.x = cvt_pk_bf16(s[0 * 65], s[1 * 65]); o.y = cvt_pk_bf16(s[2 * 65], s[3 * 65]); o.z = cvt_pk_bf16(s[4 * 65], s[5 * 65]); o.w = cvt_pk_bf16(s[6 * 65], s[7 * 65]);
        *(u32x4*)(WT + (size_t)(n0 + n) * K + k0 + 8 * c) = o; }
    asm volatile("s_waitcnt lgkmcnt(0)" ::: "memory");
}
__device__ __forceinline__ void wprep_item(const In& I, int ty, int sub, int K, int N, bf16_t* WT, LAS float* scr, int item, int lane) { float v[16][4]; wprep_ld(I, ty, sub, K, N, item, lane, v); wprep_st(K, N, WT, scr, item, lane, v); }
struct WJ { int ty, sub, K, N; size_t off; };
__device__ const WJ wjobs[34] = {
        {0, 0, 1024, 1024, W_RKV}, {0, 1, 1024, 1024, W_RKV + 2 * MiB}, {0, 2, 1024, 1024, W_RKV + 4 * MiB}, {1, 0, 1024, 512, W_L1},
        {2, 0, 256, 3072, W_L2}, {3, 0, 1024, 1024, W_AO}, {4, 0, 1024, 5632, W_FGU}, {5, 0, 2816, 1024, W_FDN}, {6, 0, 256, 1024, W_PLE}, {7, 0, 1024, 1024, W_GATE},
        {6, 1, 256, 1024, W_PLE + MiB / 2}, {7, 1, 1024, 1024, W_GATE + 2 * MiB},
        {8, 0, 1024, 1024, W_NSA}, {9, 0, 1024, 1280, W_NSA + 2 * MiB}, {10, 0, 1024, 512, W_VT}, {11, 0, 2048, 256, W_PHI}, {11, 1, 2048, 256, W_PHI + MiB}, {12, 0, 1024, 1024, W_BO},
        {13, 0, 1024, 2816, W_MGU}, {13, 1, 1024, 2816, W_MGU + 11 * MiB / 2}, {13, 2, 1024, 2816, W_MGU + 11 * MiB}, {13, 3, 1024, 2816, W_MGU + 33 * MiB / 2},
        {13, 4, 1024, 2816, W_MGU + 22 * MiB}, {13, 5, 1024, 2816, W_MGU + 55 * MiB / 2}, {13, 6, 1024, 2816, W_MGU + 33 * MiB}, {13, 7, 1024, 2816, W_MGU + 77 * MiB / 2},
        {14, 0, 1408, 1024, W_MDN}, {14, 1, 1408, 1024, W_MDN + 11 * MiB / 4}, {14, 2, 1408, 1024, W_MDN + 11 * MiB / 2}, {14, 3, 1408, 1024, W_MDN + 33 * MiB / 4},
        {14, 4, 1408, 1024, W_MDN + 11 * MiB}, {14, 5, 1408, 1024, W_MDN + 55 * MiB / 4}, {14, 6, 1408, 1024, W_MDN + 33 * MiB / 2}, {14, 7, 1408, 1024, W_MDN + 77 * MiB / 4}};
__device__ __forceinline__ void wfill(const Params& P, LAS unsigned char* lds, int jb_lo, int jb_hi, int skip, int count) {
    const In& I = P.in; unsigned char* ws = P.ws;
    int tid = threadIdx.x; asm volatile("" : "+v"(tid));
    const int lane = tid & 63, wave = __builtin_amdgcn_readfirstlane(tid >> 6); const int gw = blockIdx.x * 8 + wave, NGW = gridDim.x * 8;
    LAS float* scr = (LAS float*)(lds + wave * 16896);
    int start = 0, seen = 0;
#pragma unroll 1
    for (int jb = jb_lo; jb < jb_hi; ++jb) {
        const int ty = wjobs[jb].ty, sub = wjobs[jb].sub, K = wjobs[jb].K, N = wjobs[jb].N; const size_t off = wjobs[jb].off; const int nit = (K / 64) * (N / 64);
        int it = start + ((gw - start) % NGW + NGW) % NGW;
#pragma unroll 1
        for (; it < start + nit; it += NGW) { if (seen >= skip && seen - skip < count) wprep_item(I, ty, sub, K, N, (bf16_t*)(ws + off), scr, it - start, lane); ++seen; }
        start += nit;
    }
}

__device__ __forceinline__ void prep_phase(const Params& P, LAS unsigned char* lds) {
    const In& I = P.in; unsigned char* ws = P.ws;
    const int tid = threadIdx.x, lane = tid & 63, wave = tid >> 6; const int G = gridDim.x;
    const int gw = blockIdx.x * 8 + wave, NGW = G * 8; const int gt = blockIdx.x * 512 + tid, NGT = G * 512;
    LAS float* scr = (LAS float*)(lds + wave * 16896);
#ifdef PREP_AMP
    unsigned long long pa_acc = 0, pa_t0 = 0;
#define PA_T0() pa_t0 = __builtin_amdgcn_s_memrealtime()
#define PA_T1(sec) do { if (PREP_AMP == (sec)) pa_acc += __builtin_amdgcn_s_memrealtime() - pa_t0; } while (0)
#else
#define PA_T0() do { } while (0)
#define PA_T1(sec) do { } while (0)
#endif
    PA_T0();
    { float* cs = (float*)(ws + X_CS);
        for (int i = gt; i < T * 32; i += NGT) { const int t = i >> 5, j = i & 31; const float inv = powf(10000.f, -(float)j / 32.f); const float ang = (float)t * inv;
            const double a = (double)ang; const double n = rint(a * 0.15915494309189535); const float rf = (float)(a - n * 6.283185307179586476925); cs[2 * i] = cosf(rf); cs[2 * i + 1] = sinf(rf); } }
    { float* cb = (float*)(ws + X_CB);
        for (int o = gw; o < 512; o += NGW) { const int j = o >> 8, c = o & 255; float s = 0.f;
            float pv[32], wv[32];
#pragma unroll
            for (int i = 0; i < 32; ++i) { const int k = lane + 64 * i; pv[i] = I.b_cmp_pos[j * 2048 + k]; wv[i] = I.b_phi_w1[(size_t)j * 2048 * 256 + (size_t)k * 256 + c]; }
#pragma unroll
            for (int i = 0; i < 32; ++i) s += pv[i] * wv[i];
            s = wave_sum(s); if (lane == 0) cb[o] = s + I.b_phi_b1[o]; } }
    { int* rs = (int*)(ws + X_RSRC); int* rd = (int*)(ws + X_RDST); float* rw = (float*)(ws + X_RW);
        for (int i = gt; i < MOE_ROWS_MAX; i += NGT) { rs[i] = 0; rd[i] = -1; rw[i] = 0.f; } }
    PA_T1(3); PA_T0();
    {
        int start = 0;
#pragma unroll 1
        for (int jb = 0; jb < 34; ++jb) {
            const int ty = wjobs[jb].ty, sub = wjobs[jb].sub, K = wjobs[jb].K, N = wjobs[jb].N; const size_t off = wjobs[jb].off; const int nit = (K / 64) * (N / 64);
            int it = start + ((gw - start) % NGW + NGW) % NGW;
#pragma unroll 1
            for (; it < start + nit; it += NGW) wprep_item(I, ty, sub, K, N, (bf16_t*)(ws + off), scr, it - start, lane);
            start += nit;
        }
    }
    PA_T1(1); PA_T0();
    {
        bf16_t* mr = (bf16_t*)(ws + A_MIX); bf16_t* mk = mr + (size_t)M * D; bf16_t* mv = mk + (size_t)M * D; bf16_t* xb = (bf16_t*)((unsigned char*)P.out + O_XB);
        for (int rb = gw; rb < M / 16; rb += NGW) {
#pragma unroll 1
            for (int hf = 0; hf < 2; ++hf) {
                const int c0 = hf * 512 + lane * 8;
                f32x4 mur[2], muk[2], muv[2];
#pragma unroll
                for (int q = 0; q < 2; ++q) { mur[q] = *(const f32x4*)(I.a_mu + 0 * D + c0 + 4 * q); muk[q] = *(const f32x4*)(I.a_mu + 1 * D + c0 + 4 * q); muv[q] = *(const f32x4*)(I.a_mu + 2 * D + c0 + 4 * q); }
                const int row0 = rb * 16; f32x4 pv[2];
                if ((row0 & (T - 1)) == 0) { pv[0] = (f32x4){0.f, 0.f, 0.f, 0.f}; pv[1] = pv[0];
                    const int b = row0 >> 11; *(u32x4*)(xb + (size_t)(b * XBT) * D + c0) = (u32x4){0u, 0u, 0u, 0u}; }
                else { pv[0] = *(const f32x4*)(I.x + (size_t)(row0 - 1) * D + c0); pv[1] = *(const f32x4*)(I.x + (size_t)(row0 - 1) * D + c0 + 4); }
#pragma unroll 8
                for (int rr = 0; rr < 16; ++rr) { const int row = row0 + rr; const int b = row >> 11, t = row & (T - 1);
                    f32x4 xv[2]; xv[0] = *(const f32x4*)(I.x + (size_t)row * D + c0); xv[1] = *(const f32x4*)(I.x + (size_t)row * D + c0 + 4);
                    const f32x4 d0 = pv[0] - xv[0], d1 = pv[1] - xv[1];
                    *(u32x4*)(mr + (size_t)row * D + c0) = pack8(xv[0] + d0 * mur[0], xv[1] + d1 * mur[1]);
                    *(u32x4*)(mk + (size_t)row * D + c0) = pack8(xv[0] + d0 * muk[0], xv[1] + d1 * muk[1]);
                    *(u32x4*)(mv + (size_t)row * D + c0) = pack8(xv[0] + d0 * muv[0], xv[1] + d1 * muv[1]);
                    *(u32x4*)(xb + (size_t)(b * XBT + 1 + t) * D + c0) = pack8(xv[0], xv[1]);
                    pv[0] = xv[0]; pv[1] = xv[1]; }
            }
        }
    }
    PA_T1(2);
#ifdef PREP_AMP
    { const unsigned long long ts = __builtin_amdgcn_s_memrealtime(); while (__builtin_amdgcn_s_memrealtime() - ts < pa_acc * 4) __builtin_amdgcn_s_sleep(8); }
#endif
}

__device__ __forceinline__ void unpack8(const u32x4 w, float (&f)[8]) { f[0] = bflo(w.x); f[1] = bfhi(w.x); f[2] = bflo(w.y); f[3] = bfhi(w.y); f[4] = bflo(w.z); f[5] = bfhi(w.z); f[6] = bflo(w.w); f[7] = bfhi(w.w); }
constexpr int SC_L = 32;
constexpr int SC_ARR = SC_L * 64;
constexpr int SC_BUF = 7 * SC_ARR + 64;
#ifdef SCAN_AMP
#define SAMP_T0(sec) unsigned long long _s0_##sec = __builtin_amdgcn_s_memrealtime()
#define SAMP_T1(sec) do { if (SCAN_AMP == sec) samp_acc += __builtin_amdgcn_s_memrealtime() - _s0_##sec; } while (0)
#else
#define SAMP_T0(sec) do { } while (0)
#define SAMP_T1(sec) do { } while (0)
#endif
__device__ __forceinline__ void scan_phase(const Params& P, LAS unsigned char* lds, bf16_t* og) {
    const In& I = P.in; unsigned char* ws = P.ws; unsigned long long samp_acc = 0; (void)samp_acc;
    const bf16_t* gr = (const bf16_t*)(ws + A_RKV); const bf16_t* gk = gr + (size_t)M * D; const bf16_t* gv = gk + (size_t)M * D;
    const bf16_t* gwl = (const bf16_t*)(ws + A_WAG); const bf16_t* ga = gwl + (size_t)M * D; const bf16_t* gg = ga + (size_t)M * D;
    LAS float* L0 = (LAS float*)lds;
    const int tid = threadIdx.x; const bool helper = tid >= 256; const int ht = tid & 255, row = ht >> 3, jg = ht & 7;
    constexpr int NCH = T / SC_L;
    SAMP_T0(9);
    for (int item = blockIdx.x; item < NB * 16; item += gridDim.x) {
        const int b = item >> 4, h = item & 15; const int cb = h * 64 + jg * 8;
        const size_t base = (size_t)b * T * D + cb;
        if (helper) {
            float kkc[8], kac[8], rkc[8], gng[8], gnb[8];
#pragma unroll
            for (int i = 0; i < 8; ++i) { kkc[i] = I.a_k_k[cb + i]; kac[i] = I.a_k_a[cb + i]; rkc[i] = I.a_r_k[cb + i]; gng[i] = I.a_gn_g[cb + i]; gnb[i] = I.a_gn_b[cb + i]; }
            u32x4 pr, pk, pv, pw, pa, pg;
#define SC_LOAD(c) do { const size_t _o = base + (size_t)((c) * SC_L + row) * D; pr = *(const u32x4*)(gr + _o); pk = *(const u32x4*)(gk + _o); pv = *(const u32x4*)(gv + _o); pw = *(const u32x4*)(gwl + _o); pa = *(const u32x4*)(ga + _o); } while (0)
#define SC_PRE(c) do { LAS float* Lb = L0 + ((c) & 1) * SC_BUF; \
                float rf[8], kf[8], vf[8], wf[8], af[8]; unpack8(pr, rf); unpack8(pk, kf); unpack8(pv, vf); unpack8(pw, wf); unpack8(pa, af); \
                float kk[8], km[8], dd[8], bb[8]; float ss = 0.f, bon = 0.f; \
                _Pragma("unroll") for (int i = 0; i < 8; ++i) { kk[i] = kf[i] * kkc[i]; ss += kk[i] * kk[i]; km[i] = kf[i] * (1.f + (af[i] - 1.f) * kac[i]); dd[i] = __expf(wf[i]); bon += rf[i] * km[i] * rkc[i]; } \
                ss = sum8(ss); bon = sum8(bon); const float inv = 1.f / fmaxf(sqrtf(ss), 1e-12f); \
                _Pragma("unroll") for (int i = 0; i < 8; ++i) { kk[i] *= inv; bb[i] = kk[i] * af[i]; } \
                const int o = row * 64 + jg * 8; \
                *(LAS f32x4*)(Lb + 0 * SC_ARR + o) = (f32x4){rf[0], rf[1], rf[2], rf[3]}; *(LAS f32x4*)(Lb + 0 * SC_ARR + o + 4) = (f32x4){rf[4], rf[5], rf[6], rf[7]}; \
                *(LAS f32x4*)(Lb + 1 * SC_ARR + o) = (f32x4){km[0], km[1], km[2], km[3]}; *(LAS f32x4*)(Lb + 1 * SC_ARR + o + 4) = (f32x4){km[4], km[5], km[6], km[7]}; \
                *(LAS f32x4*)(Lb + 2 * SC_ARR + o) = (f32x4){dd[0], dd[1], dd[2], dd[3]}; *(LAS f32x4*)(Lb + 2 * SC_ARR + o + 4) = (f32x4){dd[4], dd[5], dd[6], dd[7]}; \
                *(LAS f32x4*)(Lb + 3 * SC_ARR + o) = (f32x4){kk[0], kk[1], kk[2], kk[3]}; *(LAS f32x4*)(Lb + 3 * SC_ARR + o + 4) = (f32x4){kk[4], kk[5], kk[6], kk[7]}; \
                *(LAS f32x4*)(Lb + 4 * SC_ARR + o) = (f32x4){bb[0], bb[1], bb[2], bb[3]}; *(LAS f32x4*)(Lb + 4 * SC_ARR + o + 4) = (f32x4){bb[4], bb[5], bb[6], bb[7]}; \
                *(LAS f32x4*)(Lb + 5 * SC_ARR + o) = (f32x4){vf[0], vf[1], vf[2], vf[3]}; *(LAS f32x4*)(Lb + 5 * SC_ARR + o + 4) = (f32x4){vf[4], vf[5], vf[6], vf[7]}; \
                if (jg == 0) Lb[7 * SC_ARR + row] = bon; } while (0)
#define SC_POST(c) do { const LAS float* Lb = L0 + ((c) & 1) * SC_BUF; const int o = row * 64 + jg * 8; \
                const f32x4 o0 = *(const LAS f32x4*)(Lb + 6 * SC_ARR + o), o1 = *(const LAS f32x4*)(Lb + 6 * SC_ARR + o + 4); \
                float ov[8] = {o0[0], o0[1], o0[2], o0[3], o1[0], o1[1], o1[2], o1[3]}; float sm = 0.f; \
                _Pragma("unroll") for (int i = 0; i < 8; ++i) sm += ov[i]; \
                const float mean = sum8(sm) * (1.f / 64.f); float q = 0.f; \
                _Pragma("unroll") for (int i = 0; i < 8; ++i) { ov[i] -= mean; q += ov[i] * ov[i]; } \
                const float rs = rsqrtf(sum8(q) * (1.f / 64.f) + GN_EPS); const float bon = Lb[7 * SC_ARR + row]; \
                const f32x4 v0 = *(const LAS f32x4*)(Lb + 5 * SC_ARR + o), v1 = *(const LAS f32x4*)(Lb + 5 * SC_ARR + o + 4); const float vv[8] = {v0[0], v0[1], v0[2], v0[3], v1[0], v1[1], v1[2], v1[3]}; \
                float gf[8]; unpack8(pg, gf); float y[8]; \
                _Pragma("unroll") for (int i = 0; i < 8; ++i) y[i] = (ov[i] * rs * gng[i] + gnb[i] + bon * vv[i]) * gf[i]; \
                u32x4 w; w.x = cvt_pk_bf16(y[0], y[1]); w.y = cvt_pk_bf16(y[2], y[3]); w.z = cvt_pk_bf16(y[4], y[5]); w.w = cvt_pk_bf16(y[6], y[7]); \
                *(u32x4*)(og + base + (size_t)((c) * SC_L + row) * D) = w; } while (0)
            SC_LOAD(0); SC_PRE(0); SC_LOAD(1);
            __syncthreads();
#pragma unroll 1
            for (int c = 0; c < NCH; ++c) {
                SAMP_T0(1);
                if (c >= 1) SC_POST(c - 1);
                pg = *(const u32x4*)(gg + base + (size_t)(c * SC_L + row) * D);
                if (c + 1 < NCH) SC_PRE(c + 1);
                if (c + 2 < NCH) SC_LOAD(c + 2);
                SAMP_T1(1);
                __syncthreads();
            }
            SC_POST(NCH - 1);
#undef SC_LOAD
#undef SC_PRE
#undef SC_POST
        } else {
            f32x2 SA[4], SB[4];
#pragma unroll
            for (int i = 0; i < 4; ++i) { SA[i] = (f32x2){0.f, 0.f}; SB[i] = (f32x2){0.f, 0.f}; }
            __syncthreads();
#pragma unroll 1
            for (int c = 0; c < NCH; ++c) {
                SAMP_T0(2);
                const LAS float* Lb = L0 + (c & 1) * SC_BUF; LAS float* Lo = L0 + (c & 1) * SC_BUF + 6 * SC_ARR;
                const LAS float* sR = Lb, *sKM = Lb + SC_ARR, *sDD = Lb + 2 * SC_ARR, *sKK = Lb + 3 * SC_ARR, *sBB = Lb + 4 * SC_ARR, *sVV = Lb + 5 * SC_ARR;
                const int ob = jg * 8;
                f32x4 k0 = *(const LAS f32x4*)(sKK + ob), k1 = *(const LAS f32x4*)(sKK + ob + 4), d0 = *(const LAS f32x4*)(sDD + ob), d1 = *(const LAS f32x4*)(sDD + ob + 4);
                f32x4 b0 = *(const LAS f32x4*)(sBB + ob), b1 = *(const LAS f32x4*)(sBB + ob + 4), m0 = *(const LAS f32x4*)(sKM + ob), m1 = *(const LAS f32x4*)(sKM + ob + 4);
                f32x4 r0 = *(const LAS f32x4*)(sR + ob), r1 = *(const LAS f32x4*)(sR + ob + 4); float va = sVV[row], vb = sVV[row + 32];
#pragma unroll 1
                for (int s8 = 0; s8 < SC_L / 8; ++s8) {
                    float keepa = 0.f, keepb = 0.f;
#pragma unroll
                    for (int u = 0; u < 8; ++u) {
                        const int sn = (s8 * 8 + u + 1) & (SC_L - 1); const int o = sn * 64 + ob;
                        const f32x4 nk0 = *(const LAS f32x4*)(sKK + o), nk1 = *(const LAS f32x4*)(sKK + o + 4), nd0 = *(const LAS f32x4*)(sDD + o), nd1 = *(const LAS f32x4*)(sDD + o + 4);
                        const f32x4 nb0 = *(const LAS f32x4*)(sBB + o), nb1 = *(const LAS f32x4*)(sBB + o + 4), nm0 = *(const LAS f32x4*)(sKM + o), nm1 = *(const LAS f32x4*)(sKM + o + 4);
                        const f32x4 nr0 = *(const LAS f32x4*)(sR + o), nr1 = *(const LAS f32x4*)(sR + o + 4); const float nva = sVV[sn * 64 + row], nvb = sVV[sn * 64 + row + 32];
                        const f32x2 kk0 = (f32x2){k0[0], k0[1]}, kk1 = (f32x2){k0[2], k0[3]}, kk2 = (f32x2){k1[0], k1[1]}, kk3 = (f32x2){k1[2], k1[3]};
                        const f32x2 pa = (SA[0] * kk0 + SA[2] * kk2) + (SA[1] * kk1 + SA[3] * kk3), pb = (SB[0] * kk0 + SB[2] * kk2) + (SB[1] * kk1 + SB[3] * kk3);
                        const float dota = sum8(pa.x + pa.y), dotb = sum8(pb.x + pb.y);
                        const f32x2 na = (f32x2){-dota, -dota}, nb = (f32x2){-dotb, -dotb}, wa = (f32x2){va, va}, wb = (f32x2){vb, vb};
                        const f32x2 dd0 = (f32x2){d0[0], d0[1]}, dd1 = (f32x2){d0[2], d0[3]}, dd2 = (f32x2){d1[0], d1[1]}, dd3 = (f32x2){d1[2], d1[3]};
                        const f32x2 bb0 = (f32x2){b0[0], b0[1]}, bb1 = (f32x2){b0[2], b0[3]}, bb2 = (f32x2){b1[0], b1[1]}, bb3 = (f32x2){b1[2], b1[3]};
                        const f32x2 mm0 = (f32x2){m0[0], m0[1]}, mm1 = (f32x2){m0[2], m0[3]}, mm2 = (f32x2){m1[0], m1[1]}, mm3 = (f32x2){m1[2], m1[3]};
                        SA[0] = SA[0] * dd0 + (na * bb0 + wa * mm0); SA[1] = SA[1] * dd1 + (na * bb1 + wa * mm1); SA[2] = SA[2] * dd2 + (na * bb2 + wa * mm2); SA[3] = SA[3] * dd3 + (na * bb3 + wa * mm3);
                        SB[0] = SB[0] * dd0 + (nb * bb0 + wb * mm0); SB[1] = SB[1] * dd1 + (nb * bb1 + wb * mm1); SB[2] = SB[2] * dd2 + (nb * bb2 + wb * mm2); SB[3] = SB[3] * dd3 + (nb * bb3 + wb * mm3);
                        const f32x2 rr0 = (f32x2){r0[0], r0[1]}, rr1 = (f32x2){r0[2], r0[3]}, rr2 = (f32x2){r1[0], r1[1]}, rr3 = (f32x2){r1[2], r1[3]};
                        const f32x2 qa = (SA[0] * rr0 + SA[2] * rr2) + (SA[1] * rr1 + SA[3] * rr3), qb = (SB[0] * rr0 + SB[2] * rr2) + (SB[1] * rr1 + SB[3] * rr3);
                        const float oa = sum8(qa.x + qa.y), obv = sum8(qb.x + qb.y);
                        keepa = (u == jg) ? oa : keepa; keepb = (u == jg) ? obv : keepb;
                        k0 = nk0; k1 = nk1; d0 = nd0; d1 = nd1; b0 = nb0; b1 = nb1; m0 = nm0; m1 = nm1; r0 = nr0; r1 = nr1; va = nva; vb = nvb;
                    }
                    Lo[(s8 * 8 + jg) * 64 + row] = keepa; Lo[(s8 * 8 + jg) * 64 + row + 32] = keepb;
                }
                SAMP_T1(2);
                __syncthreads();
            }
        }
        __syncthreads();
    }
    SAMP_T1(9);
#ifdef SCAN_AMP
    { const unsigned long long ts = __builtin_amdgcn_s_memrealtime(); while (__builtin_amdgcn_s_memrealtime() - ts < samp_acc) __builtin_amdgcn_s_sleep(8); }
#endif
}

__device__ __forceinline__ void ln_phase(const Params& P, LAS unsigned char* lds, int lni, bf16_t* xb, const bf16_t* ys2, bool router, const float* psrc, bf16_t* pdst, const _Float16* sin16, _Float16* sout16) {
#define LNC(j) (8 * lane + 512 * ((j) >> 1) + 4 * ((j) & 1))
    const In& I = P.in; unsigned char* ws = P.ws;
    const int tid = threadIdx.x, lane = tid & 63, wave = tid >> 6; const int gw = blockIdx.x * 8 + wave, NGW = gridDim.x * 8;
    LAS float* wrT = (LAS float*)lds;
    LAS unsigned* hist = (LAS unsigned*)(lds + 32768);
    if (router) { for (int i = tid; i < 8192; i += 512) { const int k = i >> 3, e = i & 7; const int ph = 4 * ((k & 511) >> 3) + 256 * (2 * (k >> 9) + ((k & 7) >> 2)) + (k & 3); wrT[e * 1024 + ph] = I.m_w_router[i]; } if (tid < 8) hist[tid] = 0u; __syncthreads(); }
    f32x4 gv[4], bv[4]; f32x2* stats = (f32x2*)(ws + X_STAT) + (size_t)lni * M;
#pragma unroll
    for (int j = 0; j < 4; ++j) { gv[j] = *(const f32x4*)(I.ln_g + lni * D + LNC(j)); bv[j] = *(const f32x4*)(I.ln_b + lni * D + LNC(j)); }
    for (int rb = gw; rb < M / 16; rb += NGW) {
        h16x4 hn[4]; u32x2 yan[4], ybn[4];
        { const int row = rb * 16; const _Float16* xr = sin16 + (size_t)row * D;
#pragma unroll
            for (int j = 0; j < 4; ++j) { hn[j] = *(const h16x4*)(xr + LNC(j)); yan[j] = (u32x2){0u, 0u}; ybn[j] = (u32x2){0u, 0u}; }
            if (ys2) {
#pragma unroll
                for (int j = 0; j < 4; ++j) { yan[j] = *(const u32x2*)(ys2 + (size_t)(2 * row) * D + LNC(j)); ybn[j] = *(const u32x2*)(ys2 + (size_t)(2 * row + 1) * D + LNC(j)); } } }
#pragma unroll 1
        for (int rr = 0; rr < 16; ++rr) { const int row = rb * 16 + rr; _Float16* xw = sout16 + (size_t)row * D;
            f32x4 v[4]; float s = 0.f; u32x2 ya[4], yb[4];
#pragma unroll
            for (int j = 0; j < 4; ++j) { v[j] = __builtin_convertvector(hn[j], f32x4); ya[j] = yan[j]; yb[j] = ybn[j]; }
            if (rr + 1 < 16) {
                const _Float16* xr = sin16 + (size_t)(row + 1) * D;
#pragma unroll
                for (int j = 0; j < 4; ++j) hn[j] = *(const h16x4*)(xr + LNC(j));
                if (ys2) {
#pragma unroll
                    for (int j = 0; j < 4; ++j) { yan[j] = *(const u32x2*)(ys2 + (size_t)(2 * row + 2) * D + LNC(j)); ybn[j] = *(const u32x2*)(ys2 + (size_t)(2 * row + 3) * D + LNC(j)); } } }
            if (ys2) {
                const f32x2 ps = ((const f32x2*)(ws + X_STAT) + (size_t)(lni - 1) * M)[row];
#pragma unroll
                for (int j = 0; j < 4; ++j) { const u32x2 a = ya[j], b2 = yb[j];
                    const f32x4 x4 = (v[j] - ps.x) * ps.y * *(const f32x4*)(I.ln_g + (lni - 1) * D + LNC(j)) + *(const f32x4*)(I.ln_b + (lni - 1) * D + LNC(j));
                    v[j] = x4 * ALPHA + ((f32x4){bflo(a.x), bfhi(a.x), bflo(a.y), bfhi(a.y)} + (f32x4){bflo(b2.x), bfhi(b2.x), bflo(b2.y), bfhi(b2.y)}); if (sout16) { const h16x4 hv = __builtin_convertvector(v[j], h16x4); *(h16x4*)(xw + LNC(j)) = hv; v[j] = __builtin_convertvector(hv, f32x4); } }
            }
#pragma unroll
            for (int j = 0; j < 4; ++j) s += (v[j][0] + v[j][1]) + (v[j][2] + v[j][3]);
            const float mean = wave_sum(s) * (1.f / D); float q = 0.f;
#pragma unroll
            for (int j = 0; j < 4; ++j) { v[j] = v[j] - mean; q += (v[j][0] * v[j][0] + v[j][1] * v[j][1]) + (v[j][2] * v[j][2] + v[j][3] * v[j][3]); }
            const float rstd = rsqrtf(wave_sum(q) * (1.f / D) + LN_EPS);
            if (lane == 0) stats[row] = (f32x2){mean, rstd};
#pragma unroll
            for (int j = 0; j < 4; ++j) { v[j] = v[j] * rstd * gv[j] + bv[j];
                u32x2 w; w.x = cvt_pk_bf16(v[j][0], v[j][1]); w.y = cvt_pk_bf16(v[j][2], v[j][3]); *(u32x2*)(xb + (size_t)row * D + LNC(j)) = w; }
            if (router) {
                float lg[8];
#pragma unroll
                for (int e = 0; e < 8; ++e) { float a = 0.f;
#pragma unroll
                    for (int j = 0; j < 4; ++j) { const f32x4 w4 = *(const LAS f32x4*)(wrT + e * 1024 + 4 * lane + 256 * j); a += (v[j][0] * w4[0] + v[j][1] * w4[1]) + (v[j][2] * w4[2] + v[j][3] * w4[3]); }
                    lg[e] = wave_sum(a) + I.m_b_router[e]; }
                int e1 = 0; float v1 = lg[0];
#pragma unroll
                for (int e = 1; e < 8; ++e) if (lg[e] > v1) { v1 = lg[e]; e1 = e; }
                int e2 = -1; float v2 = 0.f;
#pragma unroll
                for (int e = 0; e < 8; ++e) if (e != e1 && (e2 < 0 || lg[e] > v2)) { v2 = lg[e]; e2 = e; }
                const float p2 = __expf(v2 - v1); const float w1 = 1.f / (1.f + p2), w2 = p2 / (1.f + p2);
                if (lane == 0) { ((unsigned*)(ws + X_TOKE))[row] = (unsigned)e1 | ((unsigned)e2 << 8); ((f32x2*)(ws + X_TOKW))[row] = (f32x2){w1, w2}; __hip_atomic_fetch_add(&hist[e1], 1u, __ATOMIC_RELAXED, __HIP_MEMORY_SCOPE_WORKGROUP); __hip_atomic_fetch_add(&hist[e2], 1u, __ATOMIC_RELAXED, __HIP_MEMORY_SCOPE_WORKGROUP); }
            }
        }
    }
    if (router) { __syncthreads(); if (tid < 8) atomicAdd((unsigned*)(ws + X_CTL) + CW_CNT + tid, hist[tid]); }
    if (psrc) { const int gt = blockIdx.x * 512 + tid, NGT = gridDim.x * 512;
        for (int i = gt; i < M * PLE / 8; i += NGT) { const f32x4 a = *(const f32x4*)(psrc + (size_t)i * 8), b2 = *(const f32x4*)(psrc + (size_t)i * 8 + 4); *(u32x4*)(pdst + (size_t)i * 8) = pack8(a, b2); } }
}
#undef LNC

__device__ __forceinline__ void moe_gather_phase(const Params& P, LAS unsigned char* lds) {
    unsigned char* ws = P.ws; const unsigned* cnt = (const unsigned*)(ws + X_CTL) + CW_CNT;
    const unsigned* toke = (const unsigned*)(ws + X_TOKE); const f32x2* tokw = (const f32x2*)(ws + X_TOKW);
    int* rs = (int*)(ws + X_RSRC); int* rd = (int*)(ws + X_RDST); float* rw = (float*)(ws + X_RW);
    const bf16_t* x4b = (const bf16_t*)(ws + A_X4B); bf16_t* xs = (bf16_t*)(ws + A_XS);
    const int tid = threadIdx.x, lane = tid & 63, wave = tid >> 6;
    LAS unsigned* pre = (LAS unsigned*)lds; LAS unsigned* lc = pre + 8;
    unsigned pstart[8]; { unsigned acc = 0;
#pragma unroll
        for (int e = 0; e < 8; ++e) { pstart[e] = acc; acc += (cnt[e] + 255u) / 256u * 256u; } }
    for (int ch = blockIdx.x; ch < M / 128; ch += gridDim.x) {
        if (tid < 8) pre[tid] = 0u;
        __syncthreads();
        {
            unsigned long long a8 = 0ull;
            const u32x4* tk4 = (const u32x4*)toke; const int n4 = ch * 32;
#pragma unroll 4
            for (int i = tid; i < n4; i += 512) { const u32x4 t4 = tk4[i];
                a8 += (1ull << (8 * (t4.x & 7u))) + (1ull << (8 * ((t4.x >> 8) & 7u))) + (1ull << (8 * (t4.y & 7u))) + (1ull << (8 * ((t4.y >> 8) & 7u)))
                    + (1ull << (8 * (t4.z & 7u))) + (1ull << (8 * ((t4.z >> 8) & 7u))) + (1ull << (8 * (t4.w & 7u))) + (1ull << (8 * ((t4.w >> 8) & 7u))); }
#pragma unroll
            for (int e = 0; e < 8; ++e) { const float c = wave_sum((float)((a8 >> (8 * e)) & 0xffull)); if (lane == 0) __hip_atomic_fetch_add(pre + e, (unsigned)c, __ATOMIC_RELAXED, __HIP_MEMORY_SCOPE_WORKGROUP); }
        }
        const int tb = ch * 8 + wave;
        const int tok = tb * 16 + ((lane & 31) >> 1), slot = lane & 1; int e = -1; float w = 0.f;
        if (lane < 32) { const unsigned te = toke[tok]; const f32x2 tw = tokw[tok]; e = slot ? (int)((te >> 8) & 0xff) : (int)(te & 0xff); w = slot ? tw.y : tw.x; }
        int rank = 0;
#pragma unroll
        for (int q = 0; q < 8; ++q) { const unsigned long long mk = __ballot(e == q); if (lane == 0) lc[wave * 8 + q] = (unsigned)__popcll(mk); if (e == q) rank = (int)__popcll(mk & ((1ull << lane) - 1ull)); }
        __syncthreads();
        int dest = 0;
        if (lane < 32) { unsigned base = pstart[0];
#pragma unroll
            for (int q = 1; q < 8; ++q) base = e == q ? pstart[q] : base;
            base += pre[e];
            for (int w2 = 0; w2 < wave; ++w2) base += lc[w2 * 8 + e];
            dest = (int)base + rank; rs[dest] = tok; rd[dest] = tok * 2 + slot; rw[dest] = w; }
#ifdef MOE_COPY_ROWS
#pragma unroll 4
        for (int q = 0; q < 32; ++q) { const int dq = __shfl(dest, q); const int tq = tb * 16 + (q >> 1);
            const u32x4* src = (const u32x4*)(x4b + (size_t)tq * D); u32x4* dst = (u32x4*)(xs + (size_t)dq * D); dst[lane] = src[lane]; dst[lane + 64] = src[lane + 64]; }
#endif
        __syncthreads();
    }
}
struct MoeSched {
    const char* A; const char* B; long tileA, tileB, strideE; int nN, nt; int G, c, lda, ldb; int pend[8]; int nblk;
    __device__ __forceinline__ void init(const unsigned* cnt) { int acc = 0;
#pragma unroll
        for (int e = 0; e < 8; ++e) { acc += (int)((cnt[e] + 255u) / 256u); pend[e] = acc; } nblk = acc; }
    __device__ __forceinline__ bool next(int i, Unit& u) const {
        const long L = (long)i * G + c; const int nwg = nblk * nN; if (L >= (long)nwg) return false;
#ifndef MOE_PLAIN_ORDER
        int wgid = (int)L; { const int qq = nwg / NXCD, r = nwg % NXCD, xcd = wgid % NXCD, off = wgid / NXCD; wgid = (xcd < r ? xcd * (qq + 1) : r * (qq + 1) + (xcd - r) * qq) + off; }
#ifndef MOE_WGM
#define MOE_WGM 8
#endif
        const int nig = MOE_WGM * nN, gid = wgid / nig, fm = gid * MOE_WGM, gsz = (nblk - fm) < MOE_WGM ? (nblk - fm) : MOE_WGM;
        const int rb = fm + ((wgid % nig) % gsz), pn = (wgid % nig) / gsz; int e = 0;
#else
        const int rb = (int)(L / nN), pn = (int)(L % nN); int e = 0;
#endif
#pragma unroll
        for (int q = 0; q < 7; ++q) e += (rb >= pend[q]) ? 1 : 0;
        u.pm = rb; u.pn = pn; u.job = e; u.A = A + (long)rb * tileA; u.B = B + (long)e * strideE + (long)pn * tileB; u.nt = nt; u.ksplit = 1 << 30; u.wrapA = 0; u.wrapB = 0; return true;
    }
};

struct MoeSchedG : MoeSched { const int* rs;
    __device__ __forceinline__ bool next(int i, Unit& u) const { const bool ok = MoeSched::next(i, u); if (ok) u.A = A; return ok; } };
template <> struct sched_gather<MoeSchedG> { static constexpr bool v = true; };
__device__ __forceinline__ void cmp2_phase(const Params& P, LAS unsigned char* lds) {
    const In& I = P.in; unsigned char* ws = P.ws; const int lane = threadIdx.x & 63, wave = threadIdx.x >> 6; const int gw = blockIdx.x * 8 + wave, NGW = gridDim.x * 8;
    bf16_t* kcmp = (bf16_t*)(ws + A_KCMP); bf16_t* vcT = (bf16_t*)(ws + A_VCMPT); const float* part = (const float*)(ws + A_HCP); const float* cb = (const float*)(ws + X_CB);
    LAS float* hb = (LAS float*)(lds + wave * 8192);
    for (int og = gw; og < 2048; og += NGW) { const int j = og >> 10, row0 = (og & 1023) * 8; const float* w2 = I.b_phi_w2 + (size_t)j * 256 * 64;
        const f32x4 cbv = *(const f32x4*)(cb + j * 256 + 4 * lane);
#pragma unroll
        for (int r = 0; r < 8; ++r) { f32x4 h = cbv;
#pragma unroll
            for (int ks = 0; ks < 4; ++ks) h += *(const f32x4*)(part + ((size_t)(j * 4 + ks) * 8192 + row0 + r) * 256 + 4 * lane);
            h = gelu4(h); *(LAS f32x4*)(hb + r * 256 + 4 * lane) = h; }
        asm volatile("s_waitcnt lgkmcnt(0)" ::: "memory");
        float acc[8];
#pragma unroll
        for (int r = 0; r < 8; ++r) acc[r] = 0.f;
#pragma unroll 4
        for (int c4 = 0; c4 < 64; ++c4) { const float w0 = w2[(4 * c4) * 64 + lane], w1 = w2[(4 * c4 + 1) * 64 + lane], w2v = w2[(4 * c4 + 2) * 64 + lane], w3 = w2[(4 * c4 + 3) * 64 + lane];
#pragma unroll
            for (int r = 0; r < 8; ++r) { const f32x4 hv = *(const LAS f32x4*)(hb + r * 256 + 4 * c4); acc[r] += hv[0] * w0 + hv[1] * w1 + hv[2] * w2v + hv[3] * w3; } }
        asm volatile("s_waitcnt lgkmcnt(0)" ::: "memory");
        if (j == 0) {
#pragma unroll
            for (int r = 0; r < 8; ++r) kcmp[(size_t)(row0 + r) * 64 + lane] = (unsigned short)(cvt_pk_bf16(acc[r], 0.f) & 0xffffu);
        } else { const int bg = row0 >> 7, n = row0 & 127; u32x4 o; o.x = cvt_pk_bf16(acc[0], acc[1]); o.y = cvt_pk_bf16(acc[2], acc[3]); o.z = cvt_pk_bf16(acc[4], acc[5]); o.w = cvt_pk_bf16(acc[6], acc[7]);
            *(u32x4*)(vcT + ((size_t)bg * 64 + lane) * 128 + n) = o; } }
}
}
namespace fx {
namespace cs {
constexpr int PT = 144, PW = 80;
constexpr int S_KT = 0, S_RT = 2304, S_WV = 4608, S_BKT = 9856, S_TT = 15104, S_MXT = 16384, S_PQT = 17664, S_GL = 18944, SET_BYTES = 19200, NS = 4;
#define CS_SKW(row) (((row) >> 4) * 32)
constexpr int LWP = 68, OBP = 68, NFP = 20, OB_BYTES = 16 * OBP * 4;
constexpr int L_SP = 0, L_OB = 4 * 3072, L_CV = L_OB + 3 * OB_BYTES, L_SETS = L_CV + 1280, L_HP = L_SETS + NS * SET_BYTES;
constexpr int HP_BT = 0, HP_KK = 2304, HP_LW = 4608, HP_NF = HP_LW + 16 * LWP * 4, HP_BON = HP_NF + 16 * NFP * 4, HP_BYTES = HP_BON + 128;
constexpr int L_SP_UNUSED = 0;
constexpr int SP_SB = 0, SP_RB = 2304, SP_BYTES = 3072;
constexpr int L_END = L_HP + 4 * HP_BYTES;
static_assert(L_END <= 147456 - 64, "chunked scan LDS");
typedef float f32x4v __attribute__((ext_vector_type(4)));
#define MFMA16(a, b, c) __builtin_amdgcn_mfma_f32_16x16x32_bf16((a), (b), (c), 0, 0, 0)
__device__ __forceinline__ unsigned short bf1(float x) { return __builtin_bit_cast(unsigned short, (__bf16)x); }
__device__ __forceinline__ void unpack16(const u32x4 a, const u32x4 b, float (&f)[16]) { f[0] = bflo(a.x); f[1] = bfhi(a.x); f[2] = bflo(a.y); f[3] = bfhi(a.y); f[4] = bflo(a.z); f[5] = bfhi(a.z); f[6] = bflo(a.w); f[7] = bfhi(a.w);
    f[8] = bflo(b.x); f[9] = bfhi(b.x); f[10] = bflo(b.y); f[11] = bfhi(b.y); f[12] = bflo(b.z); f[13] = bfhi(b.z); f[14] = bflo(b.w); f[15] = bfhi(b.w); }
}

#ifdef CS_AMP
#define CAMP_T0(sec) unsigned long long _c0_##sec = __builtin_amdgcn_s_memrealtime()
#define CAMP_T1(sec) do { if (CS_AMP == sec) camp_acc += __builtin_amdgcn_s_memrealtime() - _c0_##sec; } while (0)
#else
#define CAMP_T0(sec) do { } while (0)
#define CAMP_T1(sec) do { } while (0)
#endif
__device__ __forceinline__ void scan_chunked(const Params& P, LAS unsigned char* lds, bf16_t* og) {
    using namespace cs; unsigned long long camp_acc = 0; (void)camp_acc;
    const In& I = P.in; unsigned char* ws = P.ws;
    const bf16_t* gr = (const bf16_t*)(ws + A_RKV); const bf16_t* gk = gr + (size_t)M * D; const bf16_t* gv = gk + (size_t)M * D;
    const bf16_t* gwl = (const bf16_t*)(ws + A_WAG); const bf16_t* ga = gwl + (size_t)M * D; const bf16_t* gg = ga + (size_t)M * D;
    const int tid = threadIdx.x, lane = tid & 63, wv = __builtin_amdgcn_readfirstlane(tid >> 6); const bool helper = wv >= 4;
    constexpr int NCH = T / 16, NINT = NCH + 4;
    for (int item = blockIdx.x; item < NB * 16; item += gridDim.x) {
        const int b = item >> 4, h = item & 15; const size_t hb = (size_t)b * T * D + h * 64;
        { LAS float* cv = (LAS float*)(lds + L_CV); if (tid < 64) { cv[tid] = I.a_k_k[h * 64 + tid]; cv[64 + tid] = I.a_k_a[h * 64 + tid]; cv[128 + tid] = I.a_r_k[h * 64 + tid]; cv[192 + tid] = I.a_gn_g[h * 64 + tid]; cv[256 + tid] = I.a_gn_b[h * 64 + tid]; }
          for (int i = tid; i < NS * SET_BYTES / 4; i += 512) ((LAS unsigned*)(lds + L_SETS))[i] = 0u;
          for (int i = tid; i < 4 * SP_BYTES / 4; i += 512) ((LAS unsigned*)(lds + L_SP))[i] = 0u; }
        __syncthreads();
        if (helper) {
            const int hw = wv - 4; LAS unsigned char* hp = lds + L_HP + hw * HP_BYTES; const LAS float* cv = (const LAS float*)(lds + L_CV);
            const int t = lane >> 2, jq = lane & 3, j0 = jq * 16;
            u32x4 nr[2], nk[2], nv[2], nw[2], na[2];
#define CS_PREFETCH(cc) do { const size_t _go = hb + (size_t)((cc) * 16 + t) * D + j0; _Pragma("unroll") for (int q = 0; q < 2; ++q) { nr[q] = *(const u32x4*)(gr + _go + 8 * q); nk[q] = *(const u32x4*)(gk + _go + 8 * q); \
                nv[q] = *(const u32x4*)(gv + _go + 8 * q); nw[q] = *(const u32x4*)(gwl + _go + 8 * q); na[q] = *(const u32x4*)(ga + _go + 8 * q); } } while (0)
            CS_PREFETCH(hw);
            for (int g = 0; g < hw; ++g) __syncthreads();
#pragma unroll 1
            for (int c = hw; c < NCH; c += 4) {
                LAS unsigned char* st = lds + L_SETS + (c % NS) * SET_BYTES;
                float kn16[16], km16[16];
                CAMP_T0(10);
                u32x4 xr[2], xk[2], xv[2], xw[2], xa[2];
#pragma unroll
                for (int q = 0; q < 2; ++q) { xr[q] = nr[q]; xk[q] = nk[q]; xv[q] = nv[q]; xw[q] = nw[q]; xa[q] = na[q]; }
                u32x4 pv2[2], pg2[2];
                if (c >= 4) { const size_t po = hb + (size_t)((c - 4) * 16 + t) * D + j0;
#pragma unroll
                    for (int q = 0; q < 2; ++q) { pv2[q] = *(const u32x4*)(gv + po + 8 * q); pg2[q] = *(const u32x4*)(gg + po + 8 * q); } }
                else { pv2[0] = pv2[1] = pg2[0] = pg2[1] = (u32x4){0u, 0u, 0u, 0u}; }
                { LAS float* lw = (LAS float*)(hp + HP_LW);
#pragma unroll
                  for (int q = 0; q < 2; ++q) { float f[8]; unpack8(xw[q], f); *(LAS f32x4*)(lw + t * LWP + j0 + 8 * q) = (f32x4){f[0], f[1], f[2], f[3]}; *(LAS f32x4*)(lw + t * LWP + j0 + 8 * q + 4) = (f32x4){f[4], f[5], f[6], f[7]}; }
                  asm volatile("s_waitcnt lgkmcnt(0)" ::: "memory");
                  float wv16[16];
#pragma unroll
                  for (int s = 0; s < 16; ++s) wv16[s] = lw[s * LWP + lane];
                  float run = 0.f;
#pragma unroll
                  for (int s = 0; s < 16; ++s) { run += wv16[s]; lw[s * LWP + lane] = __expf(run); }
                  asm volatile("s_waitcnt lgkmcnt(0)" ::: "memory"); }
                {
                    float rf[16], kf[16], af[16]; unpack16(xr[0], xr[1], rf); unpack16(xk[0], xk[1], kf); unpack16(xa[0], xa[1], af);
                    float ss = 0.f, bon = 0.f;
#pragma unroll
                    for (int i = 0; i < 16; ++i) { kn16[i] = kf[i] * cv[j0 + i]; ss += kn16[i] * kn16[i]; km16[i] = kf[i] * (1.f + (af[i] - 1.f) * cv[64 + j0 + i]); bon += rf[i] * km16[i] * cv[128 + j0 + i]; }
                    ss += dpp_xor1(ss); ss += dpp_xor2(ss); bon += dpp_xor1(bon); bon += dpp_xor2(bon); const float inv = 1.f / fmaxf(sqrtf(ss), 1e-12f);
#pragma unroll
                    for (int i = 0; i < 16; ++i) kn16[i] *= inv;
                    if (jq == 0) ((LAS float*)(hp + HP_BON))[((c >> 2) & 1) * 16 + t] = bon;
                }
                CAMP_T1(10);
                __syncthreads();
                CAMP_T0(11);
                {
                    const LAS float* lw = (const LAS float*)(hp + HP_LW);
                    float rf[16], af[16]; unpack16(xr[0], xr[1], rf); unpack16(xa[0], xa[1], af);
                    LAS unsigned short* KTp = (LAS unsigned short*)(st + S_KT + t * PT) + j0; LAS unsigned short* RTp = (LAS unsigned short*)(st + S_RT + t * PT) + j0;
                    LAS unsigned short* BTp = (LAS unsigned short*)(hp + HP_BT + t * PT) + j0; LAS unsigned short* KKp = (LAS unsigned short*)(hp + HP_KK + t * PT) + j0;
                    float gt16[16], gp16[16];
#pragma unroll
                    for (int q = 0; q < 4; ++q) { const f32x4 x = *(const LAS f32x4*)(lw + t * LWP + j0 + 4 * q); gt16[4 * q] = x[0]; gt16[4 * q + 1] = x[1]; gt16[4 * q + 2] = x[2]; gt16[4 * q + 3] = x[3];
                        f32x4 y = (f32x4){1.f, 1.f, 1.f, 1.f}; if (t > 0) y = *(const LAS f32x4*)(lw + (t - 1) * LWP + j0 + 4 * q); gp16[4 * q] = y[0]; gp16[4 * q + 1] = y[1]; gp16[4 * q + 2] = y[2]; gp16[4 * q + 3] = y[3]; }
#pragma unroll
                    for (int i = 0; i < 16; i += 2) {
                        float kt2[2], rt2[2], bt2[2], kk2[2];
#pragma unroll
                        for (int e = 0; e < 2; ++e) { const int j = j0 + i + e; const float gt = gt16[i + e], gi = __builtin_amdgcn_rcpf(gt), gp = gp16[i + e]; const float kn = kn16[i + e];
                            kt2[e] = kn * gp; rt2[e] = rf[i + e] * gt; bt2[e] = kn * af[i + e] * gi; kk2[e] = km16[i + e] * gi;
                            (void)j; }
                        *(LAS unsigned*)(KTp + i) = cvt_pk_bf16(kt2[0], kt2[1]); *(LAS unsigned*)(RTp + i) = cvt_pk_bf16(rt2[0], rt2[1]);
                        *(LAS unsigned*)(BTp + i) = cvt_pk_bf16(bt2[0], bt2[1]); *(LAS unsigned*)(KKp + i) = cvt_pk_bf16(kk2[0], kk2[1]); }
                    asm volatile("s_waitcnt lgkmcnt(0)" ::: "memory");
                }
                CAMP_T1(11);
                __syncthreads();
                CAMP_T0(12);
                {
                    const LAS unsigned char* bp = hp + HP_BT + t * PT + j0 * 2; const LAS unsigned char* kp = hp + HP_KK + t * PT + j0 * 2;
                    const u32x4 bA = *(const LAS u32x4*)bp, bB = *(const LAS u32x4*)(bp + 16), kA = *(const LAS u32x4*)kp, kB = *(const LAS u32x4*)(kp + 16);
                    const unsigned bw[8] = {bA.x, bA.y, bA.z, bA.w, bB.x, bB.y, bB.z, bB.w}, kw[8] = {kA.x, kA.y, kA.z, kA.w, kB.x, kB.y, kB.z, kB.w};
#pragma unroll
                    for (int i = 0; i < 16; ++i) { LAS unsigned short* dst = (LAS unsigned short*)(st + S_BKT + (j0 + i) * PW + CS_SKW(j0 + i));
                        dst[t] = (unsigned short)(((i & 1) ? (bw[i >> 1] >> 16) : (bw[i >> 1] & 0xffffu)) ^ 0x8000u); dst[16 + t] = (unsigned short)((i & 1) ? (kw[i >> 1] >> 16) : (kw[i >> 1] & 0xffffu)); }
                }
                if (c >= 4) {
                    const int cp = c - 4; const LAS float* ob = (const LAS float*)(lds + L_OB + (cp % 3) * OB_BYTES); const LAS float* bonp = (const LAS float*)(hp + HP_BON) + (((c >> 2) + 1) & 1) * 16;
                    const size_t po = hb + (size_t)(cp * 16 + t) * D + j0;
                    float ov[16]; float sm = 0.f;
#pragma unroll
                    for (int q = 0; q < 4; ++q) { const f32x4 x = *(const LAS f32x4*)(ob + t * OBP + j0 + 4 * q); ov[4 * q] = x[0]; ov[4 * q + 1] = x[1]; ov[4 * q + 2] = x[2]; ov[4 * q + 3] = x[3]; sm += (x[0] + x[1]) + (x[2] + x[3]); }
                    sm += dpp_xor1(sm); sm += dpp_xor2(sm); const float mean = sm * (1.f / 64.f); float qv = 0.f;
#pragma unroll
                    for (int i = 0; i < 16; ++i) { ov[i] -= mean; qv += ov[i] * ov[i]; }
                    qv += dpp_xor1(qv); qv += dpp_xor2(qv); const float rs = rsqrtf(qv * (1.f / 64.f) + GN_EPS); const float bon = bonp[t];
#pragma unroll
                    for (int q = 0; q < 2; ++q) { float vf[8], gf[8], y[8]; unpack8(pv2[q], vf); unpack8(pg2[q], gf);
#pragma unroll
                        for (int i = 0; i < 8; ++i) y[i] = (ov[8 * q + i] * rs * cv[192 + j0 + 8 * q + i] + cv[256 + j0 + 8 * q + i] + bon * vf[i]) * gf[i];
                        u32x4 w; w.x = cvt_pk_bf16(y[0], y[1]); w.y = cvt_pk_bf16(y[2], y[3]); w.z = cvt_pk_bf16(y[4], y[5]); w.w = cvt_pk_bf16(y[6], y[7]); *(u32x4*)(og + po + 8 * q) = w; }
                }
                {
                    const int fr = lane & 15, fq = lane >> 4;
                    f32x4 cN = {0.f, 0.f, 0.f, 0.f}, cM = cN, cP = cN, cQ = cN;
#pragma unroll
                    for (int ks = 0; ks < 2; ++ks) { const int off = fr * PT + (8 * fq + 32 * ks) * 2;
                        const bf16x8 aB = *(const LAS bf16x8*)(hp + HP_BT + off), aK = *(const LAS bf16x8*)(hp + HP_KK + off), bK = *(const LAS bf16x8*)(st + S_KT + off), bR = *(const LAS bf16x8*)(st + S_RT + off);
                        cN = MFMA16(aB, bK, cN); cM = MFMA16(aK, bK, cM); cP = MFMA16(aB, bR, cP); cQ = MFMA16(aK, bR, cQ); }
                    float mx[4], pp[4], qq[4]; LAS float* nf = (LAS float*)(hp + HP_NF);
#pragma unroll
                    for (int rg = 0; rg < 4; ++rg) { const int s = 4 * fq + rg; nf[s * NFP + fr] = s < fr ? cN[rg] : 0.f; mx[rg] = s < fr ? cM[rg] : 0.f; pp[rg] = s <= fr ? -cP[rg] : 0.f; qq[rg] = s <= fr ? cQ[rg] : 0.f; }
                    LAS unsigned char* mxt = st + S_MXT + fr * PW; LAS unsigned char* pqt = st + S_PQT + fr * PW;
                    *(LAS u32x2*)(mxt + 32 + 8 * fq) = (u32x2){cvt_pk_bf16(mx[0], mx[1]), cvt_pk_bf16(mx[2], mx[3])};
                    *(LAS u32x2*)(pqt + 8 * fq) = (u32x2){cvt_pk_bf16(pp[0], pp[1]), cvt_pk_bf16(pp[2], pp[3])};
                    *(LAS u32x2*)(pqt + 32 + 8 * fq) = (u32x2){cvt_pk_bf16(qq[0], qq[1]), cvt_pk_bf16(qq[2], qq[3])};
                    asm volatile("s_waitcnt lgkmcnt(0)" ::: "memory");
                }
                CAMP_T1(12);
                __syncthreads();
                CAMP_T0(13);
                if (c + 4 < NCH) CS_PREFETCH(c + 4);
                {
                    const unsigned vw[8] = {xv[0].x, xv[0].y, xv[0].z, xv[0].w, xv[1].x, xv[1].y, xv[1].z, xv[1].w};
#pragma unroll
                    for (int i = 0; i < 16; ++i) ((LAS unsigned short*)(st + S_WV + (j0 + i) * PW + CS_SKW(j0 + i)))[16 + t] = (unsigned short)((i & 1) ? (vw[i >> 1] >> 16) : (vw[i >> 1] & 0xffffu));
                    if (t == 15) { const LAS float* lw = (const LAS float*)(hp + HP_LW);
#pragma unroll
                        for (int q = 0; q < 4; ++q) *(LAS f32x4*)((LAS float*)(st + S_GL) + j0 + 4 * q) = *(const LAS f32x4*)(lw + 15 * LWP + j0 + 4 * q); }
                }
                {
                    const LAS float* nf = (const LAS float*)(hp + HP_NF); const int col = lane & 15; float Tc[16];
#pragma unroll
                    for (int s = 15; s >= 0; --s) { float acc = (s == col) ? 1.f : 0.f;
#pragma unroll
                        for (int u2 = s + 1; u2 < 16; ++u2) acc -= nf[s * NFP + u2] * Tc[u2];
#if defined(DBG_TID) && DBG_TID == 1
                        acc = (s == col) ? 1.f : 0.f;
#elif defined(DBG_TID) && DBG_TID == 2
                        acc = (s == col) ? 1.f : ((s < col) ? -nf[s * NFP + col] : 0.f);
#endif
                        Tc[s] = acc; }
                    if (lane < 16) { LAS unsigned char* tt = st + S_TT + col * PW;
#pragma unroll
                        for (int q = 0; q < 4; ++q) *(LAS u32x2*)(tt + 8 * q) = (u32x2){cvt_pk_bf16(Tc[4 * q], Tc[4 * q + 1]), cvt_pk_bf16(Tc[4 * q + 2], Tc[4 * q + 3])}; }
                    asm volatile("s_waitcnt lgkmcnt(0)" ::: "memory");
                }
                CAMP_T1(13);
                __syncthreads();
            }
#undef CS_PREFETCH
            {
                const int cl = NCH - 4 + hw; __syncthreads();
                const LAS float* ob = (const LAS float*)(lds + L_OB + (cl % 3) * OB_BYTES); const LAS float* bonp = (const LAS float*)(hp + HP_BON) + ((cl >> 2) & 1) * 16; const size_t po = hb + (size_t)(cl * 16 + t) * D + j0;
                float ov[16]; float sm = 0.f;
#pragma unroll
                for (int q = 0; q < 4; ++q) { const f32x4 x = *(const LAS f32x4*)(ob + t * OBP + j0 + 4 * q); ov[4 * q] = x[0]; ov[4 * q + 1] = x[1]; ov[4 * q + 2] = x[2]; ov[4 * q + 3] = x[3]; sm += (x[0] + x[1]) + (x[2] + x[3]); }
                sm += dpp_xor1(sm); sm += dpp_xor2(sm); const float mean = sm * (1.f / 64.f); float qv = 0.f;
#pragma unroll
                for (int i = 0; i < 16; ++i) { ov[i] -= mean; qv += ov[i] * ov[i]; }
                qv += dpp_xor1(qv); qv += dpp_xor2(qv); const float rs = rsqrtf(qv * (1.f / 64.f) + GN_EPS); const float bon = bonp[t];
#pragma unroll
                for (int q = 0; q < 2; ++q) { const u32x4 pv2 = *(const u32x4*)(gv + po + 8 * q), pg2 = *(const u32x4*)(gg + po + 8 * q); float vf[8], gf[8], y[8]; unpack8(pv2, vf); unpack8(pg2, gf);
#pragma unroll
                    for (int i = 0; i < 8; ++i) y[i] = (ov[8 * q + i] * rs * cv[192 + j0 + 8 * q + i] + cv[256 + j0 + 8 * q + i] + bon * vf[i]) * gf[i];
                    u32x4 w; w.x = cvt_pk_bf16(y[0], y[1]); w.y = cvt_pk_bf16(y[2], y[3]); w.z = cvt_pk_bf16(y[4], y[5]); w.w = cvt_pk_bf16(y[6], y[7]); *(u32x4*)(og + po + 8 * q) = w; }
                for (int g = 0; g < 3 - hw; ++g) __syncthreads();
            }
        } else {
            const int fr = lane & 15, fq = lane >> 4, i0 = wv * 16; LAS unsigned char* sp = lds + L_SP + wv * SP_BYTES;
            f32x4 Sacc[4];
#pragma unroll
            for (int c4 = 0; c4 < 4; ++c4) Sacc[c4] = (f32x4){0.f, 0.f, 0.f, 0.f};
            for (int g = 0; g < 4; ++g) __syncthreads();
#pragma unroll 1
            for (int c = 0; c < NCH; ++c) {
                CAMP_T0(20);
                const LAS unsigned char* st = lds + L_SETS + (c % NS) * SET_BYTES; LAS unsigned char* stw = lds + L_SETS + (c % NS) * SET_BYTES;
                const bf16x8 aS0 = *(const LAS bf16x8*)(sp + SP_SB + fr * PT + (8 * fq) * 2), aS1 = *(const LAS bf16x8*)(sp + SP_SB + fr * PT + (8 * fq + 32) * 2);
                const bf16x8 bK0 = *(const LAS bf16x8*)(st + S_KT + fr * PT + (8 * fq) * 2), bK1 = *(const LAS bf16x8*)(st + S_KT + fr * PT + (8 * fq + 32) * 2);
                const bf16x8 bR0 = *(const LAS bf16x8*)(st + S_RT + fr * PT + (8 * fq) * 2), bR1 = *(const LAS bf16x8*)(st + S_RT + fr * PT + (8 * fq + 32) * 2);
                f32x4 G = MFMA16(aS0, bK0, ((f32x4){0.f, 0.f, 0.f, 0.f})); G = MFMA16(aS1, bK1, G);
                f32x4 O = MFMA16(aS0, bR0, ((f32x4){0.f, 0.f, 0.f, 0.f})); O = MFMA16(aS1, bR1, O);
                const bf16x8 aWV0 = *(const LAS bf16x8*)(st + S_WV + (i0 + fr) * PW + CS_SKW(i0) + 16 * fq);
                const bf16x8 bMX = *(const LAS bf16x8*)(st + S_MXT + fr * PW + 16 * fq);
                G = MFMA16(aWV0, bMX, G);
                { LAS unsigned short* rb = (LAS unsigned short*)(sp + SP_RB);
#pragma unroll
                  for (int rg = 0; rg < 4; ++rg) rb[(4 * fq + rg) * 24 + fr] = bf1(G[rg]);
                  asm volatile("s_waitcnt lgkmcnt(0)" ::: "memory"); }
                bf16x8 aRH = *(const LAS bf16x8*)(sp + SP_RB + fr * 48 + 16 * (fq & 1)); if (fq >= 2) aRH = (bf16x8){0, 0, 0, 0, 0, 0, 0, 0};
#if defined(DBG_ARH)
                aRH = (fq >= 2) ? (bf16x8){0, 0, 0, 0, 0, 0, 0, 0} : (bf16x8){0x3f80, 0x3f80, 0x3f80, 0x3f80, 0x3f80, 0x3f80, 0x3f80, 0x3f80};
#endif
#if defined(DBG_BTT)
                const bf16x8 bTT = (fq >= 2) ? (bf16x8){0, 0, 0, 0, 0, 0, 0, 0} : (bf16x8){0x3f80, 0, 0, 0, 0, 0, 0, 0};
#else
                const bf16x8 bTT = *(const LAS bf16x8*)(st + S_TT + fr * PW + 16 * fq);
#endif
                const f32x4 W = MFMA16(aRH, bTT, ((f32x4){0.f, 0.f, 0.f, 0.f}));
                {
#pragma unroll
                  for (int rg = 0; rg < 4; ++rg) ((LAS unsigned short*)(stw + S_WV + (i0 + 4 * fq + rg) * PW + CS_SKW(i0)))[fr] = bf1(W[rg]);
                  asm volatile("s_waitcnt lgkmcnt(0)" ::: "memory"); }
                const bf16x8 aWV = *(const LAS bf16x8*)(st + S_WV + (i0 + fr) * PW + CS_SKW(i0) + 16 * fq);
                const bf16x8 bPQ = *(const LAS bf16x8*)(st + S_PQT + fr * PW + 16 * fq);
                O = MFMA16(aWV, bPQ, O);
#if defined(DBG_OSEL) && DBG_OSEL == 1
                O = G;
#elif defined(DBG_OSEL) && DBG_OSEL == 2
                O = W;
#elif defined(DBG_OSEL) && DBG_OSEL == 4
                O = (f32x4){bf2f((unsigned short)aRH[0]), bf2f((unsigned short)aRH[1]), bf2f((unsigned short)aRH[2]), bf2f((unsigned short)aRH[3])};
#elif defined(DBG_OSEL) && DBG_OSEL == 5
                O = (f32x4){bf2f(bf1(G[0])), bf2f(bf1(G[1])), bf2f(bf1(G[2])), bf2f(bf1(G[3]))};
#elif defined(DBG_OSEL) && DBG_OSEL == 3
                O = (f32x4){1.f + fr, 2.f, 3.f + fq, 4.f};
#endif
                *(LAS f32x4*)(lds + L_OB + (c % 3) * OB_BYTES + (fr * OBP + i0 + 4 * fq) * 4) = O;
#pragma unroll
                for (int c4 = 0; c4 < 4; ++c4) { const bf16x8 bBK = *(const LAS bf16x8*)(st + S_BKT + (16 * c4 + fr) * PW + CS_SKW(16 * c4) + 16 * fq); const float gl = ((const LAS float*)(st + S_GL))[16 * c4 + fr];
                    Sacc[c4] = MFMA16(aWV, bBK, Sacc[c4]); Sacc[c4] = Sacc[c4] * gl; }
                { LAS unsigned short* sb = (LAS unsigned short*)(sp + SP_SB);
#pragma unroll
                  for (int c4 = 0; c4 < 4; ++c4)
#pragma unroll
                      for (int rg = 0; rg < 4; ++rg) sb[(4 * fq + rg) * (PT / 2) + 16 * c4 + fr] = bf1(Sacc[c4][rg]);
                  asm volatile("s_waitcnt lgkmcnt(0)" ::: "memory"); }
                CAMP_T1(20);
                __syncthreads();
            }
        }
        __syncthreads();
    }
#ifdef CS_AMP
    { const unsigned long long ts = __builtin_amdgcn_s_memrealtime(); while (__builtin_amdgcn_s_memrealtime() - ts < camp_acc) __builtin_amdgcn_s_sleep(8); }
#endif
}
}
namespace fx {
__device__ __forceinline__ bf16x8 ldg8(const bf16_t* p) { return *(const bf16x8*)p; }
__device__ __forceinline__ bf16x8 ldg4x2(const bf16_t* p) { const bf16x4 a = *(const bf16x4*)p, b = *(const bf16x4*)(p + 8); return (bf16x8){a[0], a[1], a[2], a[3], b[0], b[1], b[2], b[3]}; }
__device__ __forceinline__ bf16x8 packp(const f32x16& p, int s2) { u32x4 w; w.x = cvt_pk_bf16(p[8 * s2 + 0], p[8 * s2 + 1]); w.y = cvt_pk_bf16(p[8 * s2 + 2], p[8 * s2 + 3]); w.z = cvt_pk_bf16(p[8 * s2 + 4], p[8 * s2 + 5]); w.w = cvt_pk_bf16(p[8 * s2 + 6], p[8 * s2 + 7]); return __builtin_bit_cast(bf16x8, w); }
__device__ __forceinline__ int or8(int v) { v |= __builtin_amdgcn_update_dpp(0, v, 0xB1, 0xF, 0xF, true); v |= __builtin_amdgcn_update_dpp(0, v, 0x4E, 0xF, 0xF, true); v |= __builtin_amdgcn_update_dpp(0, v, 0x141, 0xF, 0xF, true); return v; }
#define MFMA32(a, b, c) __builtin_amdgcn_mfma_f32_32x32x16_bf16((a), (b), (c), 0, 0, 0)
constexpr float SCL = 0.125f * LOG2E;

constexpr int KP = 144, VP = 136;
constexpr int CKP = 144, CVP = 264;
constexpr int IWP = 36;
constexpr int L_KB = 0, L_VB = 18432, L_CK = 35840, L_CV = 54272, L_IMPW = 71168, L_IMPF = 103936, L_SELM = 112128, L_INVS = 112384, L_UNI = 113408, L_JOBS = 113424;
constexpr float MASKV = -1e30f, MINIT = -5e29f;
__device__ __forceinline__ void attn_sub(const LAS unsigned char* kt, const LAS unsigned char* vtile, int sub, const bf16x8 (&qf)[4], int ql, int hh, float lanebias, bool emask, int key0s, int t, int winlim, float& m, float& lsum, f32x16 (&o)[2]) {
    f32x16 sa;
#pragma unroll
    for (int i = 0; i < 16; ++i) sa[i] = 0.f;
#pragma unroll
    for (int s = 0; s < 4; ++s) sa = MFMA32(*(const LAS bf16x8*)(kt + (sub * 32 + ql) * KP + 32 * s + 16 * hh), qf[s], sa);
    float mt = MASKV;
    if (emask) {
#pragma unroll
        for (int i = 0; i < 16; ++i) { const int key = key0s + (i & 3) + 8 * (i >> 2) + 4 * hh; const bool ok = key <= t && (t - key) < winlim; sa[i] = ok ? __builtin_fmaf(sa[i], SCL, lanebias) : MASKV; mt = fmaxf(mt, sa[i]); }
    } else {
#pragma unroll
        for (int i = 0; i < 16; ++i) { sa[i] = __builtin_fmaf(sa[i], SCL, lanebias); mt = fmaxf(mt, sa[i]); }
    }
    mt = max_xhalf(mt); const float mn = fmaxf(m, mt); const float alpha = __builtin_amdgcn_exp2f(m - mn); float ps = 0.f;
#pragma unroll
    for (int i = 0; i < 16; ++i) { sa[i] = __builtin_amdgcn_exp2f(sa[i] - mn); ps += sa[i]; }
    lsum = lsum * alpha + ps; m = mn;
    if (__ballot(alpha != 1.f) != 0ull) {
#pragma unroll
        for (int dt = 0; dt < 2; ++dt)
#pragma unroll
            for (int i = 0; i < 16; ++i) o[dt][i] *= alpha;
    }
#pragma unroll
    for (int s2 = 0; s2 < 2; ++s2) { const bf16x8 pf = packp(sa, s2);
#pragma unroll
        for (int dt = 0; dt < 2; ++dt) { const LAS unsigned char* vp = vtile + (dt * 32 + ql) * VP + (sub * 32 + 16 * s2 + 4 * hh) * 2;
            const bf16x4 a = *(const LAS bf16x4*)vp, b2 = *(const LAS bf16x4*)(vp + 16);
            o[dt] = MFMA32(((bf16x8){a[0], a[1], a[2], a[3], b2[0], b2[1], b2[2], b2[3]}), pf, o[dt]); } }
}

__device__ __forceinline__ void attn_job64(const LAS unsigned char* kt, const LAS unsigned char* vtile, const bf16x8 (&qf)[4], int ql, int hh, float lanebias, bool emask, int key0, int t, int winlim, float& m, f32x16& lacc, f32x16 (&o)[2]) {
    f32x16 sa[2];
#pragma unroll
    for (int sub = 0; sub < 2; ++sub)
#pragma unroll
        for (int i = 0; i < 16; ++i) sa[sub][i] = 0.f;
#ifndef NO_ATT_PRIO
    __builtin_amdgcn_s_setprio(1);
#endif
#pragma unroll
    for (int s = 0; s < 4; ++s)
#pragma unroll
        for (int sub = 0; sub < 2; ++sub) sa[sub] = MFMA32(*(const LAS bf16x8*)(kt + (sub * 32 + ql) * KP + 32 * s + 16 * hh), qf[s], sa[sub]);
#ifndef NO_ATT_PRIO
    __builtin_amdgcn_s_setprio(0);
#endif
    (void)m; const unsigned keep = lanebias < 0.f ? 0u : 0xffffffffu;
    if (emask) {
#pragma unroll
        for (int sub = 0; sub < 2; ++sub)
#pragma unroll
            for (int i = 0; i < 16; ++i) { const int key = key0 + sub * 32 + (i & 3) + 8 * (i >> 2) + 4 * hh; const bool ok = key <= t && (t - key) < winlim; sa[sub][i] = ok ? __builtin_amdgcn_exp2f(sa[sub][i]) : 0.f; }
    } else {
#pragma unroll
        for (int sub = 0; sub < 2; ++sub)
#pragma unroll
            for (int i = 0; i < 16; ++i) sa[sub][i] = __builtin_amdgcn_exp2f(sa[sub][i]);
    }
#ifndef NO_ATT_PRIO
    __builtin_amdgcn_s_setprio(1);
#endif
    const bf16x8 ones = (ql == 0) ? (bf16x8){0x3f80, 0x3f80, 0x3f80, 0x3f80, 0x3f80, 0x3f80, 0x3f80, 0x3f80} : (bf16x8){0, 0, 0, 0, 0, 0, 0, 0};
#pragma unroll
    for (int sub = 0; sub < 2; ++sub)
#pragma unroll
        for (int s2 = 0; s2 < 2; ++s2) { bf16x8 pf = packp(sa[sub], s2); if (keep == 0u) pf = (bf16x8){0, 0, 0, 0, 0, 0, 0, 0};
            lacc = MFMA32(ones, pf, lacc);
#pragma unroll
            for (int dt = 0; dt < 2; ++dt) { const LAS unsigned char* vp = vtile + (dt * 32 + ql) * VP + (sub * 32 + 16 * s2 + 4 * hh) * 2;
                const bf16x4 a = *(const LAS bf16x4*)vp, b2 = *(const LAS bf16x4*)(vp + 16);
                o[dt] = MFMA32(((bf16x8){a[0], a[1], a[2], a[3], b2[0], b2[1], b2[2], b2[3]}), pf, o[dt]); } }
#ifndef NO_ATT_PRIO
    __builtin_amdgcn_s_setprio(0);
#endif
}

#ifdef ATT_AMP
#ifndef AMP_MUL
#define AMP_MUL 1
#endif
#define AMP_T0(sec) unsigned long long _t0_##sec = __builtin_amdgcn_s_memrealtime()
#define AMP_T1(sec) do { if (ATT_AMP == sec) amp_acc += __builtin_amdgcn_s_memrealtime() - _t0_##sec; } while (0)
#else
#define AMP_T0(sec) do { } while (0)
#define AMP_T1(sec) do { } while (0)
#endif
__device__ __forceinline__ void attn_phase(const Params& P, LAS unsigned char* lds) {
    unsigned char* ws = P.ws; unsigned long long amp_acc = 0; (void)amp_acc;
    const bf16_t* q = (const bf16_t*)(ws + A_Q); const bf16_t* qr = (const bf16_t*)(ws + A_QR); const bf16_t* kcmp = (const bf16_t*)(ws + A_KCMP); const bf16_t* vcT = (const bf16_t*)(ws + A_VCMPT);
    const bf16_t* ks = (const bf16_t*)(ws + A_KS); const bf16_t* kw = (const bf16_t*)(ws + A_KW); const bf16_t* vts = (const bf16_t*)(ws + A_VTS); const bf16_t* vtw = vts + (size_t)256 * M;
    const float* gates = (const float*)(ws + A_GATES); bf16_t* att = (bf16_t*)(ws + A_ATT);
    LAS float* impw = (LAS float*)(lds + L_IMPW); LAS float* impf = (LAS float*)(lds + L_IMPF); LAS unsigned* selm = (LAS unsigned*)(lds + L_SELM); LAS float* invs = (LAS float*)(lds + L_INVS);
    LAS unsigned* uni = (LAS unsigned*)(lds + L_UNI); LAS unsigned char* jobs = lds + L_JOBS;
    const int tid = threadIdx.x, lane = tid & 63, wid = tid >> 6, r = wid & 3, c2 = wid >> 2, ql = lane & 31, hh = lane >> 5;
    const int srow = tid >> 3, schunk = tid & 7;
    for (int it = blockIdx.x; it < 2048; it += gridDim.x) {
#ifdef ATT_OLD_ORDER
        const int j = it >> 8, w = it & 255, wq = w >> 6; const int qb = 31 - ((j & 1) ? (3 - wq) : wq) - 4 * j; const int bg = w & 63, b = bg >> 2, g = bg & 3;
#else
        const int j = it >> 8, w = it & 255, xx = w & 7, ii = w >> 3, i16 = ii & 15, hi = ii >> 4, pp2 = j >> 1;
        const int u = pp2 == 0 ? i16 : (pp2 == 1 ? 15 - i16 : (pp2 == 2 ? ((i16 + 8) & 15) : ((7 - i16) & 15)));
        const int qb = ((j & 1) ^ hi) ? 31 - u : u; const int bg = xx * 8 + j, b = bg >> 2, g = bg & 3;
#endif
        const int head = g * 4 + r, t = qb * 64 + c2 * 32 + ql; const size_t qoff = (size_t)(b * T + t) * 1024 + head * 64;
        const float g0 = gates[(size_t)(b * T + t) * 64 + head * 3 + 0], g1 = gates[(size_t)(b * T + t) * 64 + head * 3 + 1], g2 = gates[(size_t)(b * T + t) * 64 + head * 3 + 2];
        AMP_T0(1); AMP_T0(5);
        const bf16_t* ksb = ks + (size_t)bg * T * 64; const bf16_t* kwb = kw + (size_t)bg * T * 64;
        const bf16_t* vsb = vts + (size_t)(g * 64) * M + (size_t)b * T; const bf16_t* vwb = vtw + (size_t)(g * 64) * M + (size_t)b * T;
        u32x4 kregA, vregA, kregB, vregB;
#define ATT_LOADB(_blk, _win, KR, VR) do { const bf16_t* _kb = (_win) ? kwb : ksb; const bf16_t* _vb = (_win) ? vwb : vsb; \
            KR = *(const u32x4*)(_kb + (size_t)((_blk) * 64 + srow) * 64 + schunk * 8); VR = *(const u32x4*)(_vb + (size_t)srow * M + (_blk) * 64 + schunk * 8); } while (0)
        bf16x8 qfc[4];
#pragma unroll
        for (int s = 0; s < 4; ++s) qfc[s] = ldg8(q + qoff + 16 * s + 8 * hh);
        ATT_LOADB(0, false, kregB, vregB);
        { const int b1 = qb == 0 ? 0 : (qb - 1 > 1 ? qb - 1 : 1); ATT_LOADB(b1, qb == 0, kregA, vregA); }
        {
            const u32x4* kc4 = (const u32x4*)(kcmp + (size_t)bg * 128 * 64); const u32x4* vc4 = (const u32x4*)(vcT + (size_t)bg * 64 * 128);
            const int ntl = (4 * qb + 2) / 32 + 1;
#pragma unroll
            for (int i = 0; i < 2; ++i) { const int e = tid + 512 * i;
                if ((e >> 3) < 32 * ntl) { const u32x4 kv = kc4[e]; *(LAS u32x4*)(lds + L_CK + (e >> 3) * CKP + (e & 7) * 16) = kv; }
                if ((e & 15) < 4 * ntl) { const u32x4 vv = vc4[e]; LAS unsigned char* vd = lds + L_CV + (e >> 4) * CVP + (e & 15) * 16; *(LAS u32x2*)vd = (u32x2){vv.x, vv.y}; *(LAS u32x2*)(vd + 8) = (u32x2){vv.z, vv.w}; } }
            if (tid == 0) uni[0] = 0u;
        }
        __syncthreads();
        AMP_T1(5); AMP_T0(6);
        unsigned otp[2][8];
        {
            float ls = 0.f, ecarry = 0.f; f32x16 oc[2];
#pragma unroll
            for (int dt = 0; dt < 2; ++dt)
#pragma unroll
                for (int i = 0; i < 16; ++i) oc[dt][i] = 0.f;
            LAS float* iw = impw + (size_t)(r * 64 + c2 * 32 + ql) * IWP;
#pragma unroll 2
            for (int tl = 0; tl < 4; ++tl) { f32x16 a;
                if (tl * 512 + 31 > qb * 64 + c2 * 32 + 31) {
#pragma unroll
                    for (int gg = 0; gg < 4; ++gg) iw[tl * 8 + 2 * gg + hh] = 0.f;
                    ecarry = 0.f; continue; }
#pragma unroll
                for (int i = 0; i < 16; ++i) a[i] = 0.f;
#pragma unroll
                for (int s = 0; s < 4; ++s) a = MFMA32(*(const LAS bf16x8*)(lds + L_CK + (tl * 32 + ql) * CKP + 32 * s + 16 * hh), qfc[s], a);
#pragma unroll
                for (int i = 0; i < 16; ++i) { const int n = tl * 32 + (i & 3) + 8 * (i >> 2) + 4 * hh; const float pv = (n * 16 + 31 <= t) ? __builtin_amdgcn_exp2f(a[i]) : 0.f; a[i] = pv; ls += pv; }
                float ep[4];
#pragma unroll
                for (int gg = 0; gg < 4; ++gg) ep[gg] = xhalf(a[4 * gg + 3]);
#pragma unroll
                for (int gg = 0; gg < 4; ++gg) { const float Gs = (a[4 * gg] + a[4 * gg + 1]) + (a[4 * gg + 2] + a[4 * gg + 3]);
                    const float eprev0 = gg > 0 ? ep[gg > 0 ? gg - 1 : 0] : ecarry; const float e = hh ? ep[gg] : eprev0; iw[tl * 8 + 2 * gg + hh] = Gs + e; }
                ecarry = ep[3];
#pragma unroll
                for (int s2 = 0; s2 < 2; ++s2) { const bf16x8 pf = packp(a, s2);
#pragma unroll
                    for (int dt = 0; dt < 2; ++dt) { const LAS unsigned char* vp = lds + L_CV + (dt * 32 + ql) * CVP + (tl * 32 + 16 * s2 + 4 * hh) * 2;
                        const bf16x4 x = *(const LAS bf16x4*)vp, y = *(const LAS bf16x4*)(vp + 16);
                        oc[dt] = MFMA32(((bf16x8){x[0], x[1], x[2], x[3], y[0], y[1], y[2], y[3]}), pf, oc[dt]); } } }
            ls = sum_xhalf(ls); const float inv = ls > 0.f ? 1.f / ls : 0.f;
            if (hh == 0) invs[r * 64 + c2 * 32 + ql] = inv;
            const float sc0 = inv * g0;
#pragma unroll
            for (int dt = 0; dt < 2; ++dt)
#pragma unroll
                for (int i = 0; i < 8; ++i) otp[dt][i] = cvt_pk_bf16(oc[dt][2 * i] * sc0, oc[dt][2 * i + 1] * sc0);
        }
        AMP_T1(6); AMP_T0(7);
        __syncthreads();
        {
            const int qq = tid >> 3, sg = tid & 7;
            f32x4 tot = (f32x4){0.f, 0.f, 0.f, 0.f};
#pragma unroll
            for (int h = 0; h < 4; ++h) { const f32x4 x = *(const LAS f32x4*)(impw + (size_t)(h * 64 + qq) * IWP + 4 * sg); const float iv = invs[h * 64 + qq]; tot[0] += x[0] * iv; tot[1] += x[1] * iv; tot[2] += x[2] * iv; tot[3] += x[3] * iv; }
            unsigned kx[4];
#pragma unroll
            for (int i = 0; i < 4; ++i) { const int sI = 4 * sg + i; const bool forced = (sI == 0) || (sI == qb) || (sI == qb - 1); const float v = forced ? 1e4f : tot[i];
                kx[i] = sI <= qb ? ((__float_as_uint(v) & ~31u) | (unsigned)(31 - sI)) : 0u; }
            unsigned bits = 0u;
#pragma unroll
            for (int k = 0; k < 8; ++k) {
                unsigned gm = max(max(kx[0], kx[1]), max(kx[2], kx[3]));
                gm = max(gm, (unsigned)__builtin_amdgcn_update_dpp(0, (int)gm, 0xB1, 0xF, 0xF, true)); gm = max(gm, (unsigned)__builtin_amdgcn_update_dpp(0, (int)gm, 0x4E, 0xF, 0xF, true)); gm = max(gm, (unsigned)__builtin_amdgcn_update_dpp(0, (int)gm, 0x141, 0xF, 0xF, true));
                bits |= gm ? (1u << (31u - (gm & 31u))) : 0u;
#pragma unroll
                for (int i = 0; i < 4; ++i) kx[i] = kx[i] == gm ? 0u : kx[i];
            }
            if (sg == 0) { selm[qq] = bits; __hip_atomic_fetch_or(uni, bits, __ATOMIC_RELAXED, __HIP_MEMORY_SCOPE_WORKGROUP); }
        }
        __syncthreads();
        AMP_T1(7); AMP_T0(8);
        const unsigned um = uni[0] & (qb >= 31 ? 0xffffffffu : ((1u << (qb + 1)) - 1u));
        const int nslc = __popc(um); const int wlo = qb - 8 > 0 ? qb - 8 : 0; const int njobs = nslc + (qb - wlo + 1);
        {
            const unsigned fm = (1u | (1u << qb) | (qb > 0 ? (1u << (qb - 1)) : 0u)) & um; const unsigned rest = um & ~fm; const int nf = __popc(fm);
            if (tid < 32) { const unsigned below = (1u << tid) - 1u;
                if ((fm >> tid) & 1u) jobs[__popc(fm & below)] = (unsigned char)tid; else if ((rest >> tid) & 1u) jobs[nf + __popc(rest & below)] = (unsigned char)tid; }
            else if (tid < 48) { const int kb = wlo + (tid - 32); if (kb <= qb) jobs[nslc + (tid - 32)] = (unsigned char)kb; }
        }
        const unsigned sel = selm[c2 * 32 + ql];
        bf16x8 qf[4];
#pragma unroll
        for (int s = 0; s < 4; ++s) qf[s] = ldg8(qr + qoff + 16 * s + 8 * hh);
        __syncthreads();
        AMP_T1(1); AMP_T1(8);
        AMP_T0(2);
#define ATT_LOAD(ji, KR, VR) do { const int _jb = jobs[(ji)]; const bool _jw = (ji) >= nslc; ATT_LOADB(_jb, _jw, KR, VR); } while (0)
#define ATT_STORE(buf, KR, VR) do { *(LAS u32x4*)(lds + L_KB + (buf) * 9216 + srow * KP + schunk * 16) = KR; LAS unsigned char* _vd = lds + L_VB + (buf) * 8704 + srow * VP + schunk * 16; \
            *(LAS u32x2*)_vd = (u32x2){VR.x, VR.y}; *(LAS u32x2*)(_vd + 8) = (u32x2){VR.z, VR.w}; } while (0)
#define ATT_COMPUTE(ji) do { \
            if ((ji) == nslc) { const float ls = sum_xhalf(hh == 0 ? lacc[0] : 0.f); const float sc1 = ls > 0.f ? g1 / ls : 0.f; \
                _Pragma("unroll") for (int dt = 0; dt < 2; ++dt) _Pragma("unroll") for (int i = 0; i < 8; ++i) { otp[dt][i] = cvt_pk_bf16(bflo(otp[dt][i]) + o[dt][2 * i] * sc1, bfhi(otp[dt][i]) + o[dt][2 * i + 1] * sc1); o[dt][2 * i] = 0.f; o[dt][2 * i + 1] = 0.f; } \
                m = MINIT; _Pragma("unroll") for (int i = 0; i < 16; ++i) lacc[i] = 0.f; } \
            const int blk = jobs[(ji)]; const bool win = (ji) >= nslc; const int buf = (ji) & 1; \
            const LAS unsigned char* kt = lds + L_KB + buf * 9216; const LAS unsigned char* vtile = lds + L_VB + buf * 8704; \
            const bool mine = win || ((sel >> blk) & 1u); \
            if (__ballot(mine) != 0ull) { const float lb = mine ? 0.f : MASKV; const bool emask = win ? (blk == qb || blk == qb - 8) : (blk == qb); const int wl = win ? 512 : (1 << 30); \
                attn_job64(kt, vtile, qf, ql, hh, lb, emask, blk * 64, t, wl, m, lacc, o); } } while (0)
        ATT_STORE(0, kregB, vregB);
        if (njobs > 2) ATT_LOAD(2, kregB, vregB);
        __syncthreads();
        float m = MINIT; f32x16 o[2], lacc;
#pragma unroll
        for (int i = 0; i < 16; ++i) lacc[i] = 0.f;
#pragma unroll
        for (int dt = 0; dt < 2; ++dt)
#pragma unroll
            for (int i = 0; i < 16; ++i) o[dt][i] = 0.f;
#pragma unroll 1
        for (int ji = 0; ji < njobs; ji += 2) {
            {
                { AMP_T0(3); ATT_COMPUTE(ji); AMP_T1(3); }
                { AMP_T0(4); if (ji + 1 < njobs) ATT_STORE(1, kregA, vregA);
                __syncthreads();
                if (ji + 3 < njobs) ATT_LOAD(ji + 3, kregA, vregA); AMP_T1(4); }
            }
            if (ji + 1 < njobs) {
                { AMP_T0(3); ATT_COMPUTE(ji + 1); AMP_T1(3); }
                { AMP_T0(4); if (ji + 2 < njobs) ATT_STORE(0, kregB, vregB);
                __syncthreads();
                if (ji + 4 < njobs) ATT_LOAD(ji + 4, kregB, vregB); AMP_T1(4); }
            }
        }
#undef ATT_COMPUTE
        AMP_T1(2);
#undef ATT_LOAD
#undef ATT_LOADB
#undef ATT_STORE
        {
            const float ls = sum_xhalf(hh == 0 ? lacc[0] : 0.f); const float sc2 = ls > 0.f ? g2 / ls : 0.f;
#pragma unroll
            for (int dt = 0; dt < 2; ++dt)
#pragma unroll
                for (int i = 0; i < 8; ++i) otp[dt][i] = cvt_pk_bf16(bflo(otp[dt][i]) + o[dt][2 * i] * sc2, bfhi(otp[dt][i]) + o[dt][2 * i + 1] * sc2);
        }
#pragma unroll
        for (int dt = 0; dt < 2; ++dt)
#pragma unroll
            for (int gp = 0; gp < 2; ++gp) { const int ge = 2 * gp, go = 2 * gp + 1;
                const unsigned s0 = hh ? otp[dt][2 * ge] : otp[dt][2 * go], s1 = hh ? otp[dt][2 * ge + 1] : otp[dt][2 * go + 1];
                const unsigned r0 = (unsigned)__shfl_xor((int)s0, 32), r1 = (unsigned)__shfl_xor((int)s1, 32);
                u32x4 wv; if (hh) { wv.x = r0; wv.y = r1; wv.z = otp[dt][2 * go]; wv.w = otp[dt][2 * go + 1]; } else { wv.x = otp[dt][2 * ge]; wv.y = otp[dt][2 * ge + 1]; wv.z = r0; wv.w = r1; }
                *(u32x4*)(att + qoff + dt * 32 + 8 * (hh ? go : ge)) = wv; }
        __syncthreads();
    }
#ifdef ATT_AMP
    { const unsigned long long ts = __builtin_amdgcn_s_memrealtime(); while (__builtin_amdgcn_s_memrealtime() - ts < amp_acc * AMP_MUL) __builtin_amdgcn_s_sleep(8); }
#endif
}

#define XB_TMO      128
#define XB_XCNT(j)  (256  + 64 * (j))
#define XB_XSUB(j)  (1280 + 64 * (j))
#define XB_XGEN(j)  (2304 + 64 * (j))
#define XB_TOP      3328
#define XB_TOPGEN   3392
#define XCD_BAR_WORDS 3456
#define XB_SPIN_CAP (1u << 18)

__device__ __forceinline__ unsigned xb_ld(unsigned* p)              { return __hip_atomic_load(p, __ATOMIC_RELAXED, __HIP_MEMORY_SCOPE_AGENT); }
__device__ __forceinline__ unsigned xb_add(unsigned* p, unsigned v) { return __hip_atomic_fetch_add(p, v, __ATOMIC_RELAXED, __HIP_MEMORY_SCOPE_AGENT); }
#ifdef XB_LOCAL_L2
__device__ __forceinline__ unsigned xb_add_l(unsigned* p, unsigned v) { return __hip_atomic_fetch_add(p, v, __ATOMIC_RELAXED, __HIP_MEMORY_SCOPE_WORKGROUP); }
#else
__device__ __forceinline__ unsigned xb_add_l(unsigned* p, unsigned v) { return __hip_atomic_fetch_add(p, v, __ATOMIC_RELAXED, __HIP_MEMORY_SCOPE_AGENT); }
#endif
__device__ __forceinline__ unsigned xb_xcc_id() { return (unsigned)__builtin_amdgcn_s_getreg((3 << 11) | 20) & 0xFu; }
#define XB_SPIN(cond, bar) do { unsigned _sp = 0; while (cond) { __builtin_amdgcn_s_sleep(1); \
    if ((++_sp & 255u) == 0u) { if (xb_ld(&(bar)[XB_TMO])) break; if (_sp > XB_SPIN_CAP) { atomicAdd(&(bar)[XB_TMO], 1u); break; } } } } while (0)

struct XcdBarrier {
    unsigned* bar; unsigned x;
    volatile LAS unsigned* st;
};

__device__ __forceinline__ XcdBarrier xcd_barrier_post(unsigned* bar, volatile LAS unsigned* st) {
    XcdBarrier b; b.bar = bar; b.x = xb_xcc_id(); b.st = st;
    if (threadIdx.x == 0) (void)xb_add(&bar[XB_XCNT(b.x)], 1u);
    return b;
}
__device__ __forceinline__ void xcd_barrier_complete(unsigned* bar, unsigned x, unsigned& nloc, unsigned& nx) {
    const unsigned G = gridDim.x * gridDim.y * gridDim.z;
    unsigned sum, cnt, mine, sp = 0u;
    for (;;) {
        sum = 0u; cnt = 0u; mine = 0u;
#pragma unroll
        for (unsigned j = 0; j < 16; ++j) { const unsigned c = xb_ld(&bar[XB_XCNT(j)]); sum += c; cnt += (c > 0u) ? 1u : 0u; mine = (j == x) ? c : mine; }
        if (sum == G) break;
        __builtin_amdgcn_s_sleep(1);
        if ((++sp & 255u) == 0u) { if (xb_ld(&bar[XB_TMO])) break; if (sp > XB_SPIN_CAP) { atomicAdd(&bar[XB_TMO], 1u); break; } }
    }
    nloc = mine > 0u ? mine : 1u; nx = cnt > 0u ? cnt : 1u;
}

__device__ __forceinline__ void xcd_barrier(const XcdBarrier& b) {
    asm volatile("s_waitcnt vmcnt(0)" ::: "memory");
    __syncthreads();
    if (threadIdx.x == 0) {
        unsigned* bar = b.bar;
        __builtin_amdgcn_s_waitcnt(0);
        unsigned nloc = b.st[0], nx = b.st[1];
        if (nloc == 0u) { xcd_barrier_complete(bar, b.x, nloc, nx); b.st[0] = nloc; b.st[1] = nx; }
        const unsigned old = xb_add_l(&bar[XB_XSUB(b.x)], 1u);
        const unsigned gen = old / nloc;
        if (old + 1u == (gen + 1u) * nloc) {
            __builtin_amdgcn_fence(__ATOMIC_RELEASE, "agent");
            asm volatile("s_waitcnt vmcnt(0)" ::: "memory");
            const unsigned og = xb_add(&bar[XB_TOP], 1u);
            const unsigned tg = og / nx;
            if (og + 1u == (tg + 1u) * nx) xb_add(&bar[XB_TOPGEN], 1u);
            else XB_SPIN(xb_ld(&bar[XB_TOPGEN]) == tg, bar);
            __builtin_amdgcn_fence(__ATOMIC_ACQUIRE, "agent");
            xb_add_l(&bar[XB_XGEN(b.x)], 1u);
            asm volatile("s_waitcnt vmcnt(0)" ::: "memory");
        } else {
            XB_SPIN(xb_ld(&bar[XB_XGEN(b.x)]) == gen, bar);
            __builtin_amdgcn_fence(__ATOMIC_ACQUIRE, "agent");
            asm volatile("s_waitcnt vmcnt(0)" ::: "memory");
        }
    }
    __syncthreads();
}


__device__ __forceinline__ JobD job(const void* A, const void* B, long tileA, long tileB, int nM, int nN, int nt) { JobD j; j.A = (const char*)A; j.B = (const char*)B; j.tileA = tileA; j.tileB = tileB; j.nM = nM; j.nN = nN; j.nt = nt; j.ksplit = 1 << 30; j.wrapA = 0; j.wrapB = 0; j.batchA = 0; j.batchB = 0; j.tileBm = 0; j.shA = 0; j.shB = 0; return j; }
constexpr int NPHASE = 23;
constexpr int LDS_BYTES = 147456;
__global__ void __launch_bounds__(512, 2) mega(Params P) {
    extern __shared__ __attribute__((aligned(16))) unsigned char lds_raw[];
    LAS unsigned char* lds = (LAS unsigned char*)lds_raw;
    cooperative_groups::grid_group grid = cooperative_groups::this_grid();
    const In& I = P.in; unsigned char* ws = P.ws; const int G = gridDim.x, c = blockIdx.x;
    const int lo = P.ph_lo, hi = P.ph_hi;
    volatile LAS unsigned* bst = (volatile LAS unsigned*)(lds + LDS_BYTES - 16);
    if (threadIdx.x == 0) { bst[0] = 0u; bst[1] = 0u; }
    __syncthreads();
    if (P.ph_lo < 0) grid.sync();
    XcdBarrier bar = xcd_barrier_post((unsigned*)(ws + X_BAR) + P.li * XCD_BAR_WORDS, bst);
#ifndef PHMASK
#define PHMASK 0xffffffffu
#endif
#define IN(k) ((((PHMASK) >> (k)) & 1u) && lo <= (k) && (k) < hi)
#ifdef TIMING
#define STAMP(k) do { if (blockIdx.x == 0 && threadIdx.x == 0) ((unsigned long long*)(ws + X_CTL + 1024))[(k)] = __builtin_amdgcn_s_memrealtime(); } while (0)
#define SEAM(k) do { if (IN(k) && IN((k) + 1)) { xcd_barrier(bar); } STAMP((k) + 1); } while (0)
#else
#define STAMP(k) do { } while (0)
#define SEAM(k) do { if (IN(k) && IN((k) + 1)) { xcd_barrier(bar); } } while (0)
#endif
#ifndef DUP_MASK
#define DUP_MASK 0u
#endif
#ifdef PH_AMP
#ifndef PH_MUL
#define PH_MUL 4
#endif
#define PHAMP_B(k) const unsigned long long _pa0 = __builtin_amdgcn_s_memrealtime();
#define PHAMP_E(k) if ((k) == PH_AMP) { const unsigned long long _pa1 = __builtin_amdgcn_s_memrealtime(); while (__builtin_amdgcn_s_memrealtime() - _pa1 < (_pa1 - _pa0) * PH_MUL) __builtin_amdgcn_s_sleep(8); }
#else
#define PHAMP_B(k)
#define PHAMP_E(k)
#endif
#define PH(k, ...) if (IN(k)) { const int PHK = (k); (void)PHK; PHAMP_B(k) { __VA_ARGS__ } PHAMP_E(k) if (((DUP_MASK) >> (k)) & 1u) { xcd_barrier(bar); { __VA_ARGS__ } } } SEAM(k);
    const long T1K = 256L * 1024 * 2;
    STAMP(0);
#ifdef EXTRA_SYNCS
    for (int i = 0; i < EXTRA_SYNCS; ++i) xcd_barrier(bar);
#endif
#define STAG2(n) { if ((n) > 0 && ((blockIdx.x >> 3) & 1)) { const unsigned long long _s0 = __builtin_amdgcn_s_memrealtime(); while (__builtin_amdgcn_s_memrealtime() - _s0 < (unsigned long long)(n)) __builtin_amdgcn_s_sleep(4); } }
#ifndef STAG4
#define STAG4 0
#endif
#ifndef STAG10
#define STAG10 0
#endif
#ifndef STAG15
#define STAG15 0
#endif
#ifndef STAG22
#define STAG22 0
#endif
#define STAGGER(n)
    PH(0,  prep_phase(P, lds); )
#ifndef FILL1_Q
#define FILL1_Q 8
#endif
#ifndef FILL6_Q
#define FILL6_Q 1
#endif
    PH(1,  StaticSched S; S.G = G; S.c = c; S.lda = 2048; S.ldb = 2048; S.nj = 2;
        S.j0 = job(ws + A_MIX, ws + W_RKV, T1K, T1K, 384, 4, 16); S.j0.shB = 7; S.j0.batchB = 2 * MiB;
        S.j1 = job((unsigned char*)P.out + O_XB + 2048, ws + W_L1, T1K, T1K, 128, 1, 32); S.j1.ksplit = 16; S.j1.wrapA = -(16L * 128 + 2048); S.j1.wrapB = 256L * 1024 * 2 - 16L * 128; S.j1.shA = 3; S.j1.batchA = 2048;
        EpiP1 E{(bf16_t*)(ws + A_RKV), (bf16_t*)((unsigned char*)P.out + O_HL)};
        struct SchedP1 { StaticSched s; __device__ __forceinline__ bool next(int i, Unit& u) const {
                if (s.G != 256) return s.next(i, u);
                const int c = s.c; long L;
                if (i == 0) L = c < 128 ? 1536 + c : c - 128; else if (i <= 5) L = 128 + (long)(i - 1) * 256 + c; else if (i == 6 && c >= 128) L = 1408 + (c - 128); else return false;
                StaticSched t = s; t.G = 1; t.c = 0; return t.next((int)L, u); }
            int lda, ldb; } SP; SP.s = S; SP.lda = S.lda; SP.ldb = S.ldb;
        gemm_phase(lds, SP, E); )
    PH(2,  StaticSched S; S.G = G; S.c = c; S.lda = 512; S.ldb = 512; S.nj = 1; S.j0 = job((unsigned char*)P.out + O_HL, ws + W_L2, 256L * 256 * 2, 256L * 256 * 2, 128, 12, 4); S.j1 = S.j0;
        EpiP2 E{(bf16_t*)(ws + A_WAG), I.a_w0, I.a_a0}; gemm_phase(lds, S, E); )
#ifdef DUP_SCAN
    if (IN(3)) { scan_phase(P, lds, (bf16_t*)P.out); xcd_barrier(bar); }
#endif
#if defined(DBG_SCAN)
    if (IN(3)) {
        scan_chunked(P, lds, (bf16_t*)P.out); xcd_barrier(bar);
        scan_phase(P, lds, (bf16_t*)(ws + A_RKV)); xcd_barrier(bar);
        { const bf16_t* a = (const bf16_t*)P.out; const bf16_t* r2 = (const bf16_t*)(ws + A_RKV); float s0 = 0.f, s1 = 0.f;
          for (size_t i = (size_t)blockIdx.x * 512 + threadIdx.x; i < (size_t)M * D; i += (size_t)gridDim.x * 512) { const int tt = (int)((i >> 10) & 2047); if (tt < DBG_TMIN || tt >= DBG_TMAX) continue; float x = bf2f(a[i]), y = bf2f(r2[i]);
#if DBG_MODE == 1
            if (!(fabsf(x) < 1e30f)) { s0 += 1.f; } s1 += 1.f; }
#else
            if (!(fabsf(x) < 1e30f)) continue; s0 += (x - y) * (x - y); s1 += y * y; }
#endif
          s0 = wave_sum(s0); s1 = wave_sum(s1); if ((threadIdx.x & 63) == 0) { atomicAdd((float*)(ws + X_CTL) + 300, s0); atomicAdd((float*)(ws + X_CTL) + 301, s1); } }
    } SEAM(3);
#elif defined(SCAN_OLD)
    PH(3,  scan_phase(P, lds, (bf16_t*)(ws + A_RKV)); )
#else
    PH(3,  scan_chunked(P, lds, (bf16_t*)(ws + A_RKV)); )
#endif
    PH(4,  STAG2(STAG4) StaticSched S; S.G = G; S.c = c; S.lda = 2048; S.ldb = 2048; S.nj = 1; S.j0 = job(ws + A_RKV, ws + W_AO, T1K, T1K, 128, 4, 16); S.j1 = S.j0; EpiResid E{I.x, nullptr, (_Float16*)P.out, nullptr, nullptr, nullptr}; gemm_phase(lds, S, E); )
    PH(5,  ln_phase(P, lds, 0, (bf16_t*)(ws + A_X1B), nullptr, false, I.p, (bf16_t*)(ws + A_PB0), (_Float16*)P.out, (_Float16*)P.out); )
    PH(6,  StaticSched S; S.G = G; S.c = c; S.lda = 2048; S.ldb = 2048; S.nj = 1; S.j0 = job(ws + A_X1B, ws + W_FGU, T1K, T1K, 128, 22, 16); S.j1 = S.j0; EpiGlu E{(bf16_t*)(ws + A_H), DFF}; gemm_phase(lds, S, E); )
    PH(7,  StaticSched S; S.G = G; S.c = c; S.lda = DFF * 2; S.ldb = DFF * 2; S.nj = 1; S.j0 = job(ws + A_H, ws + W_FDN, 256L * DFF * 2, 256L * DFF * 2, 128, 4, 44); S.j1 = S.j0; EpiResid E{nullptr, (_Float16*)P.out, (_Float16*)P.out, (const f32x2*)(ws + X_STAT), I.ln_g, I.ln_b}; gemm_phase(lds, S, E); )
    PH(8,  { StaticSched S; S.G = G; S.c = c; S.lda = 512; S.ldb = 512; S.nj = 1; S.j0 = job(ws + A_PB0, ws + W_PLE, 256L * 256 * 2, 256L * 256 * 2, 128, 4, 4); S.j1 = S.j0; EpiBf16 E{(bf16_t*)(ws + A_PP0), nullptr, 1024, nullptr, nullptr, 0}; gemm_phase(lds, S, E); }
        ln_phase(P, lds, 1, (bf16_t*)(ws + A_X2B), nullptr, false, nullptr, nullptr, (_Float16*)P.out, (_Float16*)P.out); )
    PH(10,  STAG2(STAG10) StaticSched S; S.G = G; S.c = c; S.lda = 2048; S.ldb = 2048; S.nj = 1; S.j0 = job(ws + A_X2B, ws + W_GATE, T1K, T1K, 128, 4, 16); S.j1 = S.j0; EpiGate E{(_Float16*)P.out, nullptr, nullptr, (const bf16_t*)(ws + A_PP0), I.ple_gate_b, (bf16_t*)(ws + A_X3B), (const f32x2*)(ws + X_STAT) + (size_t)M, I.ln_g + D, I.ln_b + D}; gemm_phase(lds, S, E); )
    PH(11,  StaticSched S; S.G = G; S.c = c; S.lda = 2048; S.ldb = 2048; S.nj = 2; S.j0 = job(ws + A_X3B, ws + W_NSA, T1K, T1K, 128, 9, 16); S.j1 = job(ws + W_VT, ws + A_X3B, T1K, T1K, 2, 128, 16);
        EpiNsa E{ws}; gemm_phase(lds, S, E);
        { const int rr = 1408 % G; if (c >= rr) { const int nl = G - rr; const float* psrc = I.p + (size_t)M * PLE; bf16_t* pdst = (bf16_t*)(ws + A_PB1);
              for (int i = (c - rr) * 512 + (int)threadIdx.x; i < M * PLE / 8; i += nl * 512) { const f32x4 a = *(const f32x4*)(psrc + (size_t)i * 8), b2 = *(const f32x4*)(psrc + (size_t)i * 8 + 4); *(u32x4*)(pdst + (size_t)i * 8) = pack8(a, b2); } } } )
    PH(12,  StaticSched S; S.G = G; S.c = c; S.lda = 2048; S.ldb = 4096; S.nj = 2;
        S.j0 = job(ws + A_KC, ws + W_PHI, 1024, 0, 128, 1, 8); S.j0.shA = 2; S.j0.batchA = T1K - 4096; S.j0.tileBm = 1024; S.j0.shB = 2; S.j0.batchB = -4096;
        S.j1 = job(ws + A_VC, ws + W_PHI + MiB, 1024, 0, 128, 1, 8); S.j1.shA = 2; S.j1.batchA = T1K - 4096; S.j1.tileBm = 1024; S.j1.shB = 2; S.j1.batchB = -4096;
        EpiPart E{(float*)(ws + A_HCP)}; gemm_phase(lds, S, E); )
    PH(13,  cmp2_phase(P, lds); )
    PH(14,  attn_phase(P, lds); )
    PH(15,  STAG2(STAG15) StaticSched S; S.G = G; S.c = c; S.lda = 2048; S.ldb = 2048; S.nj = 1; S.j0 = job(ws + A_ATT, ws + W_BO, T1K, T1K, 128, 4, 16); S.j1 = S.j0; EpiResid E{nullptr, nullptr, (_Float16*)P.out, nullptr, nullptr, nullptr, (const bf16_t*)(ws + A_X3B)}; gemm_phase(lds, S, E); )
    PH(16,  ln_phase(P, lds, 2, (bf16_t*)(ws + A_X4B), nullptr, true, nullptr, nullptr, (_Float16*)P.out, (_Float16*)P.out); )
    PH(17,  moe_gather_phase(P, lds); )
    PH(18,  MoeSchedG S; S.rs = (const int*)(ws + X_RSRC); S.A = (const char*)(ws + A_X4B); S.B = (const char*)(ws + W_MGU); S.tileA = T1K; S.tileB = T1K; S.strideE = 2816L * 1024 * 2; S.nN = 11; S.nt = 16; S.G = G; S.c = c; S.lda = 2048; S.ldb = 2048; S.init((const unsigned*)(ws + X_CTL) + CW_CNT);
        EpiGlu E{(bf16_t*)(ws + A_HM), DFE}; gemm_phase(lds, S, E); )
    PH(19,  MoeSched S; S.A = (const char*)(ws + A_HM); S.B = (const char*)(ws + W_MDN); S.tileA = 256L * DFE * 2; S.tileB = 256L * DFE * 2; S.strideE = 1024L * DFE * 2; S.nN = 4; S.nt = 22; S.G = G; S.c = c; S.lda = DFE * 2; S.ldb = DFE * 2; S.init((const unsigned*)(ws + X_CTL) + CW_CNT);
        EpiMoeDown E{(bf16_t*)(ws + A_YS2), (const int*)(ws + X_RDST), (const float*)(ws + X_RW)}; gemm_phase(lds, S, E);
        { const int ntail = S.nblk * S.nN - 4 * G; const int nt0 = ntail < 0 ? 0 : (ntail > G - 8 ? G - 8 : ntail);
          if (c >= nt0) { StaticSched S2; S2.G = G - nt0; S2.c = c - nt0; S2.lda = 512; S2.ldb = 512; S2.nj = 1; S2.j0 = job(ws + A_PB1, ws + W_PLE + MiB / 2, 256L * 256 * 2, 256L * 256 * 2, 128, 4, 4); S2.j1 = S2.j0;
              EpiBf16 E2{(bf16_t*)(ws + A_PP1), nullptr, 1024, nullptr, nullptr, 0}; gemm_phase(lds, S2, E2); } } )
    PH(20,  ln_phase(P, lds, 3, (bf16_t*)(ws + A_X5B), (const bf16_t*)(ws + A_YS2), false, nullptr, nullptr, (_Float16*)P.out, nullptr); )
    PH(22,  STAG2(STAG22) StaticSched S; S.G = G; S.c = c; S.lda = 2048; S.ldb = 2048; S.nj = 1; S.j0 = job(ws + A_X5B, ws + W_GATE + 2 * MiB, T1K, T1K, 128, 4, 16); S.j1 = S.j0; EpiGateOut E{(const bf16_t*)(ws + A_X5B), P.out, (const bf16_t*)(ws + A_PP1), I.ple_gate_b + D}; gemm_phase(lds, S, E); )
#if defined(DBG_SCAN)
    xcd_barrier(bar);
    { const float e0 = ((const float*)(ws + X_CTL))[300], e1 = ((const float*)(ws + X_CTL))[301]; float e = sqrtf(e0 / fmaxf(e1, 1e-30f)); if (!(e < 1e3f)) e = 1e3f; const float sc = 1.f + 10.f * e;
      for (size_t i = (size_t)blockIdx.x * 512 + threadIdx.x; i < (size_t)M * D; i += (size_t)gridDim.x * 512) P.out[i] *= sc; }
#endif
#undef IN
#undef SEAM
}

static int g_grid = 0;
static bool fast_setup(size_t ws_size) {
    if (g_grid) return g_grid > 0;
    int dev = 0, cus = 0, per_cu = 0;
    if (ws_size < WS_NEED) { fprintf(stderr, "kernel_launch: workspace too small: %zu < %zu\n", ws_size, (size_t)WS_NEED); g_grid = -1; return false; }
    (void)hipGetDevice(&dev); (void)hipDeviceGetAttribute(&cus, hipDeviceAttributeMultiprocessorCount, dev);
    if (hipFuncSetAttribute((const void*)mega, hipFuncAttributeMaxDynamicSharedMemorySize, LDS_BYTES) != hipSuccess) { fprintf(stderr, "hipFuncSetAttribute failed\n"); g_grid = -1; return false; }
    if (hipOccupancyMaxActiveBlocksPerMultiprocessor(&per_cu, (const void*)mega, 512, LDS_BYTES) != hipSuccess || per_cu < 1) { fprintf(stderr, "occupancy query failed (%d)\n", per_cu); g_grid = -1; return false; }
    g_grid = cus * 1;
    fprintf(stderr, "fast_setup: cus %d per_cu %d grid %d ws %zu need %zu\n", cus, per_cu, g_grid, ws_size, (size_t)WS_NEED);
    return true;
}
static void fast_launch(void* const* d_in, void* d_out, void* d_ws, hipStream_t stream, int lo, int hi, int li = 0) {
    Params p{}; const float** f = (const float**)&p.in; for (int i = 0; i < 36; ++i) f[i] = (const float*)d_in[i];
    p.out = (float*)d_out; p.ws = (unsigned char*)d_ws; p.ph_lo = lo; p.ph_hi = hi; p.li = li; p.pad = 0;
    void* args[] = {&p};
    hipError_t e = hipLaunchCooperativeKernel((const void*)mega, dim3(g_grid), dim3(512), args, LDS_BYTES, stream);
    if (e != hipSuccess) fprintf(stderr, "cooperative launch failed: %s (grid %d)\n", hipGetErrorString(e), g_grid);
}
}
extern "C" void kernel_launch(void* const* d_in, const int* in_sizes, int n_in, void* d_out, int out_size, void* d_ws, size_t ws_size, hipStream_t stream) {
    if (!fx::fast_setup(ws_size)) return;
    (void)hipMemsetAsync((char*)d_ws + fx::X_CTL, 0, 65536, stream);
#if defined(PER_PHASE)
    for (int ph = 0; ph < fx::NPHASE; ++ph) fx::fast_launch(d_in, d_out, d_ws, stream, ph, ph + 1);
#else
    fx::fast_launch(d_in, d_out, d_ws, stream, 0, fx::NPHASE);
#endif
}
```
